# Optimizing an MI355X kernel written in HIP

```python
import jax, jax.numpy as jnp
from jax import lax
import numpy as np

D_MODEL = 1024
BATCH = 4
SEQ = 8192
DEPTH = 2

GRID_W = 64
CTX_LEN = 256
HEAD_DIM = 64
ATT_HEADS = (D_MODEL // 2) // HEAD_DIM
ATT_KV_HEADS = ATT_HEADS // 4
ATT_GROUP = ATT_HEADS // ATT_KV_HEADS
ATT_WIDTH = ATT_HEADS * HEAD_DIM
KV_WIDTH = ATT_KV_HEADS * HEAD_DIM
WINDOW = 128
BLOCK = 128
ROPE_BASE = 10000.0
RWKV_HEADS = (D_MODEL // 2) // HEAD_DIM
RWKV_WIDTH = RWKV_HEADS * HEAD_DIM
DECAY_LORA = 64
ICLR_LORA = 64
GATE_LORA = 128
MLP_HIDDEN = 4 * D_MODEL
N_EVEN = (DEPTH + 1) // 2
N_ODD = DEPTH // 2
NORM_EPS = 1e-6
GN_EPS = 64e-5
ATT_SPLITS = (ATT_WIDTH, KV_WIDTH, KV_WIDTH)
RWKV_SPLITS = (RWKV_WIDTH, RWKV_WIDTH, RWKV_WIDTH, DECAY_LORA, DECAY_LORA, ICLR_LORA, ICLR_LORA, GATE_LORA)
ATT_IN_WIDTH = ATT_WIDTH + 2 * KV_WIDTH
RWKV_IN_WIDTH = 3 * RWKV_WIDTH + 2 * DECAY_LORA + 2 * ICLR_LORA + GATE_LORA
AB_IN_WIDTH = ATT_IN_WIDTH + RWKV_IN_WIDTH
MIX_WIDTH = ATT_WIDTH + RWKV_WIDTH
F32 = jnp.float32

kernel_name = 'hybrid_swa_rwkv7_shortconv_dit'


def _split(u, sizes):
    out, start = [], 0
    for s in sizes:
        out.append(u[..., start:start + s])
        start += s
    return out


def rms_norm(u, g):
    uf = u.astype(F32)
    y = uf * lax.rsqrt(jnp.mean(uf * uf, axis=-1, keepdims=True) + NORM_EPS)
    return (y * g.astype(F32)).astype(u.dtype)


def shift_centred(u):
    prev = jnp.pad(u[:, :-1], ((0, 0), (1, 0), (0, 0)))
    nxt = jnp.pad(u[:, 1:], ((0, 0), (0, 1), (0, 0)))
    return 0.5 * (prev + nxt)


def conv3_centred(u, w):
    prev = jnp.pad(u[:, :-1], ((0, 0), (1, 0), (0, 0)))
    nxt = jnp.pad(u[:, 1:], ((0, 0), (0, 1), (0, 0)))
    return prev * w[0] + u * w[1] + nxt * w[2]


def rope_1d(u, pos):
    m = u.shape[-1] // 2
    inv = ROPE_BASE ** (-jnp.arange(m, dtype=F32) / m)
    ang = pos.astype(F32)[:, None] * inv[None, :]
    cos = jnp.cos(ang)[None, :, None, :]
    sin = jnp.sin(ang)[None, :, None, :]
    uf = u.astype(F32)
    u1, u2 = uf[..., :m], uf[..., m:]
    return jnp.concatenate([u1 * cos - u2 * sin, u2 * cos + u1 * sin], axis=-1).astype(u.dtype)


def rope_2d(u, row, col):
    h = u.shape[-1] // 2
    return jnp.concatenate([rope_1d(u[..., :h], row), rope_1d(u[..., h:], col)], axis=-1)


def window_attention(q, k, v, kc, vc, sink):
    B, S = q.shape[0], q.shape[1]
    L = kc.shape[1]
    nb = S // BLOCK
    n_loc = 3 * BLOCK
    scale = HEAD_DIM ** -0.5
    qb = q.reshape(B, nb, BLOCK, ATT_KV_HEADS, ATT_GROUP, HEAD_DIM).transpose(1, 0, 2, 3, 4, 5)
    pad = ((0, 0), (BLOCK, BLOCK), (0, 0), (0, 0))
    kp, vp = jnp.pad(k, pad), jnp.pad(v, pad)
    sink_l = sink.astype(F32).reshape(1, ATT_KV_HEADS, ATT_GROUP, 1, 1)
    rel = jnp.arange(BLOCK)[:, None] + BLOCK - jnp.arange(n_loc)[None, :]
    band = jnp.abs(rel) <= WINDOW

    def one_block(args):
        bi, qblk = args
        start = bi * BLOCK
        kb = lax.dynamic_slice_in_dim(kp, start, n_loc, axis=1)
        vb = lax.dynamic_slice_in_dim(vp, start, n_loc, axis=1)
        kpos = start - BLOCK + jnp.arange(n_loc)
        valid = band & ((kpos >= 0) & (kpos < S))[None, :]
        s_loc = jnp.einsum('bqhgd,bkhd->bhgqk', qblk, kb).astype(F32) * scale
        s_loc = jnp.where(valid, s_loc, -jnp.inf)
        s_ctx = jnp.einsum('bqhgd,bkhd->bhgqk', qblk, kc).astype(F32) * scale
        s_sink = jnp.broadcast_to(sink_l, s_loc.shape[:-1] + (1,))
        p = jax.nn.softmax(jnp.concatenate([s_loc, s_ctx, s_sink], axis=-1), axis=-1).astype(v.dtype)
        return (jnp.einsum('bhgqk,bkhd->bqhgd', p[..., :n_loc], vb)
                + jnp.einsum('bhgqk,bkhd->bqhgd', p[..., n_loc:n_loc + L], vc))

    out = lax.map(one_block, (jnp.arange(nb), qb))
    return out.transpose(1, 0, 2, 3, 4, 5).reshape(B, S, ATT_WIDTH)


def context_attention(qc, kc, vc, sink):
    B, L = qc.shape[0], qc.shape[1]
    qg = qc.reshape(B, L, ATT_KV_HEADS, ATT_GROUP, HEAD_DIM)
    s = jnp.einsum('bqhgd,bkhd->bhgqk', qg, kc).astype(F32) * HEAD_DIM ** -0.5
    s_sink = jnp.broadcast_to(sink.astype(F32).reshape(1, ATT_KV_HEADS, ATT_GROUP, 1, 1), s.shape[:-1] + (1,))
    p = jax.nn.softmax(jnp.concatenate([s, s_sink], axis=-1), axis=-1).astype(vc.dtype)
    return jnp.einsum('bhgqk,bkhd->bqhgd', p[..., :L], vc).reshape(B, L, ATT_WIDTH)


def _heads(u):
    return u.reshape(u.shape[:-1] + (RWKV_HEADS, HEAD_DIM))


def rwkv_features(pr, lp):
    pr = pr.astype(F32)
    pr = pr + lp['mu'] * (shift_centred(pr) - pr)
    r, k, v, wf, wb, af, ab, g = _split(pr, RWKV_SPLITS)
    kk = _heads(k * lp['kk'])
    kk = kk / jnp.maximum(jnp.sqrt(jnp.sum(kk * kk, axis=-1, keepdims=True)), 1e-12)
    decays, ks, iclrs = [], [], []
    for d, (wd, ad) in enumerate(((wf, af), (wb, ab))):
        w_log = -jax.nn.softplus(-(lp['w0'][d] + jnp.tanh(wd) @ lp['w2'][d])) - 0.5
        a = jax.nn.sigmoid(lp['a0'][d] + ad @ lp['a2'][d])
        decays.append(_heads(jnp.exp(-jnp.exp(w_log))))
        ks.append(_heads(k * (1.0 + (a - 1.0) * lp['ka'])))
        iclrs.append(_heads(a))
    gate = jax.nn.sigmoid(g) @ lp['g2']
    return dict(r=_heads(r), v=_heads(v), kk=kk, gate=gate, decay=decays, k=ks, a=iclrs)


def rwkv_scan(state0, f, d, emit, reverse):
    xs = tuple(jnp.moveaxis(t, 1, 0) for t in (f['decay'][d], f['k'][d], f['v'], -f['kk'], f['kk'] * f['a'][d]))

    def update(S, w_t, k_t, v_t, a_t, b_t):
        sa = jnp.einsum('bhvk,bhk->bhv', S, a_t)
        return S * w_t[:, :, None, :] + sa[..., None] * b_t[:, :, None, :] + v_t[..., None] * k_t[:, :, None, :]

    if not emit:
        s_fin, _ = lax.scan(lambda S, inp: (update(S, *inp), None), state0, xs, reverse=reverse)
        return s_fin, None

    def step(S, inp):
        S = update(S, *inp[1:])
        return S, jnp.einsum('bhvk,bhk->bhv', S, inp[0])

    s_fin, ys = lax.scan(step, state0, (jnp.moveaxis(f['r'], 1, 0),) + xs, reverse=reverse)
    return s_fin, jnp.moveaxis(ys, 0, 1)


def rwkv_output(y, f, lp):
    mean = jnp.mean(y, axis=-1, keepdims=True)
    var = jnp.mean(jnp.square(y - mean), axis=-1, keepdims=True)
    yn = ((y - mean) * lax.rsqrt(var + GN_EPS)).reshape(y.shape[:2] + (RWKV_WIDTH,))
    yn = yn * lp['ln_w'] + lp['ln_b']
    bonus = sum(jnp.sum(f['r'] * kd * lp['rk'], axis=-1, keepdims=True) * f['v'] for kd in f['k'])
    return (yn + bonus.reshape(yn.shape)) * f['gate']


def ab_mixer(hl, hc, row, col, lp, need_ctx_out):
    B, S = hl.shape[0], hl.shape[1]
    L = hc.shape[1]
    pl = hl @ lp['w_in']
    pc = hc @ lp['w_in']
    ql, kl, vl = _split(pl[..., :ATT_IN_WIDTH], ATT_SPLITS)
    qc, kc, vc = _split(pc[..., :ATT_IN_WIDTH], ATT_SPLITS)
    ql = rope_2d(ql.reshape(B, S, ATT_HEADS, HEAD_DIM), row, col)
    kl = rope_2d(kl.reshape(B, S, ATT_KV_HEADS, HEAD_DIM), row, col)
    vl = vl.reshape(B, S, ATT_KV_HEADS, HEAD_DIM)
    kc = kc.reshape(B, L, ATT_KV_HEADS, HEAD_DIM)
    vc = vc.reshape(B, L, ATT_KV_HEADS, HEAD_DIM)
    att_l = window_attention(ql, kl, vl, kc, vc, lp['sink'])

    fl = rwkv_features(pl[..., ATT_IN_WIDTH:], lp)
    fc = rwkv_features(pc[..., ATT_IN_WIDTH:], lp)
    state0 = jnp.zeros((B, RWKV_HEADS, HEAD_DIM, HEAD_DIM), F32)
    ys_l, ys_c = [], []
    for d in range(2):
        rev = d == 1
        s_ctx, yc_d = rwkv_scan(state0, fc, d, need_ctx_out, rev)
        _, yl_d = rwkv_scan(s_ctx, fl, d, True, rev)
        ys_l.append(yl_d)
        ys_c.append(yc_d)
    rw_l = rwkv_output(ys_l[0] + ys_l[1], fl, lp)
    out_l = jnp.concatenate([att_l, rw_l.astype(att_l.dtype)], axis=-1) @ lp['w_out']
    if not need_ctx_out:
        return out_l, None
    att_c = context_attention(qc.reshape(B, L, ATT_HEADS, HEAD_DIM), kc, vc, lp['sink'])
    rw_c = rwkv_output(ys_c[0] + ys_c[1], fc, lp)
    out_c = jnp.concatenate([att_c, rw_c.astype(att_c.dtype)], axis=-1) @ lp['w_out']
    return out_l, out_c


def conv_mixer(h, w_in, conv_w, w_out):
    gate_b, gate_c, u = jnp.split(h @ w_in, 3, axis=-1)
    return (gate_b * conv3_centred(gate_c * u, conv_w)) @ w_out


def sq_relu_mlp(h, w1, w2):
    return jnp.square(jax.nn.relu(h @ w1)) @ w2


def setup_inputs(seed: int = 0) -> dict:
    key = jax.random.key(seed)
    ks = jax.random.split(key, 26)
    D = D_MODEL

    def nrm(k, shape, s):
        return jax.random.normal(k, shape, F32) * s

    return {
        'x': nrm(ks[0], (BATCH, SEQ, D), 1.0),
        'c': nrm(ks[1], (BATCH, D), 1.0),
        'ctx': nrm(ks[2], (BATCH, CTX_LEN, D), 1.0),
        'c_ctx': nrm(ks[3], (D,), 1.0),
        'mod_w': nrm(ks[4], (DEPTH, D, 6 * D), 0.5 * D ** -0.5),
        'mod_b': nrm(ks[5], (DEPTH, 6 * D), 0.02),
        'norm_g': 1.0 + nrm(ks[6], (DEPTH, 4, D), 0.02),
        'mlp_w1': nrm(ks[7], (DEPTH, D, MLP_HIDDEN), D ** -0.5),
        'mlp_w2': nrm(ks[8], (DEPTH, MLP_HIDDEN, D), MLP_HIDDEN ** -0.5),
        'ab_w_in': nrm(ks[9], (N_EVEN, D, AB_IN_WIDTH), D ** -0.5),
        'ab_w_out': nrm(ks[10], (N_EVEN, MIX_WIDTH, D), MIX_WIDTH ** -0.5),
        'att_sink': nrm(ks[11], (N_EVEN, ATT_HEADS), 0.5),
        'rwkv_mu': jax.random.uniform(ks[12], (N_EVEN, RWKV_IN_WIDTH), F32, 0.0, 1.0),
        'rwkv_w0': nrm(ks[13], (N_EVEN, 2, RWKV_WIDTH), 0.5),
        'rwkv_w2': nrm(ks[14], (N_EVEN, 2, DECAY_LORA, RWKV_WIDTH), 0.5 * DECAY_LORA ** -0.5),
        'rwkv_a0': nrm(ks[15], (N_EVEN, 2, RWKV_WIDTH), 0.5),
        'rwkv_a2': nrm(ks[16], (N_EVEN, 2, ICLR_LORA, RWKV_WIDTH), 0.5 * ICLR_LORA ** -0.5),
        'rwkv_g2': nrm(ks[17], (N_EVEN, GATE_LORA, RWKV_WIDTH), GATE_LORA ** -0.5),
        'rwkv_kk': 0.85 + nrm(ks[18], (N_EVEN, RWKV_WIDTH), 0.05),
        'rwkv_ka': 1.0 + nrm(ks[19], (N_EVEN, RWKV_WIDTH), 0.05),
        'rwkv_rk': nrm(ks[20], (N_EVEN, RWKV_HEADS, HEAD_DIM), 0.1),
        'rwkv_ln_w': 1.0 + nrm(ks[21], (N_EVEN, RWKV_WIDTH), 0.02),
        'rwkv_ln_b': nrm(ks[22], (N_EVEN, RWKV_WIDTH), 0.02),
        'conv_w_in': nrm(ks[23], (N_ODD, D, 3 * D), D ** -0.5),
        'conv_w': nrm(ks[24], (N_ODD, 3, D), 3.0 ** -0.5),
        'conv_w_out': nrm(ks[25], (N_ODD, D, D), D ** -0.5),
    }


def reference(x, c, ctx, c_ctx, mod_w, mod_b, norm_g, mlp_w1, mlp_w2, ab_w_in, ab_w_out, att_sink,
              rwkv_mu, rwkv_w0, rwkv_w2, rwkv_a0, rwkv_a2, rwkv_g2, rwkv_kk, rwkv_ka, rwkv_rk,
              rwkv_ln_w, rwkv_ln_b, conv_w_in, conv_w, conv_w_out):
    S = x.shape[1]
    rows = S // GRID_W
    t = jnp.arange(rows * GRID_W)
    row, col = t // GRID_W, t % GRID_W
    last_even = DEPTH - 1 if (DEPTH - 1) % 2 == 0 else DEPTH - 2
    xl, xc = x, ctx
    for i in range(DEPTH):
        need_ctx = i < last_even
        ctx_live = (i % 2 == 0) or need_ctx
        mod_l = (jax.nn.silu(c) @ mod_w[i] + mod_b[i])[:, None, :]
        sh_a, sc_a, gt_a, sh_m, sc_m, gt_m = jnp.split(mod_l, 6, axis=-1)
        hl = rms_norm(xl, norm_g[i, 0]) * (1 + sc_a) + sh_a
        hc = None
        if ctx_live:
            mod_c = (jax.nn.silu(c_ctx) @ mod_w[i] + mod_b[i])[None, None, :]
            csh_a, csc_a, cgt_a, csh_m, csc_m, cgt_m = jnp.split(mod_c, 6, axis=-1)
            hc = rms_norm(xc, norm_g[i, 0]) * (1 + csc_a) + csh_a
        if i % 2 == 0:
            e = i // 2
            lp = dict(w_in=ab_w_in[e], w_out=ab_w_out[e], sink=att_sink[e], mu=rwkv_mu[e],
                      w0=rwkv_w0[e], w2=rwkv_w2[e], a0=rwkv_a0[e], a2=rwkv_a2[e], g2=rwkv_g2[e],
                      kk=rwkv_kk[e], ka=rwkv_ka[e], rk=rwkv_rk[e], ln_w=rwkv_ln_w[e], ln_b=rwkv_ln_b[e])
            yl, yc = ab_mixer(hl, hc, row, col, lp, need_ctx)
        else:
            o = i // 2
            yl = conv_mixer(hl, conv_w_in[o], conv_w[o], conv_w_out[o])
            yc = conv_mixer(hc, conv_w_in[o], conv_w[o], conv_w_out[o]) if need_ctx else None
        xl = xl + gt_a * rms_norm(yl, norm_g[i, 1])
        hm = rms_norm(xl, norm_g[i, 2]) * (1 + sc_m) + sh_m
        xl = xl + gt_m * rms_norm(sq_relu_mlp(hm, mlp_w1[i], mlp_w2[i]), norm_g[i, 3])
        if need_ctx:
            xc = xc + cgt_a * rms_norm(yc, norm_g[i, 1])
            hmc = rms_norm(xc, norm_g[i, 2]) * (1 + csc_m) + csh_m
            xc = xc + cgt_m * rms_norm(sq_relu_mlp(hmc, mlp_w1[i], mlp_w2[i]), norm_g[i, 3])
    return xl
```

```cpp
#include <hip/hip_runtime.h>
#include <hip/hip_cooperative_groups.h>
#include <cstdio>
#include <cstdint>
namespace cg = cooperative_groups;
namespace pg8 {
#define PG8_LAS __attribute__((address_space(3)))
typedef unsigned short bf16_t;
typedef short bf16x8 __attribute__((ext_vector_type(8)));
typedef float f32x4 __attribute__((ext_vector_type(4)));
typedef unsigned u32x4 __attribute__((ext_vector_type(4)));
constexpr int BM = 256, BK = 64, HALF = 128, HTB = HALF * BK * 2  , STAGE_BYTES = 8 * HTB, NXCD = 8, WGM = 8;

__host__ __device__ __forceinline__ int lds_byte(int r, int c) { const int st = (r >> 4) * 2 + (c >> 5), rr = r & 15, cc = c & 31, ob = rr * 64 + cc * 2; return st * 1024 + (ob ^ (((ob >> 9) & 1) << 5)); }
__host__ __device__ __forceinline__ void stage_rc(int b, int& R, int& C) { const int st = b / 1024, sb = b % 1024, swz = sb ^ (((sb >> 9) & 1) << 5); R = (st >> 1) * 16 + swz / 64; C = (st & 1) * 32 + (swz % 64) / 2; }
__host__ __device__ __forceinline__ int perm32(int rho) { const int n = rho >> 4, i = rho & 15; return 8 * (i >> 2) + 4 * n + (i & 3); }

struct Unit { int pm, pn; };
struct Gemm { const bf16_t* A; const bf16_t* Bt; int M, N, K, lda; };

struct StaticOrder {
    int nM, nN, nwg, G, c;
    __host__ __device__ void init(int M, int N, int G_, int c_) { nM = M / BM; nN = N / BM; nwg = nM * nN; G = G_; c = c_; }
    __host__ __device__ bool next(int i, Unit& u) const {
        const long L = (long)i * G + c; if (L >= nwg) return false;
        int wgid = (int)L; { const int q = nwg / NXCD, r = nwg % NXCD, xcd = wgid % NXCD, off = wgid / NXCD; wgid = (xcd < r ? xcd * (q + 1) : r * (q + 1) + (xcd - r) * q) + off; }
        const int nig = WGM * nN, gid = wgid / nig, fm = gid * WGM, gsz = (nM - fm) < WGM ? (nM - fm) : WGM;
        u.pm = fm + ((wgid % nig) % gsz); u.pn = (wgid % nig) / gsz; return true;
    }
    __device__ __forceinline__ void a_ready(const Unit&) const {}
    __device__ __forceinline__ void done(const Unit&) const {}
};

__device__ __forceinline__ unsigned cvt_pk_bf16(float lo, float hi) { unsigned r; asm volatile("v_cvt_pk_bf16_f32 %0, %1, %2" : "=v"(r) : "v"(lo), "v"(hi)); return r; }
typedef float f32x2 __attribute__((ext_vector_type(2)));
__device__ __forceinline__ f32x2 gelu_pk(f32x2 v) {
    const f32x2 av = __builtin_elementwise_abs(v), d = av * 0.2316418882f + 1.0f;
    f32x2 t; t.x = __builtin_amdgcn_rcpf(d.x); t.y = __builtin_amdgcn_rcpf(d.y);
    f32x2 q = t * 0.5307027145f + (-0.7265760135f); q = q * t + 0.7107068705f; q = q * t + (-0.142248368f); q = q * t + 0.127414796f; q = q * t;
    const f32x2 s = (v * v) * (-0.72134752044f);
    f32x2 e; e.x = __builtin_amdgcn_exp2f(s.x); e.y = __builtin_amdgcn_exp2f(s.y);
    const f32x2 m = v * (q * e), r = v - m;
    f32x2 o; o.x = v.x < 0.f ? m.x : r.x; o.y = v.y < 0.f ? m.y : r.y; return o;
}

template <int ACT  > struct EpiBf16 {
    static constexpr bool PERM = true, AFTER_DRAIN = false; static_assert(ACT == 0 || ACT == 1, "EpiBf16: ACT is 0 or 1");
    bf16_t* O; int ldc; const float* bias; int split_cols; size_t split_stride; float scale0;
    __device__ __forceinline__ void operator()(const f32x4 (&acc)[2][2][4][2], const Unit& u, int wr, int wc, int fr, int fq) const {
        const int row0 = u.pm * BM + wr * 64 + fr; int colt = u.pn * BM; bf16_t* base = O;
        float sc = 1.f; if (split_cols) { const int t = colt / split_cols; base += (size_t)t * split_stride; colt -= t * split_cols; if (t == 0) sc = scale0; }
        const int col0 = colt + wc * 32 + 8 * fq, bcol0 = u.pn * BM + wc * 32 + 8 * fq;
        f32x4 bv[2][2];
#pragma unroll
        for (int bj = 0; bj < 2; ++bj)
#pragma unroll
            for (int n = 0; n < 2; ++n) bv[bj][n] = bias ? *(const f32x4*)(bias + bcol0 + bj * HALF + 4 * n) : (f32x4){0.f, 0.f, 0.f, 0.f};
#pragma unroll
        for (int ai = 0; ai < 2; ++ai)
#pragma unroll
            for (int m = 0; m < 4; ++m) { bf16_t* rowp = base + (size_t)(row0 + ai * HALF + m * 16) * ldc + col0;
#pragma unroll
                for (int bj = 0; bj < 2; ++bj) { f32x4 v0 = acc[ai][bj][m][0] + bv[bj][0], v1 = acc[ai][bj][m][1] + bv[bj][1];
                    if (ACT == 1) { v0 = __builtin_elementwise_max(v0, (f32x4){0.f, 0.f, 0.f, 0.f}); v1 = __builtin_elementwise_max(v1, (f32x4){0.f, 0.f, 0.f, 0.f}); v0 = v0 * v0; v1 = v1 * v1; }
                    v0 = v0 * sc; v1 = v1 * sc; u32x4 w; w.x = cvt_pk_bf16(v0[0], v0[1]); w.y = cvt_pk_bf16(v0[2], v0[3]); w.z = cvt_pk_bf16(v1[0], v1[1]); w.w = cvt_pk_bf16(v1[2], v1[3]);
                    *(u32x4*)(rowp + bj * HALF) = w; } }
    }
};

template <class Epi, class Sched, bool ALIGN_EPI = false, bool SP2 = false>
__device__ __forceinline__ void gemm_phase(PG8_LAS unsigned char* lds, const Gemm g, const Sched& S, const Epi& E) {
    const int tid = threadIdx.x, wid = __builtin_amdgcn_readfirstlane(tid >> 6), lane = tid & 63, wr = wid >> 2, wc = wid & 3, fr = lane & 15, fq = lane >> 4;
    const int K = g.K, nt = K / BK;
    unsigned voffA[2], voffB[2];
#pragma unroll
    for (int i = 0; i < 2; ++i) { int R, C; stage_rc(tid * 16 + i * 8192, R, C); const int Rb = Epi::PERM ? ((R & ~31) + perm32(R & 31)) : R;
        voffA[i] = (unsigned)(R * g.lda + C) * 2u; voffB[i] = (unsigned)(Rb * K + C) * 2u; }
    const size_t kstep = (size_t)(BK * 2);
    const size_t hstep = (size_t)HALF * K * 2;
    const size_t tstep = 2 * hstep; const size_t hstepA = (size_t)HALF * g.lda * 2, tstepA = 2 * hstepA;
    const unsigned ldsw = (unsigned)wid * 1024u;
    const int aoff = lds_byte(wr * 64 + fr, fq * 8), boff = lds_byte(wc * 32 + fr, fq * 8);
#define PG8_SA(b, h) (((b) * 2 + (h)) * HTB)
#define PG8_SB(b, h) ((4 + (b) * 2 + (h)) * HTB)
#define PG8_STAGE(bufoff, gbase, voff) do { _Pragma("unroll") for (int _i = 0; _i < 2; ++_i) \
        __builtin_amdgcn_global_load_lds((const unsigned*)((const char*)(gbase) + (voff)[_i]), (PG8_LAS unsigned*)(lds + (bufoff) + ldsw + _i * 8192), 16, 0, 0); } while (0)
#define PG8_LDA(dst, b, h) do { _Pragma("unroll") for (int m = 0; m < 4; ++m) _Pragma("unroll") for (int k = 0; k < 2; ++k) dst[m][k] = *(const PG8_LAS bf16x8*)(lds + PG8_SA(b, h) + aoff + m * 2048 + k * 1024); } while (0)
#define PG8_LDB(dst, b, h) do { _Pragma("unroll") for (int n = 0; n < 2; ++n) _Pragma("unroll") for (int k = 0; k < 2; ++k) dst[n][k] = *(const PG8_LAS bf16x8*)(lds + PG8_SB(b, h) + boff + n * 2048 + k * 1024); } while (0)
#define PG8_MMA(ai, bj, At, Bt) do { __builtin_amdgcn_s_setprio(1); _Pragma("unroll") for (int m = 0; m < 4; ++m) _Pragma("unroll") for (int n = 0; n < 2; ++n) _Pragma("unroll") for (int k = 0; k < 2; ++k) \
        acc[ai][bj][m][n] = __builtin_amdgcn_mfma_f32_16x16x32_bf16(Bt[n][k], At[m][k], acc[ai][bj][m][n], 0, 0, 0); __builtin_amdgcn_s_setprio(0); } while (0)
#define PG8_WAIT_V(n) asm volatile("s_waitcnt vmcnt(" #n ")" ::: "memory")
#define PG8_WAIT_L(n) asm volatile("s_waitcnt lgkmcnt(" #n ")" ::: "memory")
#define PG8_BAR __builtin_amdgcn_s_barrier()
#define PG8_SCHED __builtin_amdgcn_sched_barrier(0)
    Unit cur, nxt; int ui = 0;
    if (!S.next(0, cur)) return;
    f32x4 acc[2][2][4][2];
#pragma unroll
    for (int a = 0; a < 2; ++a)
#pragma unroll
        for (int b = 0; b < 2; ++b)
#pragma unroll
            for (int m = 0; m < 4; ++m)
#pragma unroll
                for (int n = 0; n < 2; ++n) acc[a][b][m][n] = (f32x4){0.f, 0.f, 0.f, 0.f};
    bf16x8 At[4][2], B0[2][2], B1[2][2];
    const char* cA = (const char*)g.A + (size_t)cur.pm * tstepA; const char* cB = (const char*)g.Bt + (size_t)cur.pn * tstep;
    S.a_ready(cur);
    if constexpr (SP2) {
        PG8_STAGE(PG8_SB(0, 0), cB, voffB); PG8_STAGE(PG8_SB(0, 1), cB + hstep, voffB); PG8_STAGE(PG8_SA(0, 0), cA, voffA); PG8_STAGE(PG8_SA(0, 1), cA + hstepA, voffA);
        if (wr == 1) PG8_BAR;
        PG8_WAIT_V(2); PG8_BAR;
        PG8_STAGE(PG8_SB(1, 0), cB + kstep, voffB); PG8_STAGE(PG8_SA(1, 0), cA + kstep, voffA); PG8_STAGE(PG8_SB(1, 1), cB + hstep + kstep, voffB);
        PG8_WAIT_V(6); PG8_BAR;
    } else {
        PG8_STAGE(PG8_SB(0, 0), cB, voffB); PG8_STAGE(PG8_SA(0, 0), cA, voffA); PG8_STAGE(PG8_SB(0, 1), cB + hstep, voffB); PG8_STAGE(PG8_SA(0, 1), cA + hstepA, voffA);
        if (wr == 1) PG8_BAR;
        PG8_WAIT_V(4); PG8_BAR;
        PG8_STAGE(PG8_SB(1, 0), cB + kstep, voffB); PG8_STAGE(PG8_SA(1, 0), cA + kstep, voffA); PG8_STAGE(PG8_SB(1, 1), cB + hstep + kstep, voffB);
        PG8_WAIT_V(6); PG8_BAR;
    }
    for (;;) {
        const bool has_next = S.next(ui + 1, nxt);
        const char* nA = has_next ? (const char*)g.A + (size_t)nxt.pm * tstepA : cA; const char* nB = has_next ? (const char*)g.Bt + (size_t)nxt.pn * tstep : cB;
        for (int t = 0; t < nt; t += 2) {
            const bool last = (t == nt - 2);
            const char* a1 = cA + (size_t)(t + 1) * kstep;
            const char* a2 = last ? nA : cA + (size_t)(t + 2) * kstep; const char* b2 = last ? nB : cB + (size_t)(t + 2) * kstep;
            const char* a3 = a2 + kstep; const char* b3 = b2 + kstep;
            if (last && has_next) S.a_ready(nxt);
            if constexpr (SP2) {
            PG8_LDB(B0, 0, 0); PG8_LDB(B1, 0, 1); PG8_SCHED; PG8_LDA(At, 0, 0); PG8_STAGE(PG8_SA(1, 1), a1 + hstepA, voffA);
            PG8_WAIT_V(8); PG8_WAIT_L(0); PG8_BAR; PG8_MMA(0, 0, At, B0); PG8_MMA(0, 1, At, B1); PG8_BAR; PG8_SCHED;
            PG8_LDA(At, 0, 1); PG8_STAGE(PG8_SB(0, 0), b2, voffB); PG8_STAGE(PG8_SB(0, 1), b2 + hstep, voffB); PG8_STAGE(PG8_SA(0, 0), a2, voffA);
            PG8_WAIT_V(8); PG8_WAIT_L(0); PG8_BAR; PG8_MMA(1, 0, At, B0); PG8_MMA(1, 1, At, B1); PG8_BAR; PG8_SCHED;
            PG8_LDB(B0, 1, 0); PG8_LDB(B1, 1, 1); PG8_SCHED; PG8_LDA(At, 1, 0); PG8_STAGE(PG8_SA(0, 1), a2 + hstepA, voffA);
            PG8_WAIT_V(8); PG8_WAIT_L(0); PG8_BAR; PG8_MMA(0, 0, At, B0); PG8_MMA(0, 1, At, B1); PG8_BAR; PG8_SCHED;
            PG8_LDA(At, 1, 1); PG8_STAGE(PG8_SB(1, 0), b3, voffB); PG8_STAGE(PG8_SB(1, 1), b3 + hstep, voffB); PG8_STAGE(PG8_SA(1, 0), a3, voffA);
            PG8_WAIT_V(8); PG8_WAIT_L(0); PG8_BAR; PG8_MMA(1, 0, At, B0); PG8_MMA(1, 1, At, B1); PG8_BAR; PG8_SCHED;
            } else {
            PG8_LDB(B0, 0, 0); PG8_SCHED; PG8_LDA(At, 0, 0); PG8_STAGE(PG8_SA(1, 1), a1 + hstepA, voffA);
            PG8_WAIT_L(8); PG8_BAR; PG8_WAIT_L(0); PG8_MMA(0, 0, At, B0); PG8_BAR; PG8_SCHED;
            PG8_LDB(B1, 0, 1); PG8_STAGE(PG8_SB(0, 0), b2, voffB);
            PG8_BAR; PG8_WAIT_L(0); PG8_MMA(0, 1, At, B1); PG8_BAR;
            PG8_LDA(At, 0, 1); PG8_STAGE(PG8_SA(0, 0), a2, voffA);
            PG8_BAR; PG8_WAIT_L(0); PG8_MMA(1, 0, At, B0); PG8_BAR; PG8_SCHED;
            PG8_STAGE(PG8_SB(0, 1), b2 + hstep, voffB);
            PG8_WAIT_V(6); PG8_BAR; PG8_MMA(1, 1, At, B1); PG8_BAR;
            PG8_LDB(B0, 1, 0); PG8_SCHED; PG8_LDA(At, 1, 0); PG8_STAGE(PG8_SA(0, 1), a2 + hstepA, voffA);
            PG8_WAIT_L(8); PG8_BAR; PG8_WAIT_L(0); PG8_MMA(0, 0, At, B0); PG8_BAR; PG8_SCHED;
            PG8_LDB(B1, 1, 1); PG8_STAGE(PG8_SB(1, 0), b3, voffB);
            PG8_BAR; PG8_WAIT_L(0); PG8_MMA(0, 1, At, B1); PG8_BAR;
            PG8_LDA(At, 1, 1); PG8_STAGE(PG8_SA(1, 0), a3, voffA);
            PG8_BAR; PG8_WAIT_L(0); PG8_MMA(1, 0, At, B0); PG8_BAR; PG8_SCHED;
            PG8_STAGE(PG8_SB(1, 1), b3 + hstep, voffB);
            PG8_WAIT_V(6); PG8_BAR; PG8_MMA(1, 1, At, B1); PG8_BAR;
            }
        }
        if constexpr (ALIGN_EPI) { if (wr == 0) PG8_BAR; }
        if constexpr (!Epi::AFTER_DRAIN) { E(acc, cur, wr, wc, fr, fq); S.done(cur); }
        if (!has_next) break;
#pragma unroll
        for (int a = 0; a < 2; ++a)
#pragma unroll
            for (int b = 0; b < 2; ++b)
#pragma unroll
                for (int m = 0; m < 4; ++m)
#pragma unroll
                    for (int n = 0; n < 2; ++n) acc[a][b][m][n] = (f32x4){0.f, 0.f, 0.f, 0.f};
        cur = nxt; cA = nA; cB = nB; ++ui;
        if constexpr (ALIGN_EPI) { if (wr == 1) PG8_BAR; }
    }
    PG8_WAIT_V(0);
    if constexpr (!ALIGN_EPI) { if (wr == 0) PG8_BAR; }
    PG8_BAR;
    if constexpr (Epi::AFTER_DRAIN) { E.fused(acc, cur, wr, wc, fr, fq, lds, wid, lane); S.done(cur); }
#undef PG8_SA
#undef PG8_SB
#undef PG8_STAGE
#undef PG8_LDA
#undef PG8_LDB
#undef PG8_MMA
#undef PG8_WAIT_V
#undef PG8_WAIT_L
#undef PG8_BAR
#undef PG8_SCHED
}
}

#define DI __device__ __forceinline__
#define LAS __attribute__((address_space(3)))
typedef unsigned short bf16;
typedef float f32x2 __attribute__((ext_vector_type(2)));
typedef float f32x4 __attribute__((ext_vector_type(4)));
typedef float f32x16 __attribute__((ext_vector_type(16)));
typedef short bf16x8 __attribute__((ext_vector_type(8)));
typedef unsigned u32x2 __attribute__((ext_vector_type(2)));
typedef unsigned u32x4 __attribute__((ext_vector_type(4)));
typedef __bf16 bfv2 __attribute__((ext_vector_type(2)));

constexpr int NWAVES = 8, NTHR = 512;
constexpr int DM = 1024, NB = 4, SEQ = 8192, CTXL = 256, HID = 4096;
constexpr int ML = NB * SEQ, MC = NB * CTXL, MT = ML + MC;
constexpr int PP = 2816;
constexpr int RWC = 768;
constexpr int NPOS = CTXL + SEQ;
constexpr size_t MiB = 1u << 20;
constexpr size_t WS_BAR = 3 * MiB, WS_BAR_BYTES = 16384;
constexpr size_t WS_MOD = 0, WS_W2T = 256 * 1024, WS_A2T = 384 * 1024, WS_G2T = 512 * 1024, WS_BC = 1 * MiB;
constexpr size_t WS_CC = 4 * MiB;
constexpr size_t WS_WINT = 4 * MiB, WS_WOUTT = 10 * MiB, WS_P = 12 * MiB, WS_KP = 194 * MiB, WS_VT = 203 * MiB;
constexpr size_t WS_SH = 212 * MiB, WS_SD0 = 311 * MiB, WS_SD1 = 410 * MiB, WS_A0 = 212 * MiB;
constexpr size_t WS_W1T0 = 340 * MiB, WS_W2T0 = 348 * MiB, WS_W1T1 = 356 * MiB, WS_W2T1 = 364 * MiB, WS_CINT = 372 * MiB, WS_COUTT = 378 * MiB;
constexpr size_t WS_XLB = 268 * MiB;
constexpr size_t WS_YL = 380 * MiB, WS_A1 = 444 * MiB, WS_H = 12 * MiB, WS_G = 12 * MiB, WS_Z = 204 * MiB, WS_END = 509 * MiB;
constexpr int LDS_BYTES = 147456;
constexpr float LOG2E = 1.4426950408889634f;

struct Params {
    const float *x, *c, *ctx, *c_ctx, *mod_w, *mod_b, *norm_g, *mlp_w1, *mlp_w2, *ab_w_in, *ab_w_out, *att_sink;
    const float *rwkv_mu, *rwkv_w0, *rwkv_w2, *rwkv_a0, *rwkv_a2, *rwkv_g2, *rwkv_kk, *rwkv_ka, *rwkv_rk, *rwkv_ln_w, *rwkv_ln_b;
    const float *conv_w_in, *conv_w, *conv_w_out;
    float* out; unsigned char* ws;
    int ph_lo, ph_hi;
};

DI float bf_lo(unsigned p) { return __uint_as_float(p << 16); }
DI float bf_hi(unsigned p) { return __uint_as_float(p & 0xffff0000u); }
DI float bf1(bf16 v) { return __uint_as_float((unsigned)v << 16); }
DI unsigned pk2(float lo, float hi) { f32x2 v = {lo, hi}; bfv2 r = __builtin_convertvector(v, bfv2); return __builtin_bit_cast(unsigned, r); }
DI float wave_sum(float v) {
#pragma unroll
    for (int o = 1; o < 64; o <<= 1) v += __shfl_xor(v, o);
    return v;
}
#define DPP_ADD(x, ctrl) x += __builtin_bit_cast(float, __builtin_amdgcn_update_dpp(0, __builtin_bit_cast(int, x), ctrl, 0xf, 0xf, true))
DI float rowsum16(float x) { DPP_ADD(x, 0xB1); DPP_ADD(x, 0x4E); DPP_ADD(x, 0x141); DPP_ADD(x, 0x140); return x; }
DI float sigmoidf_(float z) { return __builtin_amdgcn_rcpf(1.0f + __expf(-z)); }
DI float tanhf_(float z) { const float e = __expf(-2.0f * fabsf(z)); const float t = (1.0f - e) * __builtin_amdgcn_rcpf(1.0f + e); return z < 0.f ? -t : t; }

DI void transpose_item(const float* W, int K, int N, bf16* WT, LAS float* scr, int item, int lane) {
    const int nblk = N / 32, kb = item / nblk, nb = item % nblk, k0 = 64 * kb, n0 = 32 * nb;
#pragma unroll 8
    for (int i = 0; i < 32; ++i) { const int kk = 2 * i + (lane >> 5); scr[kk * 33 + (lane & 31)] = W[(size_t)(k0 + kk) * N + n0 + (lane & 31)]; }
    asm volatile("s_waitcnt lgkmcnt(0)" ::: "memory");
    const int c = lane & 7;
#pragma unroll
    for (int j = 0; j < 4; ++j) { const int n = (lane >> 3) + 8 * j; const LAS float* s = scr + (8 * c) * 33 + n;
        u32x4 o; o.x = pk2(s[0 * 33], s[1 * 33]); o.y = pk2(s[2 * 33], s[3 * 33]); o.z = pk2(s[4 * 33], s[5 * 33]); o.w = pk2(s[6 * 33], s[7 * 33]);
        *(u32x4*)(WT + (size_t)(n0 + n) * K + k0 + 8 * c) = o; }
    asm volatile("s_waitcnt lgkmcnt(0)" ::: "memory");
}
DI void transpose_load(const float* W, int N, int item, int lane, float (&t)[32]) {
    const int nblk = N / 32, kb = item / nblk, nb = item % nblk, k0 = 64 * kb, n0 = 32 * nb;
#pragma unroll
    for (int i = 0; i < 32; ++i) t[i] = W[(size_t)(k0 + 2 * i + (lane >> 5)) * N + n0 + (lane & 31)];
}
DI void transpose_store(int K, int N, bf16* WT, LAS float* scr, int item, int lane, const float (&t)[32]) {
    const int nblk = N / 32, kb = item / nblk, nb = item % nblk, k0 = 64 * kb, n0 = 32 * nb;
#pragma unroll
    for (int i = 0; i < 32; ++i) scr[(2 * i + (lane >> 5)) * 33 + (lane & 31)] = t[i];
    asm volatile("s_waitcnt lgkmcnt(0)" ::: "memory");
    const int c = lane & 7;
#pragma unroll
    for (int j = 0; j < 4; ++j) { const int n = (lane >> 3) + 8 * j; const LAS float* s = scr + (8 * c) * 33 + n;
        u32x4 o; o.x = pk2(s[0 * 33], s[1 * 33]); o.y = pk2(s[2 * 33], s[3 * 33]); o.z = pk2(s[4 * 33], s[5 * 33]); o.w = pk2(s[6 * 33], s[7 * 33]);
        *(u32x4*)(WT + (size_t)(n0 + n) * K + k0 + 8 * c) = o; }
    asm volatile("s_waitcnt lgkmcnt(0)" ::: "memory");
}
DI void transpose_all(const float* W, int K, int N, bf16* WT, LAS float* scr, int gw, int ngw, int lane) {
    const int items = (K / 64) * (N / 32);
    for (int it = gw; it < items; it += 2 * ngw) {
        float ta[32], tb[32]; const bool two = it + ngw < items;
        transpose_load(W, N, it, lane, ta); if (two) transpose_load(W, N, it + ngw, lane, tb);
        transpose_store(K, N, WT, scr, it, lane, ta); if (two) transpose_store(K, N, WT, scr, it + ngw, lane, tb);
    }
}

DI void phase_prologue(const Params& p, LAS unsigned char* lds, int tid, int wave, int lane, int vcu, int G) {
    LAS float* sv = (LAS float*)lds;
    LAS float* part = (LAS float*)(lds + 20480);
    for (int i = tid; i < 5 * DM; i += NTHR) { const int v = i >> 10, k = i & 1023; const float cv = v < 4 ? p.c[v * DM + k] : p.c_ctx[k]; sv[i] = cv * __builtin_amdgcn_rcpf(1.0f + __expf(-cv)); }
    __syncthreads();
    float* mod = (float*)(p.ws + WS_MOD);
    for (int u = vcu; u < 192; u += G) {
        const int l = u / 96, n0 = (u % 96) * 64;
        const float* W = p.mod_w + (size_t)l * DM * 6144 + n0 + lane;
        float acc[5] = {0.f, 0.f, 0.f, 0.f, 0.f};
#pragma unroll 8
        for (int k = wave * 128; k < wave * 128 + 128; ++k) { const float w = W[(size_t)k * 6144];
#pragma unroll
            for (int v = 0; v < 5; ++v) acc[v] += sv[v * DM + k] * w; }
#pragma unroll
        for (int v = 0; v < 5; ++v) part[(wave * 5 + v) * 64 + lane] = acc[v];
        __syncthreads();
        if (tid < 320) { const int v = tid >> 6, n = tid & 63; float s = p.mod_b[l * 6144 + n0 + n];
#pragma unroll
            for (int w = 0; w < 8; ++w) s += part[(w * 5 + v) * 64 + n];
            mod[(l * 5 + v) * 6144 + n0 + n] = s; }
        __syncthreads();
    }
    __syncthreads();
    LAS float* scr = (LAS float*)(lds + wave * 16384);
    const int gw = vcu * NWAVES + wave, ngw = G * NWAVES;
    transpose_all(p.ab_w_in, DM, 2688, (bf16*)(p.ws + WS_WINT), scr, gw, ngw, lane);
    transpose_all(p.ab_w_out, DM, DM, (bf16*)(p.ws + WS_WOUTT), scr, gw, ngw, lane);
    for (int d = 0; d < 2; ++d) {
        transpose_all(p.rwkv_w2 + d * 64 * 512, 64, 512, (bf16*)(p.ws + WS_W2T) + d * 512 * 64, scr, gw, ngw, lane);
        transpose_all(p.rwkv_a2 + d * 64 * 512, 64, 512, (bf16*)(p.ws + WS_A2T) + d * 512 * 64, scr, gw, ngw, lane);
    }
    transpose_all(p.rwkv_g2, 128, 512, (bf16*)(p.ws + WS_G2T), scr, gw, ngw, lane);
    { u32x4* z = (u32x4*)((bf16*)(p.ws + WS_WINT) + (size_t)2688 * DM); const int n16 = 128 * DM * 2 / 16;
      for (int i = gw * 64 + lane; i < n16; i += ngw * 64) z[i] = (u32x4){0u, 0u, 0u, 0u}; }
}
DI void phase_weights2(const Params& p, LAS unsigned char* lds, int wave, int lane, int vcu, int G) {
    LAS float* scr = (LAS float*)(lds + wave * 16384);
    const int gw = vcu * NWAVES + wave, ngw = G * NWAVES;
    transpose_all(p.mlp_w1, DM, HID, (bf16*)(p.ws + WS_W1T0), scr, gw, ngw, lane);
    transpose_all(p.mlp_w2, HID, DM, (bf16*)(p.ws + WS_W2T0), scr, gw, ngw, lane);
    transpose_all(p.mlp_w1 + (size_t)DM * HID, DM, HID, (bf16*)(p.ws + WS_W1T1), scr, gw, ngw, lane);
    transpose_all(p.mlp_w2 + (size_t)DM * HID, HID, DM, (bf16*)(p.ws + WS_W2T1), scr, gw, ngw, lane);
    transpose_all(p.conv_w_in, DM, 3 * DM, (bf16*)(p.ws + WS_CINT), scr, gw, ngw, lane);
    transpose_all(p.conv_w_out, DM, DM, (bf16*)(p.ws + WS_COUTT), scr, gw, ngw, lane);
}

DI void store_row_bf16(bf16* orow, int lane, const f32x4 (&v)[4]) {
    unsigned long long* o8 = (unsigned long long*)orow + lane;
#pragma unroll
    for (int j = 0; j < 4; ++j) o8[64 * j] = (unsigned long long)pk2(v[j].x, v[j].y) | ((unsigned long long)pk2(v[j].z, v[j].w) << 32);
}
DI float wave_sum2(float v) { v = rowsum16(v); v += __shfl_xor(v, 16); v += __shfl_xor(v, 32); return v; }
DI void phase_norm0(const Params& p, int wave, int lane, int vcu, int G) {
    constexpr int NR = 4;
    const int gw = vcu * NWAVES + wave, ngw = G * NWAVES;
    const float* mod = (const float*)(p.ws + WS_MOD);
    bf16* A0 = (bf16*)(p.ws + WS_A0);
    for (int row0 = gw; row0 < MT; row0 += NR * ngw) {
        f32x4 xv[NR][4]; float ss[NR]; int rows[NR];
#pragma unroll
        for (int q = 0; q < NR; ++q) { int row = row0 + q * ngw; if (row >= MT) row = row0; rows[q] = row; ss[q] = 0.f;
            const float* xr = row < ML ? p.x + (size_t)row * DM : p.ctx + (size_t)(row - ML) * DM;
#pragma unroll
            for (int j = 0; j < 4; ++j) xv[q][j] = __builtin_nontemporal_load((const f32x4*)xr + lane + 64 * j); }
#pragma unroll
        for (int q = 0; q < NR; ++q) {
#pragma unroll
            for (int j = 0; j < 4; ++j) ss[q] += (xv[q][j].x * xv[q][j].x + xv[q][j].y * xv[q][j].y) + (xv[q][j].z * xv[q][j].z + xv[q][j].w * xv[q][j].w); }
#pragma unroll
        for (int q = 0; q < NR; ++q) {
            if (row0 + q * ngw >= MT) break;
            const int row = rows[q], v = row < ML ? row / SEQ : 4;
            const float* sh = mod + v * 6144, *sc = sh + 1024;
            const float rs = rsqrtf(wave_sum2(ss[q]) * (1.0f / DM) + 1e-6f);
#pragma unroll
            for (int j = 0; j < 4; ++j) { const f32x4 g = *((const f32x4*)p.norm_g + lane + 64 * j), s1 = *((const f32x4*)sc + lane + 64 * j), s0 = *((const f32x4*)sh + lane + 64 * j);
                xv[q][j] = (xv[q][j] * rs) * g * (s1 + 1.0f) + s0; }
            store_row_bf16(A0 + (size_t)row * DM, lane, xv[q]);
        }
    }
}
template <bool XIN_BF, bool XOUT_BF>
DI void phase_norm1(const bf16* Y, const void* xin_, void* xout_, const float* gA, const float* modl, int gt_off, const float* gB, int sh_off, int sc_off, bf16* aout,
                    int wave, int lane, int vcu, int G) {
    constexpr int NR = 4;
    const int gw = vcu * NWAVES + wave, ngw = G * NWAVES;
    for (int row0 = gw; row0 < ML; row0 += NR * ngw) {
        f32x4 yv[NR][4], xv[NR][4]; int rows[NR]; float ss[NR];
#pragma unroll
        for (int q = 0; q < NR; ++q) ss[q] = 0.f;
#pragma unroll
        for (int q = 0; q < NR; ++q) { int row = row0 + q * ngw; if (row >= ML) row = row0; rows[q] = row;
#pragma unroll
            for (int j = 0; j < 4; ++j) { const u32x2 w = __builtin_nontemporal_load((const u32x2*)(Y + (size_t)row * DM) + lane + 64 * j); yv[q][j] = (f32x4){bf_lo(w.x), bf_hi(w.x), bf_lo(w.y), bf_hi(w.y)};
                if (XIN_BF) { const u32x2 xw = __builtin_nontemporal_load((const u32x2*)((const bf16*)xin_ + (size_t)row * DM) + lane + 64 * j); xv[q][j] = (f32x4){bf_lo(xw.x), bf_hi(xw.x), bf_lo(xw.y), bf_hi(xw.y)}; }
                else xv[q][j] = __builtin_nontemporal_load((const f32x4*)((const float*)xin_ + (size_t)row * DM) + lane + 64 * j); } }
#pragma unroll
        for (int q = 0; q < NR; ++q)
#pragma unroll
            for (int j = 0; j < 4; ++j) ss[q] += (yv[q][j].x * yv[q][j].x + yv[q][j].y * yv[q][j].y) + (yv[q][j].z * yv[q][j].z + yv[q][j].w * yv[q][j].w);
        float rs[NR], s2[NR];
#pragma unroll
        for (int q = 0; q < NR; ++q) s2[q] = 0.f;
#pragma unroll
        for (int q = 0; q < NR; ++q) rs[q] = rsqrtf(wave_sum2(ss[q]) * (1.0f / DM) + 1e-6f);
#pragma unroll
        for (int q = 0; q < NR; ++q) { const float* mv = modl + (rows[q] / SEQ) * 6144;
            if (row0 + q * ngw >= ML) break;
#pragma unroll
            for (int j = 0; j < 4; ++j) { const f32x4 g = *((const f32x4*)gA + lane + 64 * j), gt = *((const f32x4*)(mv + gt_off) + lane + 64 * j);
                xv[q][j] = xv[q][j] + gt * ((yv[q][j] * rs[q]) * g);
                if (XOUT_BF) { u32x2 w; w.x = pk2(xv[q][j].x, xv[q][j].y); w.y = pk2(xv[q][j].z, xv[q][j].w); __builtin_nontemporal_store(w, (u32x2*)((bf16*)xout_ + (size_t)rows[q] * DM) + lane + 64 * j); }
                else __builtin_nontemporal_store(xv[q][j], (f32x4*)((float*)xout_ + (size_t)rows[q] * DM) + lane + 64 * j);
                s2[q] += (xv[q][j].x * xv[q][j].x + xv[q][j].y * xv[q][j].y) + (xv[q][j].z * xv[q][j].z + xv[q][j].w * xv[q][j].w); } }
        if (aout) {
            float r2[NR];
#pragma unroll
            for (int q = 0; q < NR; ++q) r2[q] = rsqrtf(wave_sum2(s2[q]) * (1.0f / DM) + 1e-6f);
#pragma unroll
            for (int q = 0; q < NR; ++q) { const float* mv = modl + (rows[q] / SEQ) * 6144;
                if (row0 + q * ngw >= ML) break;
#pragma unroll
                for (int j = 0; j < 4; ++j) { const f32x4 g = *((const f32x4*)gB + lane + 64 * j), s1 = *((const f32x4*)(mv + sc_off) + lane + 64 * j), s0 = *((const f32x4*)(mv + sh_off) + lane + 64 * j);
                    yv[q][j] = (xv[q][j] * r2[q]) * g * (s1 + 1.0f) + s0; }
                store_row_bf16(aout + (size_t)rows[q] * DM, lane, yv[q]); }
        }
    }
}

constexpr int FP = 1936;
DI f32x4 mix4(const LAS bf16* T, int t, int col, const f32x4 mu) {
    const u32x2 pv = *(const LAS u32x2*)(T + t * FP + col), cv = *(const LAS u32x2*)(T + (t + 1) * FP + col), nv = *(const LAS u32x2*)(T + (t + 2) * FP + col);
    const f32x4 p4 = {bf_lo(pv.x), bf_hi(pv.x), bf_lo(pv.y), bf_hi(pv.y)}, c4 = {bf_lo(cv.x), bf_hi(cv.x), bf_lo(cv.y), bf_hi(cv.y)}, n4 = {bf_lo(nv.x), bf_hi(nv.x), bf_lo(nv.y), bf_hi(nv.y)};
    return c4 + mu * ((p4 + n4) * 0.5f - c4);
}
DI void st4bf(bf16* dst, const f32x4 v) { u32x2 w; w.x = pk2(v.x, v.y); w.y = pk2(v.z, v.w); *(u32x2*)dst = w; }
DI void st4bf_nt(bf16* dst, const f32x4 v) { u32x2 w; w.x = pk2(v.x, v.y); w.y = pk2(v.z, v.w); __builtin_nontemporal_store(w, (u32x2*)dst); }
DI void unpack8(const u32x4 w, float (&o)[8]) { o[0] = bf_lo(w.x); o[1] = bf_hi(w.x); o[2] = bf_lo(w.y); o[3] = bf_hi(w.y); o[4] = bf_lo(w.z); o[5] = bf_hi(w.z); o[6] = bf_lo(w.w); o[7] = bf_hi(w.w); }
DI bf16x8 pack8(const float (&v)[8]) { u32x4 w; w.x = pk2(v[0], v[1]); w.y = pk2(v[2], v[3]); w.z = pk2(v[4], v[5]); w.w = pk2(v[6], v[7]); return __builtin_bit_cast(bf16x8, w); }

DI void phase_features(const Params& p, LAS unsigned char* lds, int tid, int wave, int lane, int vcu, int G) {
    const bf16* P = (const bf16*)(p.ws + WS_P);
    LAS bf16* T = (LAS bf16*)lds;
    bf16* SH = (bf16*)(p.ws + WS_SH); bf16* SD0 = (bf16*)(p.ws + WS_SD0); bf16* SD1 = (bf16*)(p.ws + WS_SD1);
    float* BC = (float*)(p.ws + WS_BC); bf16* KP = (bf16*)(p.ws + WS_KP); bf16* VT = (bf16*)(p.ws + WS_VT);
    const bf16* W2T = (const bf16*)(p.ws + WS_W2T); const bf16* A2T = (const bf16*)(p.ws + WS_A2T);
    const int h = wave, tq = lane >> 4, cl = lane & 15, c0 = h * 64 + 4 * cl;
    for (int u = vcu; u < MT / 16; u += G) {
        const int R0 = u * 16;
        int seq0, seqlen; if (R0 < ML) { seq0 = (R0 / SEQ) * SEQ; seqlen = SEQ; } else { seq0 = ML + ((R0 - ML) / CTXL) * CTXL; seqlen = CTXL; }
        bf16x8 bw[16];
#pragma unroll
        for (int q = 0; q < 16; ++q) { const int L = q >> 3, ks = (q >> 2) & 1, nt = q & 3; bw[q] = *(const bf16x8*)(W2T + (size_t)(L & 1) * 512 * 64 + (size_t)(c0 + nt) * 64 + ks * 32 + tq * 8); }
        __syncthreads();
        for (int i = tid; i < 18 * 240; i += NTHR) { const int rr = i / 240, ch = i % 240, row = R0 - 1 + rr;
            u32x4 v = {0u, 0u, 0u, 0u}; if (row >= seq0 && row < seq0 + seqlen) v = *(const u32x4*)(P + (size_t)row * PP + RWC + ch * 8);
            *(LAS u32x4*)(T + rr * FP + ch * 8) = v; }
        __syncthreads();
        f32x4 lo[4][4];
#pragma unroll
        for (int half = 0; half < 2; ++half) {
            if (half == 1) {
#pragma unroll
                for (int q = 0; q < 16; ++q) { const int L = 2 + (q >> 3), ks = (q >> 2) & 1, nt = q & 3; bw[q] = *(const bf16x8*)(A2T + (size_t)(L & 1) * 512 * 64 + (size_t)(c0 + nt) * 64 + ks * 32 + tq * 8); }
            }
#pragma unroll
            for (int LL = 0; LL < 2; ++LL) {
                const int L = half * 2 + LL;
#pragma unroll
                for (int nt = 0; nt < 4; ++nt) lo[L][nt] = (f32x4){0.f, 0.f, 0.f, 0.f};
#pragma unroll
                for (int ks = 0; ks < 2; ++ks) {
                    const int cb = 1536 + 64 * L + ks * 32 + tq * 8, tok = lane & 15;
                    float pv[8], cv[8], nv[8], a8[8];
                    unpack8(*(const LAS u32x4*)(T + tok * FP + cb), pv); unpack8(*(const LAS u32x4*)(T + (tok + 1) * FP + cb), cv); unpack8(*(const LAS u32x4*)(T + (tok + 2) * FP + cb), nv);
                    const f32x4 m0 = *(const f32x4*)(p.rwkv_mu + cb), m1 = *(const f32x4*)(p.rwkv_mu + cb + 4);
#pragma unroll
                    for (int e = 0; e < 8; ++e) { const float mu = e < 4 ? m0[e] : m1[e - 4]; float m = cv[e] + mu * (0.5f * (pv[e] + nv[e]) - cv[e]); if (L < 2) m = tanhf_(m); a8[e] = m; }
                    const bf16x8 a = pack8(a8);
#pragma unroll
                    for (int nt = 0; nt < 4; ++nt) lo[L][nt] = __builtin_amdgcn_mfma_f32_16x16x32_bf16(a, bw[LL * 8 + ks * 4 + nt], lo[L][nt], 0, 0, 0);
                }
            }
        }
        const f32x4 mu_r = *(const f32x4*)(p.rwkv_mu + c0), mu_k = *(const f32x4*)(p.rwkv_mu + 512 + c0), mu_v = *(const f32x4*)(p.rwkv_mu + 1024 + c0);
        const f32x4 kkw = *(const f32x4*)(p.rwkv_kk + c0), kaw = *(const f32x4*)(p.rwkv_ka + c0), rkw = *(const f32x4*)(p.rwkv_rk + c0);
        const f32x4 w0f = *(const f32x4*)(p.rwkv_w0 + c0), w0b = *(const f32x4*)(p.rwkv_w0 + 512 + c0), a0f = *(const f32x4*)(p.rwkv_a0 + c0), a0b = *(const f32x4*)(p.rwkv_a0 + 512 + c0);
#pragma unroll
        for (int j = 0; j < 4; ++j) {
            const int t = 4 * tq + j, row = R0 + t;
            const f32x4 r4 = mix4(T, t, c0, mu_r), k4 = mix4(T, t, 512 + c0, mu_k), v4 = mix4(T, t, 1024 + c0, mu_v);
            const f32x4 kkv = k4 * kkw;
            const float ss = rowsum16((kkv.x * kkv.x + kkv.y * kkv.y) + (kkv.z * kkv.z + kkv.w * kkv.w));
            const f32x4 kk4 = kkv * __builtin_amdgcn_rcpf(fmaxf(__builtin_amdgcn_sqrtf(ss), 1e-12f));
            f32x4 df, db, kf, kb, bf, bb_;
#pragma unroll
            for (int i = 0; i < 4; ++i) {
                const float zf = w0f[i] + lo[0][i][j], zb = w0b[i] + lo[1][i][j];
                df[i] = __expf(-0.6065306597f * sigmoidf_(zf)); db[i] = __expf(-0.6065306597f * sigmoidf_(zb));
                const float af = sigmoidf_(a0f[i] + lo[2][i][j]), ab = sigmoidf_(a0b[i] + lo[3][i][j]);
                kf[i] = k4[i] * (1.0f + (af - 1.0f) * kaw[i]); kb[i] = k4[i] * (1.0f + (ab - 1.0f) * kaw[i]);
                bf[i] = kk4[i] * af; bb_[i] = kk4[i] * ab;
            }
            const f32x4 bt = r4 * (kf + kb) * rkw;
            const float bonus = rowsum16((bt.x + bt.y) + (bt.z + bt.w));
            if (cl == 0) BC[row * 8 + h] = bonus;
            const size_t rec = ((size_t)row * 8 + h) * 192 + 4 * cl;
            st4bf_nt(SH + rec, r4); st4bf_nt(SH + rec + 64, v4); st4bf_nt(SH + rec + 128, -kk4);
            st4bf_nt(SD0 + rec, df); st4bf_nt(SD0 + rec + 64, kf); st4bf_nt(SD0 + rec + 128, bf);
            st4bf_nt(SD1 + rec, db); st4bf_nt(SD1 + rec + 64, kb); st4bf_nt(SD1 + rec + 128, bb_);
        }
        if (tid < 256) {
            const int t = tid >> 4, g = tid & 15, row = R0 + t, kvh = g >> 3, d0 = (g & 7) * 8;
            const bf16* src = P + (size_t)row * PP + 512 + kvh * 64;
            const bool lat = row < ML; int b_, pos, tt = 0;
            if (lat) { b_ = row / SEQ; tt = row % SEQ; pos = CTXL + tt; } else { b_ = (row - ML) / CTXL; pos = (row - ML) % CTXL; }
            u32x4 ov = *(const u32x4*)(src + d0);
            if (lat) {
                const int dd = d0 & 31; const bool first = dd < 16;
                float o8[8], q8[8], r8[8]; unpack8(ov, o8); unpack8(*(const u32x4*)(src + (first ? d0 + 16 : d0 - 16)), q8);
                const float posf = (d0 < 32) ? (float)(tt >> 6) : (float)(tt & 63);
#pragma unroll
                for (int e = 0; e < 8; ++e) { const float inv = exp2f(-(float)((dd & 15) + e) * 0.8304820237f), ang = posf * inv, sn = __sinf(ang), cs = __cosf(ang);
                    r8[e] = first ? o8[e] * cs - q8[e] * sn : o8[e] * cs + q8[e] * sn; }
                ov = __builtin_bit_cast(u32x4, pack8(r8));
            }
            *(u32x4*)(KP + ((size_t)(b_ * 2 + kvh) * NPOS + pos) * 64 + d0) = ov;
        }
        { const int t = tid & 15, dq = tid >> 4, row = R0 + t, kvh = dq >> 4, d = (dq & 15) * 4;
          int b_, pos; if (row < ML) { b_ = row / SEQ; pos = CTXL + row % SEQ; } else { b_ = (row - ML) / CTXL; pos = (row - ML) % CTXL; }
          const u32x2 w = *(const u32x2*)(P + (size_t)row * PP + 640 + 4 * dq);
          bf16* dst = VT + (((size_t)(b_ * 2 + kvh) * (NPOS / 32) + (pos >> 5)) * 64 + d) * 32 + (pos & 31);
          dst[0] = (bf16)(w.x & 0xffffu); dst[32] = (bf16)(w.x >> 16); dst[64] = (bf16)(w.y & 0xffffu); dst[96] = (bf16)(w.y >> 16); }
    }
}

DI int crow(int r, int hi) { return (r & 3) + 8 * (r >> 2) + 4 * hi; }
constexpr int ATT_TASKS = 8192;
struct AttRegs { f32x16 O[2]; float m_, l_; bf16x8 qf[4], kf[4], vf[2][2]; int b, kvh, head, ql0, kb0, it_lo, it_hi; bool local; };
DI void att_setup(const Params& p, int task, int lane, AttRegs& A) {
    const bf16* Pm = (const bf16*)(p.ws + WS_P);
    const int qblk = task & 1, qsub = (task >> 1) & 1, g = (task >> 2) & 3, qb = (task >> 4) & 63; A.kvh = (task >> 10) & 1; A.b = task >> 11;
    A.head = A.kvh * 4 + g; A.ql0 = qb * 128 + qsub * 64 + qblk * 32; A.kb0 = 0; A.local = false;
    A.it_lo = A.ql0 < 128 ? (128 - A.ql0) >> 5 : 0; A.it_hi = A.ql0 + 160 > SEQ ? (SEQ - A.ql0 + 128) >> 5 : 9;
    const int r = lane & 31, hh = lane >> 5;
    const int t = A.ql0 + r; const bf16* src = Pm + (size_t)(A.b * SEQ + t) * PP + A.head * 64 + 8 * hh;
    float qv[4][8];
#pragma unroll
    for (int c = 0; c < 4; ++c) unpack8(*(const u32x4*)(src + 16 * c), qv[c]);
    const float prow = (float)(t >> 6), pcol = (float)(t & 63);
    float n0[8], n1[8], n2[8], n3[8];
#pragma unroll
    for (int e = 0; e < 8; ++e) { const float inv = exp2f(-(float)(8 * hh + e) * 0.8304820237f);
        const float a1 = prow * inv, s1 = __sinf(a1), c1 = __cosf(a1), a2 = pcol * inv, s2 = __sinf(a2), c2 = __cosf(a2); const float sc = 0.125f * LOG2E;
        n0[e] = (qv[0][e] * c1 - qv[1][e] * s1) * sc; n1[e] = (qv[1][e] * c1 + qv[0][e] * s1) * sc; n2[e] = (qv[2][e] * c2 - qv[3][e] * s2) * sc; n3[e] = (qv[3][e] * c2 + qv[2][e] * s2) * sc; }
    A.qf[0] = pack8(n0); A.qf[1] = pack8(n1); A.qf[2] = pack8(n2); A.qf[3] = pack8(n3);
    A.m_ = p.att_sink[A.head] * LOG2E; A.l_ = hh == 0 ? 1.0f : 0.0f;
#pragma unroll
    for (int dblk = 0; dblk < 2; ++dblk)
#pragma unroll
        for (int i = 0; i < 16; ++i) A.O[dblk][i] = 0.f;
}
DI void att_issue(const Params& p, int it, int lane, AttRegs& A) {
    const bf16* KP = (const bf16*)(p.ws + WS_KP); const bf16* VT = (const bf16*)(p.ws + WS_VT);
    const int r = lane & 31, hh = lane >> 5;
    int pos0; A.local = it < 9;
    if (A.local) { A.kb0 = A.ql0 - 128 + it * 32; pos0 = CTXL + A.kb0; } else pos0 = (it - 9) * 32;
    const bf16* Kb = KP + (size_t)(A.b * 2 + A.kvh) * NPOS * 64; const bf16* Vb = VT + (size_t)(A.b * 2 + A.kvh) * (NPOS / 32) * 2048;
#pragma unroll
    for (int c = 0; c < 4; ++c) A.kf[c] = *(const bf16x8*)(Kb + (size_t)(pos0 + r) * 64 + 16 * c + 8 * hh);
#pragma unroll
    for (int dblk = 0; dblk < 2; ++dblk)
#pragma unroll
        for (int s = 0; s < 2; ++s) { const u32x2* vp = (const u32x2*)(Vb + (size_t)(pos0 >> 5) * 2048 + (dblk * 32 + r) * 32 + 16 * s + 4 * hh); const u32x2 lo = vp[0], hi = vp[2];
            A.vf[dblk][s] = __builtin_bit_cast(bf16x8, (u32x4){lo.x, lo.y, hi.x, hi.y}); }
}
DI void att_compute(int lane, AttRegs& A) {
    const int r = lane & 31, hh = lane >> 5;
    const bool need_mask = A.local && !(A.kb0 >= A.ql0 - 97 && A.kb0 <= A.ql0 + 97);
    f32x16 S;
#pragma unroll
    for (int i = 0; i < 16; ++i) S[i] = 0.f;
#pragma unroll
    for (int c = 0; c < 4; ++c) S = __builtin_amdgcn_mfma_f32_32x32x16_bf16(A.kf[c], A.qf[c], S, 0, 0, 0);
    if (need_mask) { const int ql = A.ql0 + r;
#pragma unroll
        for (int i = 0; i < 16; ++i) { const int kl = A.kb0 + crow(i, hh); const int dlt = ql - kl; const bool ok = dlt <= 128 && dlt >= -128; S[i] = ok ? S[i] : -INFINITY; } }
    float tmax = S[0];
#pragma unroll
    for (int i = 1; i < 16; ++i) tmax = fmaxf(tmax, S[i]);
    tmax = fmaxf(tmax, __shfl_xor(tmax, 32));
    const float mnew = fmaxf(A.m_, tmax), alpha = __builtin_amdgcn_exp2f(A.m_ - mnew);
    A.m_ = mnew;
    float pe[16]; float ps = 0.f;
#pragma unroll
    for (int i = 0; i < 16; ++i) { pe[i] = __builtin_amdgcn_exp2f(S[i] - mnew); ps += pe[i]; }
    A.l_ = A.l_ * alpha + ps;
    if (__any(alpha != 1.0f)) {
#pragma unroll
        for (int dblk = 0; dblk < 2; ++dblk)
#pragma unroll
            for (int i = 0; i < 16; ++i) A.O[dblk][i] *= alpha; }
    bf16x8 pf[2];
#pragma unroll
    for (int s = 0; s < 2; ++s) { u32x4 w; w.x = pk2(pe[8 * s], pe[8 * s + 1]); w.y = pk2(pe[8 * s + 2], pe[8 * s + 3]); w.z = pk2(pe[8 * s + 4], pe[8 * s + 5]); w.w = pk2(pe[8 * s + 6], pe[8 * s + 7]);
        pf[s] = __builtin_bit_cast(bf16x8, w); }
#pragma unroll
    for (int dblk = 0; dblk < 2; ++dblk)
#pragma unroll
        for (int s = 0; s < 2; ++s) A.O[dblk] = __builtin_amdgcn_mfma_f32_32x32x16_bf16(A.vf[dblk][s], pf[s], A.O[dblk], 0, 0, 0);
}
DI void att_finish(const Params& p, int lane, AttRegs& A) {
    bf16* Pm = (bf16*)(p.ws + WS_P);
    const int r = lane & 31, hh = lane >> 5;
    const float lt = A.l_ + __shfl_xor(A.l_, 32), inv = __builtin_amdgcn_rcpf(lt);
    bf16* dst = Pm + (size_t)(A.b * SEQ + A.ql0 + r) * PP + A.head * 64;
#pragma unroll
    for (int dblk = 0; dblk < 2; ++dblk)
#pragma unroll
        for (int gi = 0; gi < 4; ++gi) { const f32x4 v = {A.O[dblk][4 * gi] * inv, A.O[dblk][4 * gi + 1] * inv, A.O[dblk][4 * gi + 2] * inv, A.O[dblk][4 * gi + 3] * inv};
            st4bf(dst + dblk * 32 + 8 * gi + 4 * hh, v); }
}
#define ATT_STEP(p, lane, A, a_task, a_stride, a_it, a_stage) do { if (a_task < ATT_TASKS) { \
        if (a_stage == 0) { att_setup(p, a_task, lane, A); a_it = A.it_lo; att_issue(p, a_it, lane, A); a_stage = 1; } \
        else { att_compute(lane, A); ++a_it; if (a_it == A.it_hi) a_it = 9; \
            if (a_it < 17) att_issue(p, a_it, lane, A); else { att_finish(p, lane, A); a_task += a_stride; a_stage = 0; } } } } while (0)
DI void phase_attention2(const Params& p, int wave, int lane, int vcu, int G) {
    AttRegs A; int a_task = vcu * NWAVES + wave, a_it = 0, a_stage = 0; const int a_stride = G * NWAVES;
    while (a_task < ATT_TASKS) ATT_STEP(p, lane, A, a_task, a_stride, a_it, a_stage);
}

DI int scan_row(int step, int b, int d) { if (step < CTXL) return ML + b * CTXL + (d ? CTXL - 1 - step : step); const int t = step - CTXL; return b * SEQ + (d ? SEQ - 1 - t : t); }
DI int prev_row(int row, int d, bool& none) {
    none = false;
    if (row < ML) { const int b = row / SEQ, t = row % SEQ; if (d == 0) return t > 0 ? row - 1 : ML + b * CTXL + CTXL - 1; return t < SEQ - 1 ? row + 1 : ML + b * CTXL; }
    const int j = (row - ML) % CTXL; if (d == 0) { none = j == 0; return none ? row : row - 1; } none = j == CTXL - 1; return none ? row : row + 1;
}
DI f32x4 ld4bf(const bf16* src) { const u32x2 w = *(const u32x2*)src; return (f32x4){bf_lo(w.x), bf_hi(w.x), bf_lo(w.y), bf_hi(w.y)}; }
DI float dot4(const f32x4 a, const f32x4 b) { return (a.x * b.x + a.y * b.y) + (a.z * b.z + a.w * b.w); }
DI void phase_pairs(const Params& p, int wave, int lane, int vcu, int G) {
    const bf16* SH = (const bf16*)(p.ws + WS_SH); const bf16* SD0 = (const bf16*)(p.ws + WS_SD0); const bf16* SD1 = (const bf16*)(p.ws + WS_SD1); float* CC = (float*)(p.ws + WS_CC);
    const int gw = vcu * NWAVES + wave, ngw = G * NWAVES, sub = lane >> 4, ks = (lane & 15) * 4;
    constexpr int NIT = 4;
    for (int base = gw * 4 * NIT; base < MT * 8; base += ngw * 4 * NIT) {
        f32x4 a4[NIT], kf[NIT], bf_[NIT], kb[NIT], bb[NIT]; bool nf[NIT], nb[NIT]; int it[NIT];
#pragma unroll
        for (int q = 0; q < NIT; ++q) {
            int item = base + q * 4 + sub; if (item >= MT * 8) item = MT * 8 - 1;
            it[q] = item; const int row = item >> 3, h = item & 7;
            const int pf = prev_row(row, 0, nf[q]), pb = prev_row(row, 1, nb[q]);
            a4[q] = ld4bf(SH + ((size_t)row * 8 + h) * 192 + 128 + ks);
            kf[q] = ld4bf(SD0 + ((size_t)pf * 8 + h) * 192 + 64 + ks); bf_[q] = ld4bf(SD0 + ((size_t)pf * 8 + h) * 192 + 128 + ks);
            kb[q] = ld4bf(SD1 + ((size_t)pb * 8 + h) * 192 + 64 + ks); bb[q] = ld4bf(SD1 + ((size_t)pb * 8 + h) * 192 + 128 + ks);
        }
#pragma unroll
        for (int q = 0; q < NIT; ++q) {
            float c1f = rowsum16(dot4(bf_[q], a4[q])), c2f = rowsum16(dot4(kf[q], a4[q])), c1b = rowsum16(dot4(bb[q], a4[q])), c2b = rowsum16(dot4(kb[q], a4[q]));
            if (nf[q]) { c1f = 0.f; c2f = 0.f; } if (nb[q]) { c1b = 0.f; c2b = 0.f; }
            if ((lane & 15) == 0 && base + q * 4 + sub < MT * 8) { *(f32x2*)(CC + (size_t)it[q] * 2) = (f32x2){c1f, c2f}; *(f32x2*)(CC + ((size_t)MT * 8 + it[q]) * 2) = (f32x2){c1b, c2b}; }
        }
    }
}
DI float fma_(float a, float b, float c) { float d; asm("v_fma_f32 %0, %1, %2, %3" : "=v"(d) : "v"(a), "v"(b), "v"(c)); return d; }
DI float mul_(float a, float b) { float d; asm("v_mul_f32 %0, %1, %2" : "=v"(d) : "v"(a), "v"(b)); return d; }
template <int MODE> DI void phase_scan(const Params& p, LAS unsigned char* lds, int tid, int wave, int lane, int vcu) {
    constexpr int TC = 32, STEPF = 384, BUFF = TC * STEPF, NCH = NPOS / TC;
    const int s = vcu >> 2, qr = vcu & 3, b = s >> 4, h = (s >> 1) & 7, d = s & 1;
    const bf16* SH = (const bf16*)(p.ws + WS_SH); const bf16* SD = (const bf16*)(p.ws + (d ? WS_SD1 : WS_SD0));
    bf16* Pm = (bf16*)(p.ws + WS_P);
    LAS float* buf = (LAS float*)lds;
    if (wave >= 4) {
        const int lt = tid - 256;
        u32x4 rgA[6], rgB[6];
#define SCAN_LOAD(rg, c) do { _Pragma("unroll") for (int i = 0; i < 6; ++i) { const int idx = i * 256 + lt, st = idx / 48, part = idx % 48; const int row = scan_row((c) * TC + st, b, d); \
            const bf16* src = (part < 24 ? SH : SD) + ((size_t)row * 8 + h) * 192 + (part % 24) * 8; rg[i] = *(const u32x4*)src; } } while (0)
#define SCAN_WRITE(rg, bi) do { _Pragma("unroll") for (int i = 0; i < 6; ++i) { const int idx = i * 256 + lt, st = idx / 48, part = idx % 48; LAS float* dst = buf + (bi) * BUFF + st * STEPF + part * 8; \
            *(LAS f32x4*)dst = (f32x4){bf_lo(rg[i].x), bf_hi(rg[i].x), bf_lo(rg[i].y), bf_hi(rg[i].y)}; *(LAS f32x4*)(dst + 4) = (f32x4){bf_lo(rg[i].z), bf_hi(rg[i].z), bf_lo(rg[i].w), bf_hi(rg[i].w)}; } } while (0)
        SCAN_LOAD(rgA, 0); SCAN_WRITE(rgA, 0); SCAN_LOAD(rgA, 1); SCAN_LOAD(rgB, 2);
        AttRegs A; int a_task = MODE == 0 ? vcu * 4 + (wave - 4) : ATT_TASKS, a_it = 0, a_stage = 0; const int a_stride = 1024;
        __syncthreads();
        for (int c = 0; c < NCH; c += 2) {
            if (MODE != 1 && c + 1 < NCH) { SCAN_WRITE(rgA, 1); if (c + 3 < NCH) SCAN_LOAD(rgA, c + 3); }
            ATT_STEP(p, lane, A, a_task, a_stride, a_it, a_stage);
            __syncthreads();
            if (MODE != 1 && c + 2 < NCH) { SCAN_WRITE(rgB, 0); if (c + 4 < NCH) SCAN_LOAD(rgB, c + 4); }
            ATT_STEP(p, lane, A, a_task, a_stride, a_it, a_stage);
            __syncthreads();
        }
        while (a_task < ATT_TASKS) ATT_STEP(p, lane, A, a_task, a_stride, a_it, a_stage);
#undef SCAN_LOAD
#undef SCAN_WRITE
    } else {
        const int rl = wave * 4 + (lane >> 4), vidx = qr * 16 + rl, ks = (lane & 15) * 4, l15 = lane & 15;
        f32x2 S01 = {0.f, 0.f}, S23 = {0.f, 0.f};
        __builtin_amdgcn_s_setprio(2);
        bf16* ydst = MODE ? Pm + 2688 + d * 64 + vidx : Pm + 1024 + d * 512 + h * 64 + vidx;
        __syncthreads();
        for (int c = 0; c < NCH; ++c) {
            if (MODE == 2) { __syncthreads(); continue; }
            const LAS float* cb = buf + (c & 1) * BUFF + ks;
            const LAS float* cv = buf + (c & 1) * BUFF + 64 + vidx;
            const bool emit = c >= CTXL / TC;
            f32x4 R_[2], A_[2], W_[2], K_[2], B_[2]; float V_[2];
#define SCAN_LD(sl, st) do { const LAS float* bs = cb + (st) * STEPF; R_[sl] = *(const LAS f32x4*)(bs); A_[sl] = *(const LAS f32x4*)(bs + 128); W_[sl] = *(const LAS f32x4*)(bs + 192); \
            K_[sl] = *(const LAS f32x4*)(bs + 256); B_[sl] = *(const LAS f32x4*)(bs + 320); V_[sl] = cv[(st) * STEPF]; } while (0)
            SCAN_LD(0, 0); SCAN_LD(1, 1);
            float ykeep = 0.f;
#pragma unroll
            for (int st = 0; st < TC; ++st) {
                const int sl = st & 1;
                const f32x4 r4 = R_[sl], a4 = A_[sl], w4 = W_[sl], k4 = K_[sl], b4 = B_[sl]; const float vv = V_[sl];
                if (st + 2 < TC) SCAN_LD(sl, st + 2);
                f32x2 t = S01 * (f32x2){a4.x, a4.y}; t = S23 * (f32x2){a4.z, a4.w} + t;
                const float sa = rowsum16(t.x + t.y);
                S01 = (S01 * (f32x2){w4.x, w4.y} + (f32x2){k4.x, k4.y} * vv) + (f32x2){b4.x, b4.y} * sa;
                S23 = (S23 * (f32x2){w4.z, w4.w} + (f32x2){k4.z, k4.w} * vv) + (f32x2){b4.z, b4.w} * sa;
                f32x2 yq = S01 * (f32x2){r4.x, r4.y}; yq = S23 * (f32x2){r4.z, r4.w} + yq;
                const float y = rowsum16(yq.x + yq.y);
                ykeep = (l15 == (st & 15)) ? y : ykeep;
                if ((st & 15) == 15 && emit) { const int row = scan_row(c * TC + (st - 15) + l15, b, d); ydst[(size_t)row * PP] = (bf16)(pk2(ykeep, 0.f) & 0xffffu); }
            }
#undef SCAN_LD
            __syncthreads();
        }
        __builtin_amdgcn_s_setprio(0);
    }
}

template <int DUMMY> DI void phase_attention(const Params& p, LAS unsigned char* lds, int tid, int wave, int lane, int vcu, int G) {
    bf16* Pm = (bf16*)(p.ws + WS_P); const bf16* KP = (const bf16*)(p.ws + WS_KP); const bf16* VT = (const bf16*)(p.ws + WS_VT);
    LAS unsigned char* Kl = lds;
    LAS unsigned char* Vl = lds + 55296;
    const int r = lane & 31, hh = lane >> 5, g = wave >> 1, qsub = wave & 1;
    for (int u = vcu; u < 512; u += G) {
        const int b = u >> 7, kvh = (u >> 6) & 1, qb = u & 63, head = kvh * 4 + g, qlo = qb * 128 + qsub * 64;
        bf16x8 qf[2][4];
#pragma unroll
        for (int qblk = 0; qblk < 2; ++qblk) {
            const int t = qlo + qblk * 32 + r; const bf16* src = Pm + (size_t)(b * SEQ + t) * PP + head * 64 + 8 * hh;
            float qv[4][8];
#pragma unroll
            for (int c = 0; c < 4; ++c) unpack8(*(const u32x4*)(src + 16 * c), qv[c]);
            const float prow = (float)(t >> 6), pcol = (float)(t & 63);
            float n0[8], n1[8], n2[8], n3[8];
#pragma unroll
            for (int e = 0; e < 8; ++e) { const float inv = exp2f(-(float)(8 * hh + e) * 0.8304820237f);
                const float a1 = prow * inv, s1 = __sinf(a1), c1 = __cosf(a1), a2 = pcol * inv, s2 = __sinf(a2), c2 = __cosf(a2); const float sc = 0.125f * LOG2E;
                n0[e] = (qv[0][e] * c1 - qv[1][e] * s1) * sc; n1[e] = (qv[1][e] * c1 + qv[0][e] * s1) * sc; n2[e] = (qv[2][e] * c2 - qv[3][e] * s2) * sc; n3[e] = (qv[3][e] * c2 + qv[2][e] * s2) * sc; }
            qf[qblk][0] = pack8(n0); qf[qblk][1] = pack8(n1); qf[qblk][2] = pack8(n2); qf[qblk][3] = pack8(n3);
        }
        f32x16 O[2][2]; float m_[2], l_[2];
#pragma unroll
        for (int q = 0; q < 2; ++q) { m_[q] = p.att_sink[head] * LOG2E; l_[q] = hh == 0 ? 1.0f : 0.0f;
#pragma unroll
            for (int dblk = 0; dblk < 2; ++dblk)
#pragma unroll
                for (int i = 0; i < 16; ++i) O[q][dblk][i] = 0.f; }
        for (int round = 0; round < 2; ++round) {
            const int nslots = round ? 256 : 384;
            __syncthreads();
            for (int i = tid; i < nslots * 8; i += NTHR) { const int slot = i >> 3, ch = i & 7; int pos; bool valid = true;
                if (round == 0) { const int kl = (qb - 1) * 128 + slot; valid = kl >= 0 && kl < SEQ; pos = CTXL + kl; } else pos = slot;
                u32x4 v = {0u, 0u, 0u, 0u}; if (valid) v = *(const u32x4*)(KP + ((size_t)(b * 2 + kvh) * NPOS + pos) * 64 + ch * 8);
                *(LAS u32x4*)(Kl + slot * 144 + ch * 16) = v; }
            const int nch = nslots >> 3;
            for (int i = tid; i < 64 * nch; i += NTHR) { const int dd = i / nch, ch = i % nch, slot0 = ch * 8; int pos0; bool valid = true;
                if (round == 0) { const int kl0 = (qb - 1) * 128 + slot0; valid = kl0 >= 0 && kl0 < SEQ; pos0 = CTXL + kl0; } else pos0 = slot0;
                u32x4 v = {0u, 0u, 0u, 0u}; if (valid) v = *(const u32x4*)(VT + ((size_t)(b * 2 + kvh) * 64 + dd) * NPOS + pos0);
                LAS u32x2* dst = (LAS u32x2*)(Vl + dd * 776 + slot0 * 2); dst[0] = (u32x2){v.x, v.y}; dst[1] = (u32x2){v.z, v.w}; }
            __syncthreads();
            const int tlo = round ? 0 : 2 * qsub, thi = round ? 8 : 2 * qsub + 10;
            for (int T = tlo; T < thi; ++T) {
                bf16x8 kf[4], vf[2][2];
#pragma unroll
                for (int c = 0; c < 4; ++c) kf[c] = *(const LAS bf16x8*)(Kl + (T * 32 + r) * 144 + (16 * c + 8 * hh) * 2);
#pragma unroll
                for (int dblk = 0; dblk < 2; ++dblk)
#pragma unroll
                    for (int s = 0; s < 2; ++s) { const LAS u32x2* vp = (const LAS u32x2*)(Vl + (dblk * 32 + r) * 776 + (T * 32 + 16 * s + 4 * hh) * 2); const u32x2 lo = vp[0], hi = vp[2];
                        vf[dblk][s] = __builtin_bit_cast(bf16x8, (u32x4){lo.x, lo.y, hi.x, hi.y}); }
#pragma unroll
                for (int q = 0; q < 2; ++q) {
                    f32x16 S;
#pragma unroll
                    for (int i = 0; i < 16; ++i) S[i] = 0.f;
#pragma unroll
                    for (int c = 0; c < 4; ++c) S = __builtin_amdgcn_mfma_f32_32x32x16_bf16(kf[c], qf[q][c], S, 0, 0, 0);
                    const int kb0w = (qb - 1) * 128 + T * 32;
                    const bool need_mask = round == 0 && !(kb0w >= 0 && kb0w + 31 < SEQ && kb0w >= qlo - 65 && kb0w <= qlo + 97);
                    if (need_mask) { const int ql = qlo + q * 32 + r, kb0 = kb0w;
#pragma unroll
                        for (int i = 0; i < 16; ++i) { const int kl = kb0 + crow(i, hh); const int dlt = ql - kl; const bool ok = kl >= 0 && kl < SEQ && dlt <= 128 && dlt >= -128; S[i] = ok ? S[i] : -INFINITY; } }
                    float tmax = S[0];
#pragma unroll
                    for (int i = 1; i < 16; ++i) tmax = fmaxf(tmax, S[i]);
                    tmax = fmaxf(tmax, __shfl_xor(tmax, 32));
                    const float mnew = fmaxf(m_[q], tmax), alpha = __builtin_amdgcn_exp2f(m_[q] - mnew);
                    m_[q] = mnew;
                    float pe[16]; float ps = 0.f;
#pragma unroll
                    for (int i = 0; i < 16; ++i) { pe[i] = __builtin_amdgcn_exp2f(S[i] - mnew); ps += pe[i]; }
                    l_[q] = l_[q] * alpha + ps;
                    if (__any(alpha != 1.0f)) {
#pragma unroll
                    for (int dblk = 0; dblk < 2; ++dblk)
#pragma unroll
                        for (int i = 0; i < 16; ++i) O[q][dblk][i] *= alpha; }
                    bf16x8 pf[2];
#pragma unroll
                    for (int s = 0; s < 2; ++s) { u32x4 w; w.x = pk2(pe[8 * s], pe[8 * s + 1]); w.y = pk2(pe[8 * s + 2], pe[8 * s + 3]); w.z = pk2(pe[8 * s + 4], pe[8 * s + 5]); w.w = pk2(pe[8 * s + 6], pe[8 * s + 7]);
                        pf[s] = __builtin_bit_cast(bf16x8, w); }
#pragma unroll
                    for (int dblk = 0; dblk < 2; ++dblk)
#pragma unroll
                        for (int s = 0; s < 2; ++s) O[q][dblk] = __builtin_amdgcn_mfma_f32_32x32x16_bf16(vf[dblk][s], pf[s], O[q][dblk], 0, 0, 0);
                }
            }
        }
#pragma unroll
        for (int q = 0; q < 2; ++q) {
            const float lt = l_[q] + __shfl_xor(l_[q], 32), inv = __builtin_amdgcn_rcpf(lt);
            bf16* dst = Pm + (size_t)(b * SEQ + qlo + q * 32 + r) * PP + head * 64 + (DUMMY ? 1024 : 0);
#pragma unroll
            for (int dblk = 0; dblk < 2; ++dblk)
#pragma unroll
                for (int gi = 0; gi < 4; ++gi) { const f32x4 v = {O[q][dblk][4 * gi] * inv, O[q][dblk][4 * gi + 1] * inv, O[q][dblk][4 * gi + 2] * inv, O[q][dblk][4 * gi + 3] * inv};
                    st4bf(dst + dblk * 32 + 8 * gi + 4 * hh, v); }
        }
    }
}

DI void phase_rwkv_out(const Params& p, LAS unsigned char* lds, int tid, int wave, int lane, int vcu, int G) {
    bf16* Pm = (bf16*)(p.ws + WS_P); const bf16* SH = (const bf16*)(p.ws + WS_SH); const float* BC = (const float*)(p.ws + WS_BC); const bf16* G2T = (const bf16*)(p.ws + WS_G2T);
    constexpr int GP = 136;
    LAS bf16* T = (LAS bf16*)lds;
    const int h = wave, tq = lane >> 4, cl = lane & 15, c0 = h * 64 + 4 * cl;
    const f32x4 lnw = *(const f32x4*)(p.rwkv_ln_w + c0), lnb = *(const f32x4*)(p.rwkv_ln_b + c0);
    for (int u = vcu; u < ML / 16; u += G) {
        const int R0 = u * 16, seq0 = (R0 / SEQ) * SEQ;
        bf16x8 gw_[16];
#pragma unroll
        for (int q = 0; q < 16; ++q) gw_[q] = *(const bf16x8*)(G2T + (size_t)(c0 + (q & 3)) * 128 + (q >> 2) * 32 + tq * 8);
        u32x2 yf_[4], yb_[4], vw_[4]; float bc_[4];
#pragma unroll
        for (int j = 0; j < 4; ++j) { const int row = R0 + 4 * tq + j;
            yf_[j] = *(const u32x2*)(Pm + (size_t)row * PP + 1024 + c0); yb_[j] = *(const u32x2*)(Pm + (size_t)row * PP + 1536 + c0);
            vw_[j] = *(const u32x2*)(SH + ((size_t)row * 8 + h) * 192 + 64 + 4 * cl); bc_[j] = BC[row * 8 + h]; }
        __syncthreads();
        for (int i = tid; i < 18 * 16; i += NTHR) { const int rr = i >> 4, ch = i & 15, row = R0 - 1 + rr;
            u32x4 v = {0u, 0u, 0u, 0u}; if (row >= seq0 && row < seq0 + SEQ) v = *(const u32x4*)(Pm + (size_t)row * PP + RWC + 1792 + ch * 8);
            *(LAS u32x4*)(T + rr * GP + ch * 8) = v; }
        __syncthreads();
        f32x4 gate[4];
#pragma unroll
        for (int nt = 0; nt < 4; ++nt) gate[nt] = (f32x4){0.f, 0.f, 0.f, 0.f};
#pragma unroll
        for (int ks = 0; ks < 4; ++ks) {
            const int cb = ks * 32 + tq * 8, tok = lane & 15;
            float pv[8], cv[8], nv[8], a8[8];
            unpack8(*(const LAS u32x4*)(T + tok * GP + cb), pv); unpack8(*(const LAS u32x4*)(T + (tok + 1) * GP + cb), cv); unpack8(*(const LAS u32x4*)(T + (tok + 2) * GP + cb), nv);
            const f32x4 m0 = *(const f32x4*)(p.rwkv_mu + 1792 + cb), m1 = *(const f32x4*)(p.rwkv_mu + 1792 + cb + 4);
#pragma unroll
            for (int e = 0; e < 8; ++e) { const float mu = e < 4 ? m0[e] : m1[e - 4]; a8[e] = sigmoidf_(cv[e] + mu * (0.5f * (pv[e] + nv[e]) - cv[e])); }
            const bf16x8 a = pack8(a8);
#pragma unroll
            for (int nt = 0; nt < 4; ++nt) gate[nt] = __builtin_amdgcn_mfma_f32_16x16x32_bf16(a, gw_[ks * 4 + nt], gate[nt], 0, 0, 0);
        }
#pragma unroll
        for (int j = 0; j < 4; ++j) {
            const int row = R0 + 4 * tq + j;
            const u32x2 yf = yf_[j], yb = yb_[j];
            const f32x4 y = (f32x4){bf_lo(yf.x), bf_hi(yf.x), bf_lo(yf.y), bf_hi(yf.y)} + (f32x4){bf_lo(yb.x), bf_hi(yb.x), bf_lo(yb.y), bf_hi(yb.y)};
            const float mean = rowsum16((y.x + y.y) + (y.z + y.w)) * (1.0f / 64.0f);
            const f32x4 dv = y - mean;
            const float var = rowsum16((dv.x * dv.x + dv.y * dv.y) + (dv.z * dv.z + dv.w * dv.w)) * (1.0f / 64.0f);
            const float rstd = rsqrtf(var + 64e-5f);
            const u32x2 vw = vw_[j];
            const f32x4 v4 = {bf_lo(vw.x), bf_hi(vw.x), bf_lo(vw.y), bf_hi(vw.y)};
            const float bc = bc_[j];
            const f32x4 gt = {gate[0][j], gate[1][j], gate[2][j], gate[3][j]};
            const f32x4 o = (dv * rstd * lnw + lnb + v4 * bc) * gt;
            st4bf(Pm + (size_t)row * PP + 512 + c0, o);
        }
    }
}

DI void ld8f(const bf16* src, float (&o)[8]) { unpack8(*(const u32x4*)src, o); }
DI void phase_conv(const Params& p, int wave, int lane, int vcu, int G) {
    const bf16* Gm = (const bf16*)(p.ws + WS_G); bf16* Z = (bf16*)(p.ws + WS_Z);
    const int gw = vcu * NWAVES + wave, ngw = G * NWAVES;
    for (int row = gw; row < ML; row += ngw) {
        const int t = row % SEQ;
#pragma unroll
        for (int j = 0; j < 2; ++j) {
            const int col = 8 * lane + 512 * j; const bf16* base = Gm + (size_t)row * 3072 + col;
            float gb[8], gc[8], uu[8], qp[8], qn[8], z[8];
            ld8f(base, gb); ld8f(base + 1024, gc); ld8f(base + 2048, uu);
            if (t > 0) { float a[8], c[8]; ld8f(base - 3072 + 1024, a); ld8f(base - 3072 + 2048, c);
#pragma unroll
                for (int e = 0; e < 8; ++e) qp[e] = a[e] * c[e]; } else {
#pragma unroll
                for (int e = 0; e < 8; ++e) qp[e] = 0.f; }
            if (t < SEQ - 1) { float a[8], c[8]; ld8f(base + 3072 + 1024, a); ld8f(base + 3072 + 2048, c);
#pragma unroll
                for (int e = 0; e < 8; ++e) qn[e] = a[e] * c[e]; } else {
#pragma unroll
                for (int e = 0; e < 8; ++e) qn[e] = 0.f; }
#pragma unroll
            for (int e = 0; e < 8; ++e) z[e] = gb[e] * (p.conv_w[col + e] * qp[e] + p.conv_w[1024 + col + e] * (gc[e] * uu[e]) + p.conv_w[2048 + col + e] * qn[e]);
            *(u32x4*)(Z + (size_t)row * DM + col) = __builtin_bit_cast(u32x4, pack8(z));
        }
    }
}

#define RLX_AGENT __ATOMIC_RELAXED, __HIP_MEMORY_SCOPE_AGENT
#define XB_TMO      128
#define XB_XCNT(j)  (256  + 64 * (j))
#define XB_XSUB(j)  (1280 + 64 * (j))
#define XB_XGEN(j)  (2304 + 64 * (j))
#define XB_TOP      3328
#define XB_TOPGEN   3392
#define XCD_BAR_WORDS 3456
#define XB_SPIN_CAP (1u << 18)

__device__ __forceinline__ unsigned xb_ld(unsigned* p)              { return __hip_atomic_load(p, __ATOMIC_RELAXED, __HIP_MEMORY_SCOPE_AGENT); }
__device__ __forceinline__ unsigned xb_add(unsigned* p, unsigned v) { return __hip_atomic_fetch_add(p, v, __ATOMIC_RELAXED, __HIP_MEMORY_SCOPE_AGENT); }
__device__ __forceinline__ unsigned xb_xcc_id() { return (unsigned)__builtin_amdgcn_s_getreg((3 << 11) | 20) & 0xFu; }
#define XB_SPIN(cond, bar) do { unsigned _sp = 0; while (cond) { __builtin_amdgcn_s_sleep(1); \
    if ((++_sp & 255u) == 0u) { if (xb_ld(&(bar)[XB_TMO])) break; if (_sp > XB_SPIN_CAP) { atomicAdd(&(bar)[XB_TMO], 1u); break; } } } } while (0)

struct XcdBarrier {
    unsigned* bar; unsigned x;
    volatile LAS unsigned* st;
};

__device__ __forceinline__ XcdBarrier xcd_barrier_post(unsigned* bar, volatile LAS unsigned* st) {
    XcdBarrier b; b.bar = bar; b.x = xb_xcc_id(); b.st = st;
    if (threadIdx.x == 0) (void)xb_add(&bar[XB_XCNT(b.x)], 1u);
    return b;
}
__device__ __forceinline__ void xcd_barrier_complete(unsigned* bar, unsigned x, unsigned& nloc, unsigned& nx) {
    const unsigned G = gridDim.x * gridDim.y * gridDim.z;
    unsigned sum, cnt, mine, sp = 0u;
    for (;;) {
        sum = 0u; cnt = 0u; mine = 0u;
#pragma unroll
        for (unsigned j = 0; j < 16; ++j) { const unsigned c = xb_ld(&bar[XB_XCNT(j)]); sum += c; cnt += (c > 0u) ? 1u : 0u; mine = (j == x) ? c : mine; }
        if (sum == G) break;
        __builtin_amdgcn_s_sleep(1);
        if ((++sp & 255u) == 0u) { if (xb_ld(&bar[XB_TMO])) break; if (sp > XB_SPIN_CAP) { atomicAdd(&bar[XB_TMO], 1u); break; } }
    }
    nloc = mine > 0u ? mine : 1u; nx = cnt > 0u ? cnt : 1u;
}

__device__ __forceinline__ void xcd_barrier(const XcdBarrier& b) {
    asm volatile("s_waitcnt vmcnt(0)" ::: "memory");
    __syncthreads();
    if (threadIdx.x == 0) {
        unsigned* bar = b.bar;
        __builtin_amdgcn_s_waitcnt(0);
        unsigned nloc = b.st[0], nx = b.st[1];
        if (nloc == 0u) { xcd_barrier_complete(bar, b.x, nloc, nx); b.st[0] = nloc; b.st[1] = nx; }
        const unsigned old = xb_add(&bar[XB_XSUB(b.x)], 1u);
        const unsigned gen = old / nloc;
        if (old + 1u == (gen + 1u) * nloc) {
            __builtin_amdgcn_fence(__ATOMIC_RELEASE, "agent");
            asm volatile("s_waitcnt vmcnt(0)" ::: "memory");
            const unsigned og = xb_add(&bar[XB_TOP], 1u);
            const unsigned tg = og / nx;
            if (og + 1u == (tg + 1u) * nx) xb_add(&bar[XB_TOPGEN], 1u);
            else XB_SPIN(xb_ld(&bar[XB_TOPGEN]) == tg, bar);
            __builtin_amdgcn_fence(__ATOMIC_ACQUIRE, "agent");
            xb_add(&bar[XB_XGEN(b.x)], 1u);
            asm volatile("s_waitcnt vmcnt(0)" ::: "memory");
        } else {
            XB_SPIN(xb_ld(&bar[XB_XGEN(b.x)]) == gen, bar);
            __builtin_amdgcn_fence(__ATOMIC_ACQUIRE, "agent");
            asm volatile("s_waitcnt vmcnt(0)" ::: "memory");
        }
    }
    __syncthreads();
}

constexpr int N_PHASES = 18;
constexpr int PROBE = 0;
template <int ACT>
DI void run_gemm(LAS unsigned char* lds, const bf16* A, int lda, const bf16* Bt, int M, int N, int K, bf16* O, int ldc, int G) {
    pg8::Gemm g{A, Bt, M, N, K, lda}; pg8::StaticOrder S; S.init(M, N, G, (int)blockIdx.x);
    pg8::EpiBf16<ACT> E{O, ldc, nullptr, 0, 0, 1.f};
    pg8::gemm_phase<pg8::EpiBf16<ACT>, pg8::StaticOrder, true, true>(lds, g, S, E);
}

__global__ void __launch_bounds__(NTHR, 2) mega_fwd(Params p) {
    extern __shared__ __attribute__((aligned(16))) unsigned char lds_raw[];
    LAS unsigned char* lds = (LAS unsigned char*)lds_raw;
    cg::grid_group grid = cg::this_grid();
    const int tid = threadIdx.x, lane = tid & 63, wave = __builtin_amdgcn_readfirstlane(tid >> 6);
    const int G = gridDim.x, bx = blockIdx.x, vcu = (G % 8 == 0) ? (bx % 8) * (G / 8) + bx / 8 : bx;
    unsigned char* ws = p.ws;
    volatile LAS unsigned* misc = (volatile LAS unsigned*)(lds + 131072);
    if (tid < 32) misc[tid] = 0u;
    __syncthreads();
    XcdBarrier xbar = xcd_barrier_post((unsigned*)(ws + WS_BAR), misc + 8);
    const float* mod0 = (const float*)(ws + WS_MOD); const float* mod1 = mod0 + 5 * 6144;
    const float* ng0 = p.norm_g; const float* ng1 = p.norm_g + 4 * DM;
#define IN(k) (p.ph_lo <= (k) && (k) < p.ph_hi)
#define SEAM(k) do { if (IN(k) && IN((k) + 1)) { if ((k) == 0) grid.sync(); else xcd_barrier(xbar); } } while (0)
    if (IN(0)) { phase_prologue(p, lds, tid, wave, lane, vcu, G); if (PROBE == 7) { __syncthreads(); phase_prologue(p, lds, tid, wave, lane, vcu, G); } }
    SEAM(0);
    if (IN(1)) phase_norm0(p, wave, lane, vcu, G);
    SEAM(1);
    if (IN(2)) run_gemm<0>(lds, (const bf16*)(ws + WS_A0), DM, (const bf16*)(ws + WS_WINT), MT, PP, DM, (bf16*)(ws + WS_P), PP, G);
    SEAM(2);
    if (IN(3)) { phase_features(p, lds, tid, wave, lane, vcu, G);  }
    SEAM(3);
    if (IN(4)) { if (PROBE == 8) { phase_attention<1>(p, lds, tid, wave, lane, vcu, G); __syncthreads(); }
        for (int su = vcu; su < 256; su += G) phase_scan<0>(p, lds, tid, wave, lane, su); __syncthreads(); if (PROBE == 2) { for (int su = vcu; su < 256; su += G) phase_scan<0>(p, lds, tid, wave, lane, su); __syncthreads(); }
        if (PROBE == 5) { for (int su = vcu; su < 256; su += G) phase_scan<1>(p, lds, tid, wave, lane, su); __syncthreads(); }
        if (PROBE == 6) { for (int su = vcu; su < 256; su += G) phase_scan<2>(p, lds, tid, wave, lane, su); __syncthreads(); } }
    SEAM(4);
    if (IN(5)) { phase_rwkv_out(p, lds, tid, wave, lane, vcu, G); __syncthreads(); phase_weights2(p, lds, wave, lane, vcu, G);
        if (PROBE == 9) { __syncthreads(); phase_rwkv_out(p, lds, tid, wave, lane, vcu, G); __syncthreads(); phase_weights2(p, lds, wave, lane, vcu, G); }
        if (PROBE == 3) { __syncthreads(); phase_weights2(p, lds, wave, lane, vcu, G); } if (PROBE == 4) { __syncthreads(); phase_rwkv_out(p, lds, tid, wave, lane, vcu, G); } }
    SEAM(5);
    if (IN(6)) run_gemm<0>(lds, (const bf16*)(ws + WS_P), PP, (const bf16*)(ws + WS_WOUTT), ML, DM, DM, (bf16*)(ws + WS_YL), DM, G);
    SEAM(6);
    if (IN(7)) { phase_norm1<false, true>((const bf16*)(ws + WS_YL), p.x, ws + WS_XLB, ng0 + DM, mod0, 2048, ng0 + 2 * DM, 3072, 4096, (bf16*)(ws + WS_A1), wave, lane, vcu, G);
        if (PROBE == 1) phase_norm1<false, true>((const bf16*)(ws + WS_YL), p.x, ws + WS_XLB, ng0 + DM, mod0, 2048, ng0 + 2 * DM, 3072, 4096, (bf16*)(ws + WS_A1), wave, lane, vcu, G); }
    SEAM(7);
    if (IN(8)) run_gemm<1>(lds, (const bf16*)(ws + WS_A1), DM, (const bf16*)(ws + WS_W1T0), ML, HID, DM, (bf16*)(ws + WS_H), HID, G);
    SEAM(8);
    if (IN(9)) run_gemm<0>(lds, (const bf16*)(ws + WS_H), HID, (const bf16*)(ws + WS_W2T0), ML, DM, HID, (bf16*)(ws + WS_YL), DM, G);
    SEAM(9);
    if (IN(10)) phase_norm1<true, true>((const bf16*)(ws + WS_YL), ws + WS_XLB, ws + WS_XLB, ng0 + 3 * DM, mod0, 5120, ng1, 30720, 30720 + 1024, (bf16*)(ws + WS_A1), wave, lane, vcu, G);
    SEAM(10);
    if (IN(11)) run_gemm<0>(lds, (const bf16*)(ws + WS_A1), DM, (const bf16*)(ws + WS_CINT), ML, 3 * DM, DM, (bf16*)(ws + WS_G), 3 * DM, G);
    SEAM(11);
    if (IN(12)) phase_conv(p, wave, lane, vcu, G);
    SEAM(12);
    if (IN(13)) run_gemm<0>(lds, (const bf16*)(ws + WS_Z), DM, (const bf16*)(ws + WS_COUTT), ML, DM, DM, (bf16*)(ws + WS_YL), DM, G);
    SEAM(13);
    if (IN(14)) phase_norm1<true, true>((const bf16*)(ws + WS_YL), ws + WS_XLB, ws + WS_XLB, ng1 + DM, mod1, 2048, ng1 + 2 * DM, 3072, 4096, (bf16*)(ws + WS_A1), wave, lane, vcu, G);
    SEAM(14);
    if (IN(15)) run_gemm<1>(lds, (const bf16*)(ws + WS_A1), DM, (const bf16*)(ws + WS_W1T1), ML, HID, DM, (bf16*)(ws + WS_H), HID, G);
    SEAM(15);
    if (IN(16)) run_gemm<0>(lds, (const bf16*)(ws + WS_H), HID, (const bf16*)(ws + WS_W2T1), ML, DM, HID, (bf16*)(ws + WS_YL), DM, G);
    SEAM(16);
    if (IN(17)) phase_norm1<true, false>((const bf16*)(ws + WS_YL), ws + WS_XLB, p.out, ng1 + 3 * DM, mod1, 5120, nullptr, 0, 0, nullptr, wave, lane, vcu, G);
#undef IN
#undef SEAM
}

extern "C" void kernel_launch(void* const* d_in, const int* in_sizes, int n_in, void* d_out, int out_size, void* d_ws, size_t ws_size, hipStream_t stream) {
    static int grid = 0;
    if (grid == 0) {
        if (n_in != 26 || out_size != ML * DM || ws_size < WS_END) { fprintf(stderr, "kernel_launch: unexpected shapes (n_in %d out %d ws %zu)\n", n_in, out_size, ws_size); grid = -1; return; }
        int dev = 0, cus = 0, per_cu = 0;
        (void)hipGetDevice(&dev); (void)hipDeviceGetAttribute(&cus, hipDeviceAttributeMultiprocessorCount, dev);
        if (hipFuncSetAttribute((const void*)mega_fwd, hipFuncAttributeMaxDynamicSharedMemorySize, LDS_BYTES) != hipSuccess) { fprintf(stderr, "kernel_launch: hipFuncSetAttribute failed\n"); grid = -1; return; }
        if (hipOccupancyMaxActiveBlocksPerMultiprocessor(&per_cu, (const void*)mega_fwd, NTHR, LDS_BYTES) != hipSuccess || per_cu < 1) per_cu = 1;
        (void)hipGetLastError();
        grid = cus * per_cu; if (grid > 256) grid = 256; if (grid < 1) grid = 256;
    }
    if (grid < 0) return;
    if (hipMemsetAsync((char*)d_ws + WS_BAR, 0, WS_BAR_BYTES, stream) != hipSuccess) { fprintf(stderr, "kernel_launch: memset failed\n"); return; }
    Params p{};
    const float** f = (const float**)&p;
    for (int i = 0; i < 26; ++i) f[i] = (const float*)d_in[i];
    p.out = (float*)d_out; p.ws = (unsigned char*)d_ws;
#ifndef MK_SPLIT
    p.ph_lo = 0; p.ph_hi = N_PHASES;
    void* args[] = {&p};
    hipError_t e = hipLaunchCooperativeKernel((void*)mega_fwd, dim3(grid), dim3(NTHR), args, LDS_BYTES, stream);
    if (e != hipSuccess) fprintf(stderr, "cooperative launch failed: %s (grid %d)\n", hipGetErrorString(e), grid);
#else
    for (int k = 0; k < N_PHASES; ++k) { p.ph_lo = k; p.ph_hi = k + 1; void* args[] = {&p};
        hipError_t e = hipLaunchCooperativeKernel((void*)mega_fwd, dim3(grid), dim3(NTHR), args, LDS_BYTES, stream);
        if (e != hipSuccess) { fprintf(stderr, "launch %d failed: %s\n", k, hipGetErrorString(e)); break; } }
#endif
}
```

```cpp
#include <hip/hip_runtime.h>
#include <hip/hip_cooperative_groups.h>
#include <cstdio>
#include <cstdint>
namespace cg = cooperative_groups;
namespace pg8 {
#define PG8_LAS __attribute__((address_space(3)))
typedef unsigned short bf16_t;
typedef short bf16x8 __attribute__((ext_vector_type(8)));
typedef float f32x4 __attribute__((ext_vector_type(4)));
typedef unsigned u32x4 __attribute__((ext_vector_type(4)));
constexpr int BM = 256, BK = 64, HALF = 128, HTB = HALF * BK * 2  , STAGE_BYTES = 8 * HTB, NXCD = 8, WGM = 8;

__host__ __device__ __forceinline__ int lds_byte(int r, int c) { const int st = (r >> 4) * 2 + (c >> 5), rr = r & 15, cc = c & 31, ob = rr * 64 + cc * 2; return st * 1024 + (ob ^ (((ob >> 9) & 1) << 5)); }
__host__ __device__ __forceinline__ void stage_rc(int b, int& R, int& C) { const int st = b / 1024, sb = b % 1024, swz = sb ^ (((sb >> 9) & 1) << 5); R = (st >> 1) * 16 + swz / 64; C = (st & 1) * 32 + (swz % 64) / 2; }
__host__ __device__ __forceinline__ int perm32(int rho) { const int n = rho >> 4, i = rho & 15; return 8 * (i >> 2) + 4 * n + (i & 3); }

struct Unit { int pm, pn; };
struct Gemm { const bf16_t* A; const bf16_t* Bt; int M, N, K, lda; };

struct StaticOrder {
    int nM, nN, nwg, G, c;
    __host__ __device__ void init(int M, int N, int G_, int c_) { nM = M / BM; nN = N / BM; nwg = nM * nN; G = G_; c = c_; }
    __host__ __device__ bool next(int i, Unit& u) const {
        const long L = (long)i * G + c; if (L >= nwg) return false;
        int wgid = (int)L; { const int q = nwg / NXCD, r = nwg % NXCD, xcd = wgid % NXCD, off = wgid / NXCD; wgid = (xcd < r ? xcd * (q + 1) : r * (q + 1) + (xcd - r) * q) + off; }
        const int nig = WGM * nN, gid = wgid / nig, fm = gid * WGM, gsz = (nM - fm) < WGM ? (nM - fm) : WGM;
        u.pm = fm + ((wgid % nig) % gsz); u.pn = (wgid % nig) / gsz; return true;
    }
    __device__ __forceinline__ void a_ready(const Unit&) const {}
    __device__ __forceinline__ void done(const Unit&) const {}
};

__device__ __forceinline__ unsigned cvt_pk_bf16(float lo, float hi) { unsigned r; asm volatile("v_cvt_pk_bf16_f32 %0, %1, %2" : "=v"(r) : "v"(lo), "v"(hi)); return r; }
typedef float f32x2 __attribute__((ext_vector_type(2)));
__device__ __forceinline__ f32x2 gelu_pk(f32x2 v) {
    const f32x2 av = __builtin_elementwise_abs(v), d = av * 0.2316418882f + 1.0f;
    f32x2 t; t.x = __builtin_amdgcn_rcpf(d.x); t.y = __builtin_amdgcn_rcpf(d.y);
    f32x2 q = t * 0.5307027145f + (-0.7265760135f); q = q * t + 0.7107068705f; q = q * t + (-0.142248368f); q = q * t + 0.127414796f; q = q * t;
    const f32x2 s = (v * v) * (-0.72134752044f);
    f32x2 e; e.x = __builtin_amdgcn_exp2f(s.x); e.y = __builtin_amdgcn_exp2f(s.y);
    const f32x2 m = v * (q * e), r = v - m;
    f32x2 o; o.x = v.x < 0.f ? m.x : r.x; o.y = v.y < 0.f ? m.y : r.y; return o;
}

template <int ACT  > struct EpiBf16 {
    static constexpr bool PERM = true, AFTER_DRAIN = false; static_assert(ACT == 0 || ACT == 1, "EpiBf16: ACT is 0 or 1");
    bf16_t* O; int ldc; const float* bias; int split_cols; size_t split_stride; float scale0;
    __device__ __forceinline__ void operator()(const f32x4 (&acc)[2][2][4][2], const Unit& u, int wr, int wc, int fr, int fq) const {
        const int row0 = u.pm * BM + wr * 64 + fr; int colt = u.pn * BM; bf16_t* base = O;
        float sc = 1.f; if (split_cols) { const int t = colt / split_cols; base += (size_t)t * split_stride; colt -= t * split_cols; if (t == 0) sc = scale0; }
        const int col0 = colt + wc * 32 + 8 * fq, bcol0 = u.pn * BM + wc * 32 + 8 * fq;
        f32x4 bv[2][2];
#pragma unroll
        for (int bj = 0; bj < 2; ++bj)
#pragma unroll
            for (int n = 0; n < 2; ++n) bv[bj][n] = bias ? *(const f32x4*)(bias + bcol0 + bj * HALF + 4 * n) : (f32x4){0.f, 0.f, 0.f, 0.f};
#pragma unroll
        for (int ai = 0; ai < 2; ++ai)
#pragma unroll
            for (int m = 0; m < 4; ++m) { bf16_t* rowp = base + (size_t)(row0 + ai * HALF + m * 16) * ldc + col0;
#pragma unroll
                for (int bj = 0; bj < 2; ++bj) { f32x4 v0 = acc[ai][bj][m][0] + bv[bj][0], v1 = acc[ai][bj][m][1] + bv[bj][1];
                    if (ACT == 1) { v0 = __builtin_elementwise_max(v0, (f32x4){0.f, 0.f, 0.f, 0.f}); v1 = __builtin_elementwise_max(v1, (f32x4){0.f, 0.f, 0.f, 0.f}); v0 = v0 * v0; v1 = v1 * v1; }
                    v0 = v0 * sc; v1 = v1 * sc; u32x4 w; w.x = cvt_pk_bf16(v0[0], v0[1]); w.y = cvt_pk_bf16(v0[2], v0[3]); w.z = cvt_pk_bf16(v1[0], v1[1]); w.w = cvt_pk_bf16(v1[2], v1[3]);
                    *(u32x4*)(rowp + bj * HALF) = w; } }
    }
};

template <class Epi, class Sched, bool ALIGN_EPI = false, bool SP2 = false>
__device__ __forceinline__ void gemm_phase(PG8_LAS unsigned char* lds, const Gemm g, const Sched& S, const Epi& E) {
    const int tid = threadIdx.x, wid = __builtin_amdgcn_readfirstlane(tid >> 6), lane = tid & 63, wr = wid >> 2, wc = wid & 3, fr = lane & 15, fq = lane >> 4;
    const int K = g.K, nt = K / BK;
    unsigned voffA[2], voffB[2];
#pragma unroll
    for (int i = 0; i < 2; ++i) { int R, C; stage_rc(tid * 16 + i * 8192, R, C); const int Rb = Epi::PERM ? ((R & ~31) + perm32(R & 31)) : R;
        voffA[i] = (unsigned)(R * g.lda + C) * 2u; voffB[i] = (unsigned)(Rb * K + C) * 2u; }
    const size_t kstep = (size_t)(BK * 2);
    const size_t hstep = (size_t)HALF * K * 2;
    const size_t tstep = 2 * hstep; const size_t hstepA = (size_t)HALF * g.lda * 2, tstepA = 2 * hstepA;
    const unsigned ldsw = (unsigned)wid * 1024u;
    const int aoff = lds_byte(wr * 64 + fr, fq * 8), boff = lds_byte(wc * 32 + fr, fq * 8);
#define PG8_SA(b, h) (((b) * 2 + (h)) * HTB)
#define PG8_SB(b, h) ((4 + (b) * 2 + (h)) * HTB)
#define PG8_STAGE(bufoff, gbase, voff) do { _Pragma("unroll") for (int _i = 0; _i < 2; ++_i) \
        __builtin_amdgcn_global_load_lds((const unsigned*)((const char*)(gbase) + (voff)[_i]), (PG8_LAS unsigned*)(lds + (bufoff) + ldsw + _i * 8192), 16, 0, 0); } while (0)
#define PG8_LDA(dst, b, h) do { _Pragma("unroll") for (int m = 0; m < 4; ++m) _Pragma("unroll") for (int k = 0; k < 2; ++k) dst[m][k] = *(const PG8_LAS bf16x8*)(lds + PG8_SA(b, h) + aoff + m * 2048 + k * 1024); } while (0)
#define PG8_LDB(dst, b, h) do { _Pragma("unroll") for (int n = 0; n < 2; ++n) _Pragma("unroll") for (int k = 0; k < 2; ++k) dst[n][k] = *(const PG8_LAS bf16x8*)(lds + PG8_SB(b, h) + boff + n * 2048 + k * 1024); } while (0)
#define PG8_MMA(ai, bj, At, Bt) do { __builtin_amdgcn_s_setprio(1); _Pragma("unroll") for (int m = 0; m < 4; ++m) _Pragma("unroll") for (int n = 0; n < 2; ++n) _Pragma("unroll") for (int k = 0; k < 2; ++k) \
        acc[ai][bj][m][n] = __builtin_amdgcn_mfma_f32_16x16x32_bf16(Bt[n][k], At[m][k], acc[ai][bj][m][n], 0, 0, 0); __builtin_amdgcn_s_setprio(0); } while (0)
#define PG8_WAIT_V(n) asm volatile("s_waitcnt vmcnt(" #n ")" ::: "memory")
#define PG8_WAIT_L(n) asm volatile("s_waitcnt lgkmcnt(" #n ")" ::: "memory")
#define PG8_BAR __builtin_amdgcn_s_barrier()
#define PG8_SCHED __builtin_amdgcn_sched_barrier(0)
    Unit cur, nxt; int ui = 0;
    if (!S.next(0, cur)) return;
    f32x4 acc[2][2][4][2];
#pragma unroll
    for (int a = 0; a < 2; ++a)
#pragma unroll
        for (int b = 0; b < 2; ++b)
#pragma unroll
            for (int m = 0; m < 4; ++m)
#pragma unroll
                for (int n = 0; n < 2; ++n) acc[a][b][m][n] = (f32x4){0.f, 0.f, 0.f, 0.f};
    bf16x8 At[4][2], B0[2][2], B1[2][2];
    const char* cA = (const char*)g.A + (size_t)cur.pm * tstepA; const char* cB = (const char*)g.Bt + (size_t)cur.pn * tstep;
    S.a_ready(cur);
    if constexpr (SP2) {
        PG8_STAGE(PG8_SB(0, 0), cB, voffB); PG8_STAGE(PG8_SB(0, 1), cB + hstep, voffB); PG8_STAGE(PG8_SA(0, 0), cA, voffA); PG8_STAGE(PG8_SA(0, 1), cA + hstepA, voffA);
        if (wr == 1) PG8_BAR;
        PG8_WAIT_V(2); PG8_BAR;
        PG8_STAGE(PG8_SB(1, 0), cB + kstep, voffB); PG8_STAGE(PG8_SA(1, 0), cA + kstep, voffA); PG8_STAGE(PG8_SB(1, 1), cB + hstep + kstep, voffB);
        PG8_WAIT_V(6); PG8_BAR;
    } else {
        PG8_STAGE(PG8_SB(0, 0), cB, voffB); PG8_STAGE(PG8_SA(0, 0), cA, voffA); PG8_STAGE(PG8_SB(0, 1), cB + hstep, voffB); PG8_STAGE(PG8_SA(0, 1), cA + hstepA, voffA);
        if (wr == 1) PG8_BAR;
        PG8_WAIT_V(4); PG8_BAR;
        PG8_STAGE(PG8_SB(1, 0), cB + kstep, voffB); PG8_STAGE(PG8_SA(1, 0), cA + kstep, voffA); PG8_STAGE(PG8_SB(1, 1), cB + hstep + kstep, voffB);
        PG8_WAIT_V(6); PG8_BAR;
    }
    for (;;) {
        const bool has_next = S.next(ui + 1, nxt);
        const char* nA = has_next ? (const char*)g.A + (size_t)nxt.pm * tstepA : cA; const char* nB = has_next ? (const char*)g.Bt + (size_t)nxt.pn * tstep : cB;
        for (int t = 0; t < nt; t += 2) {
            const bool last = (t == nt - 2);
            const char* a1 = cA + (size_t)(t + 1) * kstep;
            const char* a2 = last ? nA : cA + (size_t)(t + 2) * kstep; const char* b2 = last ? nB : cB + (size_t)(t + 2) * kstep;
            const char* a3 = a2 + kstep; const char* b3 = b2 + kstep;
            if (last && has_next) S.a_ready(nxt);
            if constexpr (SP2) {
            PG8_LDB(B0, 0, 0); PG8_LDB(B1, 0, 1); PG8_SCHED; PG8_LDA(At, 0, 0); PG8_STAGE(PG8_SA(1, 1), a1 + hstepA, voffA);
            PG8_WAIT_V(8); PG8_WAIT_L(0); PG8_BAR; PG8_MMA(0, 0, At, B0); PG8_MMA(0, 1, At, B1); PG8_BAR; PG8_SCHED;
            PG8_LDA(At, 0, 1); PG8_STAGE(PG8_SB(0, 0), b2, voffB); PG8_STAGE(PG8_SB(0, 1), b2 + hstep, voffB); PG8_STAGE(PG8_SA(0, 0), a2, voffA);
            PG8_WAIT_V(8); PG8_WAIT_L(0); PG8_BAR; PG8_MMA(1, 0, At, B0); PG8_MMA(1, 1, At, B1); PG8_BAR; PG8_SCHED;
            PG8_LDB(B0, 1, 0); PG8_LDB(B1, 1, 1); PG8_SCHED; PG8_LDA(At, 1, 0); PG8_STAGE(PG8_SA(0, 1), a2 + hstepA, voffA);
            PG8_WAIT_V(8); PG8_WAIT_L(0); PG8_BAR; PG8_MMA(0, 0, At, B0); PG8_MMA(0, 1, At, B1); PG8_BAR; PG8_SCHED;
            PG8_LDA(At, 1, 1); PG8_STAGE(PG8_SB(1, 0), b3, voffB); PG8_STAGE(PG8_SB(1, 1), b3 + hstep, voffB); PG8_STAGE(PG8_SA(1, 0), a3, voffA);
            PG8_WAIT_V(8); PG8_WAIT_L(0); PG8_BAR; PG8_MMA(1, 0, At, B0); PG8_MMA(1, 1, At, B1); PG8_BAR; PG8_SCHED;
            } else {
            PG8_LDB(B0, 0, 0); PG8_SCHED; PG8_LDA(At, 0, 0); PG8_STAGE(PG8_SA(1, 1), a1 + hstepA, voffA);
            PG8_WAIT_L(8); PG8_BAR; PG8_WAIT_L(0); PG8_MMA(0, 0, At, B0); PG8_BAR; PG8_SCHED;
            PG8_LDB(B1, 0, 1); PG8_STAGE(PG8_SB(0, 0), b2, voffB);
            PG8_BAR; PG8_WAIT_L(0); PG8_MMA(0, 1, At, B1); PG8_BAR;
            PG8_LDA(At, 0, 1); PG8_STAGE(PG8_SA(0, 0), a2, voffA);
            PG8_BAR; PG8_WAIT_L(0); PG8_MMA(1, 0, At, B0); PG8_BAR; PG8_SCHED;
            PG8_STAGE(PG8_SB(0, 1), b2 + hstep, voffB);
            PG8_WAIT_V(6); PG8_BAR; PG8_MMA(1, 1, At, B1); PG8_BAR;
            PG8_LDB(B0, 1, 0); PG8_SCHED; PG8_LDA(At, 1, 0); PG8_STAGE(PG8_SA(0, 1), a2 + hstepA, voffA);
            PG8_WAIT_L(8); PG8_BAR; PG8_WAIT_L(0); PG8_MMA(0, 0, At, B0); PG8_BAR; PG8_SCHED;
            PG8_LDB(B1, 1, 1); PG8_STAGE(PG8_SB(1, 0), b3, voffB);
            PG8_BAR; PG8_WAIT_L(0); PG8_MMA(0, 1, At, B1); PG8_BAR;
            PG8_LDA(At, 1, 1); PG8_STAGE(PG8_SA(1, 0), a3, voffA);
            PG8_BAR; PG8_WAIT_L(0); PG8_MMA(1, 0, At, B0); PG8_BAR; PG8_SCHED;
            PG8_STAGE(PG8_SB(1, 1), b3 + hstep, voffB);
            PG8_WAIT_V(6); PG8_BAR; PG8_MMA(1, 1, At, B1); PG8_BAR;
            }
        }
        if constexpr (ALIGN_EPI) { if (wr == 0) PG8_BAR; }
        if constexpr (!Epi::AFTER_DRAIN) { E(acc, cur, wr, wc, fr, fq); S.done(cur); }
        if (!has_next) break;
#pragma unroll
        for (int a = 0; a < 2; ++a)
#pragma unroll
            for (int b = 0; b < 2; ++b)
#pragma unroll
                for (int m = 0; m < 4; ++m)
#pragma unroll
                    for (int n = 0; n < 2; ++n) acc[a][b][m][n] = (f32x4){0.f, 0.f, 0.f, 0.f};
        cur = nxt; cA = nA; cB = nB; ++ui;
        if constexpr (ALIGN_EPI) { if (wr == 1) PG8_BAR; }
    }
    PG8_WAIT_V(0);
    if constexpr (!ALIGN_EPI) { if (wr == 0) PG8_BAR; }
    PG8_BAR;
    if constexpr (Epi::AFTER_DRAIN) { E.fused(acc, cur, wr, wc, fr, fq, lds, wid, lane); S.done(cur); }
#undef PG8_SA
#undef PG8_SB
#undef PG8_STAGE
#undef PG8_LDA
#undef PG8_LDB
#undef PG8_MMA
#undef PG8_WAIT_V
#undef PG8_WAIT_L
#undef PG8_BAR
#undef PG8_SCHED
}
}

#define DI __device__ __forceinline__
#define LAS __attribute__((address_space(3)))
typedef unsigned short bf16;
typedef float f32x2 __attribute__((ext_vector_type(2)));
typedef float f32x4 __attribute__((ext_vector_type(4)));
typedef float f32x16 __attribute__((ext_vector_type(16)));
typedef short bf16x8 __attribute__((ext_vector_type(8)));
typedef unsigned u32x2 __attribute__((ext_vector_type(2)));
typedef unsigned u32x4 __attribute__((ext_vector_type(4)));
typedef __bf16 bfv2 __attribute__((ext_vector_type(2)));

constexpr int NWAVES = 8, NTHR = 512;
constexpr int DM = 1024, NB = 4, SEQ = 8192, CTXL = 256, HID = 4096;
constexpr int ML = NB * SEQ, MC = NB * CTXL, MT = ML + MC;
constexpr int PP = 2816;
constexpr int RWC = 768;
constexpr int NPOS = CTXL + SEQ;
constexpr size_t MiB = 1u << 20;
constexpr size_t WS_BAR = 3 * MiB, WS_BAR_BYTES = 16384;
constexpr size_t WS_MOD = 0, WS_W2T = 256 * 1024, WS_A2T = 384 * 1024, WS_G2T = 512 * 1024, WS_BC = 1 * MiB;
constexpr size_t WS_CC = 4 * MiB;
constexpr size_t WS_WINT = 4 * MiB, WS_WOUTT = 10 * MiB, WS_P = 12 * MiB, WS_KP = 194 * MiB, WS_VT = 203 * MiB;
constexpr size_t WS_SH = 212 * MiB, WS_SD0 = 311 * MiB, WS_SD1 = 410 * MiB, WS_A0 = 212 * MiB;
constexpr size_t WS_W1T0 = 340 * MiB, WS_W2T0 = 348 * MiB, WS_W1T1 = 356 * MiB, WS_W2T1 = 364 * MiB, WS_CINT = 372 * MiB, WS_COUTT = 378 * MiB;
constexpr size_t WS_XLB = 268 * MiB;
constexpr size_t WS_YL = 380 * MiB, WS_A1 = 444 * MiB, WS_H = 12 * MiB, WS_G = 12 * MiB, WS_Z = 204 * MiB, WS_END = 509 * MiB;
constexpr int LDS_BYTES = 147456;
constexpr float LOG2E = 1.4426950408889634f;

struct Params {
    const float *x, *c, *ctx, *c_ctx, *mod_w, *mod_b, *norm_g, *mlp_w1, *mlp_w2, *ab_w_in, *ab_w_out, *att_sink;
    const float *rwkv_mu, *rwkv_w0, *rwkv_w2, *rwkv_a0, *rwkv_a2, *rwkv_g2, *rwkv_kk, *rwkv_ka, *rwkv_rk, *rwkv_ln_w, *rwkv_ln_b;
    const float *conv_w_in, *conv_w, *conv_w_out;
    float* out; unsigned char* ws;
    int ph_lo, ph_hi;
};

DI float bf_lo(unsigned p) { return __uint_as_float(p << 16); }
DI float bf_hi(unsigned p) { return __uint_as_float(p & 0xffff0000u); }
DI float bf1(bf16 v) { return __uint_as_float((unsigned)v << 16); }
DI unsigned pk2(float lo, float hi) { f32x2 v = {lo, hi}; bfv2 r = __builtin_convertvector(v, bfv2); return __builtin_bit_cast(unsigned, r); }
DI float wave_sum(float v) {
#pragma unroll
    for (int o = 1; o < 64; o <<= 1) v += __shfl_xor(v, o);
    return v;
}
#define DPP_ADD(x, ctrl) x += __builtin_bit_cast(float, __builtin_amdgcn_update_dpp(0, __builtin_bit_cast(int, x), ctrl, 0xf, 0xf, true))
DI float rowsum16(float x) { DPP_ADD(x, 0xB1); DPP_ADD(x, 0x4E); DPP_ADD(x, 0x141); DPP_ADD(x, 0x140); return x; }
DI float sigmoidf_(float z) { return __builtin_amdgcn_rcpf(1.0f + __expf(-z)); }
DI float tanhf_(float z) { const float e = __expf(-2.0f * fabsf(z)); const float t = (1.0f - e) * __builtin_amdgcn_rcpf(1.0f + e); return z < 0.f ? -t : t; }

DI void transpose_item(const float* W, int K, int N, bf16* WT, LAS float* scr, int item, int lane) {
    const int nblk = N / 32, kb = item / nblk, nb = item % nblk, k0 = 64 * kb, n0 = 32 * nb;
#pragma unroll 8
    for (int i = 0; i < 32; ++i) { const int kk = 2 * i + (lane >> 5); scr[kk * 33 + (lane & 31)] = W[(size_t)(k0 + kk) * N + n0 + (lane & 31)]; }
    asm volatile("s_waitcnt lgkmcnt(0)" ::: "memory");
    const int c = lane & 7;
#pragma unroll
    for (int j = 0; j < 4; ++j) { const int n = (lane >> 3) + 8 * j; const LAS float* s = scr + (8 * c) * 33 + n;
        u32x4 o; o.x = pk2(s[0 * 33], s[1 * 33]); o.y = pk2(s[2 * 33], s[3 * 33]); o.z = pk2(s[4 * 33], s[5 * 33]); o.w = pk2(s[6 * 33], s[7 * 33]);
        *(u32x4*)(WT + (size_t)(n0 + n) * K + k0 + 8 * c) = o; }
    asm volatile("s_waitcnt lgkmcnt(0)" ::: "memory");
}
DI void transpose_load(const float* W, int N, int item, int lane, float (&t)[32]) {
    const int nblk = N / 32, kb = item / nblk, nb = item % nblk, k0 = 64 * kb, n0 = 32 * nb;
#pragma unroll
    for (int i = 0; i < 32; ++i) t[i] = W[(size_t)(k0 + 2 * i + (lane >> 5)) * N + n0 + (lane & 31)];
}
DI void transpose_store(int K, int N, bf16* WT, LAS float* scr, int item, int lane, const float (&t)[32]) {
    const int nblk = N / 32, kb = item / nblk, nb = item % nblk, k0 = 64 * kb, n0 = 32 * nb;
#pragma unroll
    for (int i = 0; i < 32; ++i) scr[(2 * i + (lane >> 5)) * 33 + (lane & 31)] = t[i];
    asm volatile("s_waitcnt lgkmcnt(0)" ::: "memory");
    const int c = lane & 7;
#pragma unroll
    for (int j = 0; j < 4; ++j) { const int n = (lane >> 3) + 8 * j; const LAS float* s = scr + (8 * c) * 33 + n;
        u32x4 o; o.x = pk2(s[0 * 33], s[1 * 33]); o.y = pk2(s[2 * 33], s[3 * 33]); o.z = pk2(s[4 * 33], s[5 * 33]); o.w = pk2(s[6 * 33], s[7 * 33]);
        *(u32x4*)(WT + (size_t)(n0 + n) * K + k0 + 8 * c) = o; }
    asm volatile("s_waitcnt lgkmcnt(0)" ::: "memory");
}
DI void transpose_all(const float* W, int K, int N, bf16* WT, LAS float* scr, int gw, int ngw, int lane) {
    const int items = (K / 64) * (N / 32);
    for (int it = gw; it < items; it += 2 * ngw) {
        float ta[32], tb[32]; const bool two = it + ngw < items;
        transpose_load(W, N, it, lane, ta); if (two) transpose_load(W, N, it + ngw, lane, tb);
        transpose_store(K, N, WT, scr, it, lane, ta); if (two) transpose_store(K, N, WT, scr, it + ngw, lane, tb);
    }
}

DI void phase_prologue(const Params& p, LAS unsigned char* lds, int tid, int wave, int lane, int vcu, int G) {
    LAS float* sv = (LAS float*)lds;
    LAS float* part = (LAS float*)(lds + 20480);
    for (int i = tid; i < 5 * DM; i += NTHR) { const int v = i >> 10, k = i & 1023; const float cv = v < 4 ? p.c[v * DM + k] : p.c_ctx[k]; sv[i] = cv * __builtin_amdgcn_rcpf(1.0f + __expf(-cv)); }
    __syncthreads();
    float* mod = (float*)(p.ws + WS_MOD);
    for (int u = vcu; u < 192; u += G) {
        const int l = u / 96, n0 = (u % 96) * 64;
        const float* W = p.mod_w + (size_t)l * DM * 6144 + n0 + lane;
        float acc[5] = {0.f, 0.f, 0.f, 0.f, 0.f};
#pragma unroll 8
        for (int k = wave * 128; k < wave * 128 + 128; ++k) { const float w = W[(size_t)k * 6144];
#pragma unroll
            for (int v = 0; v < 5; ++v) acc[v] += sv[v * DM + k] * w; }
#pragma unroll
        for (int v = 0; v < 5; ++v) part[(wave * 5 + v) * 64 + lane] = acc[v];
        __syncthreads();
        if (tid < 320) { const int v = tid >> 6, n = tid & 63; float s = p.mod_b[l * 6144 + n0 + n];
#pragma unroll
            for (int w = 0; w < 8; ++w) s += part[(w * 5 + v) * 64 + n];
            mod[(l * 5 + v) * 6144 + n0 + n] = s; }
        __syncthreads();
    }
    __syncthreads();
    LAS float* scr = (LAS float*)(lds + wave * 16384);
    const int gw = vcu * NWAVES + wave, ngw = G * NWAVES;
    transpose_all(p.ab_w_in, DM, 2688, (bf16*)(p.ws + WS_WINT), scr, gw, ngw, lane);
    transpose_all(p.ab_w_out, DM, DM, (bf16*)(p.ws + WS_WOUTT), scr, gw, ngw, lane);
    for (int d = 0; d < 2; ++d) {
        transpose_all(p.rwkv_w2 + d * 64 * 512, 64, 512, (bf16*)(p.ws + WS_W2T) + d * 512 * 64, scr, gw, ngw, lane);
        transpose_all(p.rwkv_a2 + d * 64 * 512, 64, 512, (bf16*)(p.ws + WS_A2T) + d * 512 * 64, scr, gw, ngw, lane);
    }
    transpose_all(p.rwkv_g2, 128, 512, (bf16*)(p.ws + WS_G2T), scr, gw, ngw, lane);
    { u32x4* z = (u32x4*)((bf16*)(p.ws + WS_WINT) + (size_t)2688 * DM); const int n16 = 128 * DM * 2 / 16;
      for (int i = gw * 64 + lane; i < n16; i += ngw * 64) z[i] = (u32x4){0u, 0u, 0u, 0u}; }
}
DI void phase_weights2(const Params& p, LAS unsigned char* lds, int wave, int lane, int vcu, int G) {
    LAS float* scr = (LAS float*)(lds + wave * 16384);
    const int gw = vcu * NWAVES + wave, ngw = G * NWAVES;
    transpose_all(p.mlp_w1, DM, HID, (bf16*)(p.ws + WS_W1T0), scr, gw, ngw, lane);
    transpose_all(p.mlp_w2, HID, DM, (bf16*)(p.ws + WS_W2T0), scr, gw, ngw, lane);
    transpose_all(p.mlp_w1 + (size_t)DM * HID, DM, HID, (bf16*)(p.ws + WS_W1T1), scr, gw, ngw, lane);
    transpose_all(p.mlp_w2 + (size_t)DM * HID, HID, DM, (bf16*)(p.ws + WS_W2T1), scr, gw, ngw, lane);
    transpose_all(p.conv_w_in, DM, 3 * DM, (bf16*)(p.ws + WS_CINT), scr, gw, ngw, lane);
    transpose_all(p.conv_w_out, DM, DM, (bf16*)(p.ws + WS_COUTT), scr, gw, ngw, lane);
}

DI void store_row_bf16(bf16* orow, int lane, const f32x4 (&v)[4]) {
    unsigned long long* o8 = (unsigned long long*)orow + lane;
#pragma unroll
    for (int j = 0; j < 4; ++j) o8[64 * j] = (unsigned long long)pk2(v[j].x, v[j].y) | ((unsigned long long)pk2(v[j].z, v[j].w) << 32);
}
DI float wave_sum2(float v) { v = rowsum16(v); v += __shfl_xor(v, 16); v += __shfl_xor(v, 32); return v; }
DI void phase_norm0(const Params& p, int wave, int lane, int vcu, int G) {
    constexpr int NR = 4;
    const int gw = vcu * NWAVES + wave, ngw = G * NWAVES;
    const float* mod = (const float*)(p.ws + WS_MOD);
    bf16* A0 = (bf16*)(p.ws + WS_A0);
    for (int row0 = gw; row0 < MT; row0 += NR * ngw) {
        f32x4 xv[NR][4]; float ss[NR]; int rows[NR];
#pragma unroll
        for (int q = 0; q < NR; ++q) { int row = row0 + q * ngw; if (row >= MT) row = row0; rows[q] = row; ss[q] = 0.f;
            const float* xr = row < ML ? p.x + (size_t)row * DM : p.ctx + (size_t)(row - ML) * DM;
#pragma unroll
            for (int j = 0; j < 4; ++j) xv[q][j] = __builtin_nontemporal_load((const f32x4*)xr + lane + 64 * j); }
#pragma unroll
        for (int q = 0; q < NR; ++q) {
#pragma unroll
            for (int j = 0; j < 4; ++j) ss[q] += (xv[q][j].x * xv[q][j].x + xv[q][j].y * xv[q][j].y) + (xv[q][j].z * xv[q][j].z + xv[q][j].w * xv[q][j].w); }
#pragma unroll
        for (int q = 0; q < NR; ++q) {
            if (row0 + q * ngw >= MT) break;
            const int row = rows[q], v = row < ML ? row / SEQ : 4;
            const float* sh = mod + v * 6144, *sc = sh + 1024;
            const float rs = rsqrtf(wave_sum2(ss[q]) * (1.0f / DM) + 1e-6f);
#pragma unroll
            for (int j = 0; j < 4; ++j) { const f32x4 g = *((const f32x4*)p.norm_g + lane + 64 * j), s1 = *((const f32x4*)sc + lane + 64 * j), s0 = *((const f32x4*)sh + lane + 64 * j);
                xv[q][j] = (xv[q][j] * rs) * g * (s1 + 1.0f) + s0; }
            store_row_bf16(A0 + (size_t)row * DM, lane, xv[q]);
        }
    }
}
template <bool XIN_BF, bool XOUT_BF>
DI void phase_norm1(const bf16* Y, const void* xin_, void* xout_, const float* gA, const float* modl, int gt_off, const float* gB, int sh_off, int sc_off, bf16* aout,
                    int wave, int lane, int vcu, int G) {
    constexpr int NR = 4;
    const int gw = vcu * NWAVES + wave, ngw = G * NWAVES;
    for (int row0 = gw; row0 < ML; row0 += NR * ngw) {
        f32x4 yv[NR][4], xv[NR][4]; int rows[NR]; float ss[NR];
#pragma unroll
        for (int q = 0; q < NR; ++q) ss[q] = 0.f;
#pragma unroll
        for (int q = 0; q < NR; ++q) { int row = row0 + q * ngw; if (row >= ML) row = row0; rows[q] = row;
#pragma unroll
            for (int j = 0; j < 4; ++j) { const u32x2 w = __builtin_nontemporal_load((const u32x2*)(Y + (size_t)row * DM) + lane + 64 * j); yv[q][j] = (f32x4){bf_lo(w.x), bf_hi(w.x), bf_lo(w.y), bf_hi(w.y)};
                if (XIN_BF) { const u32x2 xw = __builtin_nontemporal_load((const u32x2*)((const bf16*)xin_ + (size_t)row * DM) + lane + 64 * j); xv[q][j] = (f32x4){bf_lo(xw.x), bf_hi(xw.x), bf_lo(xw.y), bf_hi(xw.y)}; }
                else xv[q][j] = __builtin_nontemporal_load((const f32x4*)((const float*)xin_ + (size_t)row * DM) + lane + 64 * j); } }
#pragma unroll
        for (int q = 0; q < NR; ++q)
#pragma unroll
            for (int j = 0; j < 4; ++j) ss[q] += (yv[q][j].x * yv[q][j].x + yv[q][j].y * yv[q][j].y) + (yv[q][j].z * yv[q][j].z + yv[q][j].w * yv[q][j].w);
        float rs[NR], s2[NR];
#pragma unroll
        for (int q = 0; q < NR; ++q) s2[q] = 0.f;
#pragma unroll
        for (int q = 0; q < NR; ++q) rs[q] = rsqrtf(wave_sum2(ss[q]) * (1.0f / DM) + 1e-6f);
#pragma unroll
        for (int q = 0; q < NR; ++q) { const float* mv = modl + (rows[q] / SEQ) * 6144;
            if (row0 + q * ngw >= ML) break;
#pragma unroll
            for (int j = 0; j < 4; ++j) { const f32x4 g = *((const f32x4*)gA + lane + 64 * j), gt = *((const f32x4*)(mv + gt_off) + lane + 64 * j);
                xv[q][j] = xv[q][j] + gt * ((yv[q][j] * rs[q]) * g);
                if (XOUT_BF) { u32x2 w; w.x = pk2(xv[q][j].x, xv[q][j].y); w.y = pk2(xv[q][j].z, xv[q][j].w); __builtin_nontemporal_store(w, (u32x2*)((bf16*)xout_ + (size_t)rows[q] * DM) + lane + 64 * j); }
                else __builtin_nontemporal_store(xv[q][j], (f32x4*)((float*)xout_ + (size_t)rows[q] * DM) + lane + 64 * j);
                s2[q] += (xv[q][j].x * xv[q][j].x + xv[q][j].y * xv[q][j].y) + (xv[q][j].z * xv[q][j].z + xv[q][j].w * xv[q][j].w); } }
        if (aout) {
            float r2[NR];
#pragma unroll
            for (int q = 0; q < NR; ++q) r2[q] = rsqrtf(wave_sum2(s2[q]) * (1.0f / DM) + 1e-6f);
#pragma unroll
            for (int q = 0; q < NR; ++q) { const float* mv = modl + (rows[q] / SEQ) * 6144;
                if (row0 + q * ngw >= ML) break;
#pragma unroll
                for (int j = 0; j < 4; ++j) { const f32x4 g = *((const f32x4*)gB + lane + 64 * j), s1 = *((const f32x4*)(mv + sc_off) + lane + 64 * j), s0 = *((const f32x4*)(mv + sh_off) + lane + 64 * j);
                    yv[q][j] = (xv[q][j] * r2[q]) * g * (s1 + 1.0f) + s0; }
                store_row_bf16(aout + (size_t)rows[q] * DM, lane, yv[q]); }
        }
    }
}

constexpr int FP = 1936;
DI f32x4 mix4(const LAS bf16* T, int t, int col, const f32x4 mu) {
    const u32x2 pv = *(const LAS u32x2*)(T + t * FP + col), cv = *(const LAS u32x2*)(T + (t + 1) * FP + col), nv = *(const LAS u32x2*)(T + (t + 2) * FP + col);
    const f32x4 p4 = {bf_lo(pv.x), bf_hi(pv.x), bf_lo(pv.y), bf_hi(pv.y)}, c4 = {bf_lo(cv.x), bf_hi(cv.x), bf_lo(cv.y), bf_hi(cv.y)}, n4 = {bf_lo(nv.x), bf_hi(nv.x), bf_lo(nv.y), bf_hi(nv.y)};
    return c4 + mu * ((p4 + n4) * 0.5f - c4);
}
DI void st4bf(bf16* dst, const f32x4 v) { u32x2 w; w.x = pk2(v.x, v.y); w.y = pk2(v.z, v.w); *(u32x2*)dst = w; }
DI void st4bf_nt(bf16* dst, const f32x4 v) { u32x2 w; w.x = pk2(v.x, v.y); w.y = pk2(v.z, v.w); __builtin_nontemporal_store(w, (u32x2*)dst); }
DI void unpack8(const u32x4 w, float (&o)[8]) { o[0] = bf_lo(w.x); o[1] = bf_hi(w.x); o[2] = bf_lo(w.y); o[3] = bf_hi(w.y); o[4] = bf_lo(w.z); o[5] = bf_hi(w.z); o[6] = bf_lo(w.w); o[7] = bf_hi(w.w); }
DI bf16x8 pack8(const float (&v)[8]) { u32x4 w; w.x = pk2(v[0], v[1]); w.y = pk2(v[2], v[3]); w.z = pk2(v[4], v[5]); w.w = pk2(v[6], v[7]); return __builtin_bit_cast(bf16x8, w); }

DI void phase_features(const Params& p, LAS unsigned char* lds, int tid, int wave, int lane, int vcu, int G) {
    const bf16* P = (const bf16*)(p.ws + WS_P);
    LAS bf16* T = (LAS bf16*)lds;
    bf16* SH = (bf16*)(p.ws + WS_SH); bf16* SD0 = (bf16*)(p.ws + WS_SD0); bf16* SD1 = (bf16*)(p.ws + WS_SD1);
    float* BC = (float*)(p.ws + WS_BC); bf16* KP = (bf16*)(p.ws + WS_KP); bf16* VT = (bf16*)(p.ws + WS_VT);
    const bf16* W2T = (const bf16*)(p.ws + WS_W2T); const bf16* A2T = (const bf16*)(p.ws + WS_A2T);
    const int h = wave, tq = lane >> 4, cl = lane & 15, c0 = h * 64 + 4 * cl;
    for (int u = vcu; u < MT / 16; u += G) {
        const int R0 = u * 16;
        int seq0, seqlen; if (R0 < ML) { seq0 = (R0 / SEQ) * SEQ; seqlen = SEQ; } else { seq0 = ML + ((R0 - ML) / CTXL) * CTXL; seqlen = CTXL; }
        bf16x8 bw[16];
#pragma unroll
        for (int q = 0; q < 16; ++q) { const int L = q >> 3, ks = (q >> 2) & 1, nt = q & 3; bw[q] = *(const bf16x8*)(W2T + (size_t)(L & 1) * 512 * 64 + (size_t)(c0 + nt) * 64 + ks * 32 + tq * 8); }
        __syncthreads();
        for (int i = tid; i < 18 * 240; i += NTHR) { const int rr = i / 240, ch = i % 240, row = R0 - 1 + rr;
            u32x4 v = {0u, 0u, 0u, 0u}; if (row >= seq0 && row < seq0 + seqlen) v = *(const u32x4*)(P + (size_t)row * PP + RWC + ch * 8);
            *(LAS u32x4*)(T + rr * FP + ch * 8) = v; }
        __syncthreads();
        f32x4 lo[4][4];
#pragma unroll
        for (int half = 0; half < 2; ++half) {
            if (half == 1) {
#pragma unroll
                for (int q = 0; q < 16; ++q) { const int L = 2 + (q >> 3), ks = (q >> 2) & 1, nt = q & 3; bw[q] = *(const bf16x8*)(A2T + (size_t)(L & 1) * 512 * 64 + (size_t)(c0 + nt) * 64 + ks * 32 + tq * 8); }
            }
#pragma unroll
            for (int LL = 0; LL < 2; ++LL) {
                const int L = half * 2 + LL;
#pragma unroll
                for (int nt = 0; nt < 4; ++nt) lo[L][nt] = (f32x4){0.f, 0.f, 0.f, 0.f};
#pragma unroll
                for (int ks = 0; ks < 2; ++ks) {
                    const int cb = 1536 + 64 * L + ks * 32 + tq * 8, tok = lane & 15;
                    float pv[8], cv[8], nv[8], a8[8];
                    unpack8(*(const LAS u32x4*)(T + tok * FP + cb), pv); unpack8(*(const LAS u32x4*)(T + (tok + 1) * FP + cb), cv); unpack8(*(const LAS u32x4*)(T + (tok + 2) * FP + cb), nv);
                    const f32x4 m0 = *(const f32x4*)(p.rwkv_mu + cb), m1 = *(const f32x4*)(p.rwkv_mu + cb + 4);
#pragma unroll
                    for (int e = 0; e < 8; ++e) { const float mu = e < 4 ? m0[e] : m1[e - 4]; float m = cv[e] + mu * (0.5f * (pv[e] + nv[e]) - cv[e]); if (L < 2) m = tanhf_(m); a8[e] = m; }
                    const bf16x8 a = pack8(a8);
#pragma unroll
                    for (int nt = 0; nt < 4; ++nt) lo[L][nt] = __builtin_amdgcn_mfma_f32_16x16x32_bf16(a, bw[LL * 8 + ks * 4 + nt], lo[L][nt], 0, 0, 0);
                }
            }
        }
        const f32x4 mu_r = *(const f32x4*)(p.rwkv_mu + c0), mu_k = *(const f32x4*)(p.rwkv_mu + 512 + c0), mu_v = *(const f32x4*)(p.rwkv_mu + 1024 + c0);
        const f32x4 kkw = *(const f32x4*)(p.rwkv_kk + c0), kaw = *(const f32x4*)(p.rwkv_ka + c0), rkw = *(const f32x4*)(p.rwkv_rk + c0);
        const f32x4 w0f = *(const f32x4*)(p.rwkv_w0 + c0), w0b = *(const f32x4*)(p.rwkv_w0 + 512 + c0), a0f = *(const f32x4*)(p.rwkv_a0 + c0), a0b = *(const f32x4*)(p.rwkv_a0 + 512 + c0);
#pragma unroll
        for (int j = 0; j < 4; ++j) {
            const int t = 4 * tq + j, row = R0 + t;
            const f32x4 r4 = mix4(T, t, c0, mu_r), k4 = mix4(T, t, 512 + c0, mu_k), v4 = mix4(T, t, 1024 + c0, mu_v);
            const f32x4 kkv = k4 * kkw;
            const float ss = rowsum16((kkv.x * kkv.x + kkv.y * kkv.y) + (kkv.z * kkv.z + kkv.w * kkv.w));
            const f32x4 kk4 = kkv * __builtin_amdgcn_rcpf(fmaxf(__builtin_amdgcn_sqrtf(ss), 1e-12f));
            f32x4 df, db, kf, kb, bf, bb_;
#pragma unroll
            for (int i = 0; i < 4; ++i) {
                const float zf = w0f[i] + lo[0][i][j], zb = w0b[i] + lo[1][i][j];
                df[i] = __expf(-0.6065306597f * sigmoidf_(zf)); db[i] = __expf(-0.6065306597f * sigmoidf_(zb));
                const float af = sigmoidf_(a0f[i] + lo[2][i][j]), ab = sigmoidf_(a0b[i] + lo[3][i][j]);
                kf[i] = k4[i] * (1.0f + (af - 1.0f) * kaw[i]); kb[i] = k4[i] * (1.0f + (ab - 1.0f) * kaw[i]);
                bf[i] = kk4[i] * af; bb_[i] = kk4[i] * ab;
            }
            const f32x4 bt = r4 * (kf + kb) * rkw;
            const float bonus = rowsum16((bt.x + bt.y) + (bt.z + bt.w));
            if (cl == 0) BC[row * 8 + h] = bonus;
            const size_t rec = ((size_t)row * 8 + h) * 192 + 4 * cl;
            st4bf_nt(SH + rec, r4); st4bf_nt(SH + rec + 64, v4); st4bf_nt(SH + rec + 128, -kk4);
            st4bf_nt(SD0 + rec, df); st4bf_nt(SD0 + rec + 64, kf); st4bf_nt(SD0 + rec + 128, bf);
            st4bf_nt(SD1 + rec, db); st4bf_nt(SD1 + rec + 64, kb); st4bf_nt(SD1 + rec + 128, bb_);
        }
        if (tid < 256) {
            const int t = tid >> 4, g = tid & 15, row = R0 + t, kvh = g >> 3, d0 = (g & 7) * 8;
            const bf16* src = P + (size_t)row * PP + 512 + kvh * 64;
            const bool lat = row < ML; int b_, pos, tt = 0;
            if (lat) { b_ = row / SEQ; tt = row % SEQ; pos = CTXL + tt; } else { b_ = (row - ML) / CTXL; pos = (row - ML) % CTXL; }
            u32x4 ov = *(const u32x4*)(src + d0);
            if (lat) {
                const int dd = d0 & 31; const bool first = dd < 16;
                float o8[8], q8[8], r8[8]; unpack8(ov, o8); unpack8(*(const u32x4*)(src + (first ? d0 + 16 : d0 - 16)), q8);
                const float posf = (d0 < 32) ? (float)(tt >> 6) : (float)(tt & 63);
#pragma unroll
                for (int e = 0; e < 8; ++e) { const float inv = exp2f(-(float)((dd & 15) + e) * 0.8304820237f), ang = posf * inv, sn = __sinf(ang), cs = __cosf(ang);
                    r8[e] = first ? o8[e] * cs - q8[e] * sn : o8[e] * cs + q8[e] * sn; }
                ov = __builtin_bit_cast(u32x4, pack8(r8));
            }
            *(u32x4*)(KP + ((size_t)(b_ * 2 + kvh) * NPOS + pos) * 64 + d0) = ov;
        }
        { const int t = tid & 15, dq = tid >> 4, row = R0 + t, kvh = dq >> 4, d = (dq & 15) * 4;
          int b_, pos; if (row < ML) { b_ = row / SEQ; pos = CTXL + row % SEQ; } else { b_ = (row - ML) / CTXL; pos = (row - ML) % CTXL; }
          const u32x2 w = *(const u32x2*)(P + (size_t)row * PP + 640 + 4 * dq);
          bf16* dst = VT + (((size_t)(b_ * 2 + kvh) * (NPOS / 32) + (pos >> 5)) * 64 + d) * 32 + (pos & 31);
          dst[0] = (bf16)(w.x & 0xffffu); dst[32] = (bf16)(w.x >> 16); dst[64] = (bf16)(w.y & 0xffffu); dst[96] = (bf16)(w.y >> 16); }
    }
}

DI int crow(int r, int hi) { return (r & 3) + 8 * (r >> 2) + 4 * hi; }
constexpr int ATT_TASKS = 8192;
struct AttRegs { f32x16 O[2]; float m_, l_; bf16x8 qf[4], kf[4], vf[2][2]; int b, kvh, head, ql0, kb0, it_lo, it_hi; bool local; };
DI void att_setup(const Params& p, int task, int lane, AttRegs& A) {
    const bf16* Pm = (const bf16*)(p.ws + WS_P);
    const int qblk = task & 1, qsub = (task >> 1) & 1, g = (task >> 2) & 3, qb = (task >> 4) & 63; A.kvh = (task >> 10) & 1; A.b = task >> 11;
    A.head = A.kvh * 4 + g; A.ql0 = qb * 128 + qsub * 64 + qblk * 32; A.kb0 = 0; A.local = false;
    A.it_lo = A.ql0 < 128 ? (128 - A.ql0) >> 5 : 0; A.it_hi = A.ql0 + 160 > SEQ ? (SEQ - A.ql0 + 128) >> 5 : 9;
    const int r = lane & 31, hh = lane >> 5;
    const int t = A.ql0 + r; const bf16* src = Pm + (size_t)(A.b * SEQ + t) * PP + A.head * 64 + 8 * hh;
    float qv[4][8];
#pragma unroll
    for (int c = 0; c < 4; ++c) unpack8(*(const u32x4*)(src + 16 * c), qv[c]);
    const float prow = (float)(t >> 6), pcol = (float)(t & 63);
    float n0[8], n1[8], n2[8], n3[8];
#pragma unroll
    for (int e = 0; e < 8; ++e) { const float inv = exp2f(-(float)(8 * hh + e) * 0.8304820237f);
        const float a1 = prow * inv, s1 = __sinf(a1), c1 = __cosf(a1), a2 = pcol * inv, s2 = __sinf(a2), c2 = __cosf(a2); const float sc = 0.125f * LOG2E;
        n0[e] = (qv[0][e] * c1 - qv[1][e] * s1) * sc; n1[e] = (qv[1][e] * c1 + qv[0][e] * s1) * sc; n2[e] = (qv[2][e] * c2 - qv[3][e] * s2) * sc; n3[e] = (qv[3][e] * c2 + qv[2][e] * s2) * sc; }
    A.qf[0] = pack8(n0); A.qf[1] = pack8(n1); A.qf[2] = pack8(n2); A.qf[3] = pack8(n3);
    A.m_ = p.att_sink[A.head] * LOG2E; A.l_ = hh == 0 ? 1.0f : 0.0f;
#pragma unroll
    for (int dblk = 0; dblk < 2; ++dblk)
#pragma unroll
        for (int i = 0; i < 16; ++i) A.O[dblk][i] = 0.f;
}
DI void att_issue(const Params& p, int it, int lane, AttRegs& A) {
    const bf16* KP = (const bf16*)(p.ws + WS_KP); const bf16* VT = (const bf16*)(p.ws + WS_VT);
    const int r = lane & 31, hh = lane >> 5;
    int pos0; A.local = it < 9;
    if (A.local) { A.kb0 = A.ql0 - 128 + it * 32; pos0 = CTXL + A.kb0; } else pos0 = (it - 9) * 32;
    const bf16* Kb = KP + (size_t)(A.b * 2 + A.kvh) * NPOS * 64; const bf16* Vb = VT + (size_t)(A.b * 2 + A.kvh) * (NPOS / 32) * 2048;
#pragma unroll
    for (int c = 0; c < 4; ++c) A.kf[c] = *(const bf16x8*)(Kb + (size_t)(pos0 + r) * 64 + 16 * c + 8 * hh);
#pragma unroll
    for (int dblk = 0; dblk < 2; ++dblk)
#pragma unroll
        for (int s = 0; s < 2; ++s) { const u32x2* vp = (const u32x2*)(Vb + (size_t)(pos0 >> 5) * 2048 + (dblk * 32 + r) * 32 + 16 * s + 4 * hh); const u32x2 lo = vp[0], hi = vp[2];
            A.vf[dblk][s] = __builtin_bit_cast(bf16x8, (u32x4){lo.x, lo.y, hi.x, hi.y}); }
}
DI void att_compute(int lane, AttRegs& A) {
    const int r = lane & 31, hh = lane >> 5;
    const bool need_mask = A.local && !(A.kb0 >= A.ql0 - 97 && A.kb0 <= A.ql0 + 97);
    f32x16 S;
#pragma unroll
    for (int i = 0; i < 16; ++i) S[i] = 0.f;
#pragma unroll
    for (int c = 0; c < 4; ++c) S = __builtin_amdgcn_mfma_f32_32x32x16_bf16(A.kf[c], A.qf[c], S, 0, 0, 0);
    if (need_mask) { const int ql = A.ql0 + r;
#pragma unroll
        for (int i = 0; i < 16; ++i) { const int kl = A.kb0 + crow(i, hh); const int dlt = ql - kl; const bool ok = dlt <= 128 && dlt >= -128; S[i] = ok ? S[i] : -INFINITY; } }
    float tmax = S[0];
#pragma unroll
    for (int i = 1; i < 16; ++i) tmax = fmaxf(tmax, S[i]);
    tmax = fmaxf(tmax, __shfl_xor(tmax, 32));
    const float mnew = fmaxf(A.m_, tmax), alpha = __builtin_amdgcn_exp2f(A.m_ - mnew);
    A.m_ = mnew;
    float pe[16]; float ps = 0.f;
#pragma unroll
    for (int i = 0; i < 16; ++i) { pe[i] = __builtin_amdgcn_exp2f(S[i] - mnew); ps += pe[i]; }
    A.l_ = A.l_ * alpha + ps;
    if (__any(alpha != 1.0f)) {
#pragma unroll
        for (int dblk = 0; dblk < 2; ++dblk)
#pragma unroll
            for (int i = 0; i < 16; ++i) A.O[dblk][i] *= alpha; }
    bf16x8 pf[2];
#pragma unroll
    for (int s = 0; s < 2; ++s) { u32x4 w; w.x = pk2(pe[8 * s], pe[8 * s + 1]); w.y = pk2(pe[8 * s + 2], pe[8 * s + 3]); w.z = pk2(pe[8 * s + 4], pe[8 * s + 5]); w.w = pk2(pe[8 * s + 6], pe[8 * s + 7]);
        pf[s] = __builtin_bit_cast(bf16x8, w); }
#pragma unroll
    for (int dblk = 0; dblk < 2; ++dblk)
#pragma unroll
        for (int s = 0; s < 2; ++s) A.O[dblk] = __builtin_amdgcn_mfma_f32_32x32x16_bf16(A.vf[dblk][s], pf[s], A.O[dblk], 0, 0, 0);
}
DI void att_finish(const Params& p, int lane, AttRegs& A) {
    bf16* Pm = (bf16*)(p.ws + WS_P);
    const int r = lane & 31, hh = lane >> 5;
    const float lt = A.l_ + __shfl_xor(A.l_, 32), inv = __builtin_amdgcn_rcpf(lt);
    bf16* dst = Pm + (size_t)(A.b * SEQ + A.ql0 + r) * PP + A.head * 64;
#pragma unroll
    for (int dblk = 0; dblk < 2; ++dblk)
#pragma unroll
        for (int gi = 0; gi < 4; ++gi) { const f32x4 v = {A.O[dblk][4 * gi] * inv, A.O[dblk][4 * gi + 1] * inv, A.O[dblk][4 * gi + 2] * inv, A.O[dblk][4 * gi + 3] * inv};
            st4bf(dst + dblk * 32 + 8 * gi + 4 * hh, v); }
}
#define ATT_STEP(p, lane, A, a_task, a_stride, a_it, a_stage) do { if (a_task < ATT_TASKS) { \
        if (a_stage == 0) { att_setup(p, a_task, lane, A); a_it = A.it_lo; att_issue(p, a_it, lane, A); a_stage = 1; } \
        else { att_compute(lane, A); ++a_it; if (a_it == A.it_hi) a_it = 9; \
            if (a_it < 17) att_issue(p, a_it, lane, A); else { att_finish(p, lane, A); a_task += a_stride; a_stage = 0; } } } } while (0)
DI void phase_attention2(const Params& p, int wave, int lane, int vcu, int G) {
    AttRegs A; int a_task = vcu * NWAVES + wave, a_it = 0, a_stage = 0; const int a_stride = G * NWAVES;
    while (a_task < ATT_TASKS) ATT_STEP(p, lane, A, a_task, a_stride, a_it, a_stage);
}

DI int scan_row(int step, int b, int d) { if (step < CTXL) return ML + b * CTXL + (d ? CTXL - 1 - step : step); const int t = step - CTXL; return b * SEQ + (d ? SEQ - 1 - t : t); }
DI int prev_row(int row, int d, bool& none) {
    none = false;
    if (row < ML) { const int b = row / SEQ, t = row % SEQ; if (d == 0) return t > 0 ? row - 1 : ML + b * CTXL + CTXL - 1; return t < SEQ - 1 ? row + 1 : ML + b * CTXL; }
    const int j = (row - ML) % CTXL; if (d == 0) { none = j == 0; return none ? row : row - 1; } none = j == CTXL - 1; return none ? row : row + 1;
}
DI f32x4 ld4bf(const bf16* src) { const u32x2 w = *(const u32x2*)src; return (f32x4){bf_lo(w.x), bf_hi(w.x), bf_lo(w.y), bf_hi(w.y)}; }
DI float dot4(const f32x4 a, const f32x4 b) { return (a.x * b.x + a.y * b.y) + (a.z * b.z + a.w * b.w); }
DI void phase_pairs(const Params& p, int wave, int lane, int vcu, int G) {
    const bf16* SH = (const bf16*)(p.ws + WS_SH); const bf16* SD0 = (const bf16*)(p.ws + WS_SD0); const bf16* SD1 = (const bf16*)(p.ws + WS_SD1); float* CC = (float*)(p.ws + WS_CC);
    const int gw = vcu * NWAVES + wave, ngw = G * NWAVES, sub = lane >> 4, ks = (lane & 15) * 4;
    constexpr int NIT = 4;
    for (int base = gw * 4 * NIT; base < MT * 8; base += ngw * 4 * NIT) {
        f32x4 a4[NIT], kf[NIT], bf_[NIT], kb[NIT], bb[NIT]; bool nf[NIT], nb[NIT]; int it[NIT];
#pragma unroll
        for (int q = 0; q < NIT; ++q) {
            int item = base + q * 4 + sub; if (item >= MT * 8) item = MT * 8 - 1;
            it[q] = item; const int row = item >> 3, h = item & 7;
            const int pf = prev_row(row, 0, nf[q]), pb = prev_row(row, 1, nb[q]);
            a4[q] = ld4bf(SH + ((size_t)row * 8 + h) * 192 + 128 + ks);
            kf[q] = ld4bf(SD0 + ((size_t)pf * 8 + h) * 192 + 64 + ks); bf_[q] = ld4bf(SD0 + ((size_t)pf * 8 + h) * 192 + 128 + ks);
            kb[q] = ld4bf(SD1 + ((size_t)pb * 8 + h) * 192 + 64 + ks); bb[q] = ld4bf(SD1 + ((size_t)pb * 8 + h) * 192 + 128 + ks);
        }
#pragma unroll
        for (int q = 0; q < NIT; ++q) {
            float c1f = rowsum16(dot4(bf_[q], a4[q])), c2f = rowsum16(dot4(kf[q], a4[q])), c1b = rowsum16(dot4(bb[q], a4[q])), c2b = rowsum16(dot4(kb[q], a4[q]));
            if (nf[q]) { c1f = 0.f; c2f = 0.f; } if (nb[q]) { c1b = 0.f; c2b = 0.f; }
            if ((lane & 15) == 0 && base + q * 4 + sub < MT * 8) { *(f32x2*)(CC + (size_t)it[q] * 2) = (f32x2){c1f, c2f}; *(f32x2*)(CC + ((size_t)MT * 8 + it[q]) * 2) = (f32x2){c1b, c2b}; }
        }
    }
}
DI float fma_(float a, float b, float c) { float d; asm("v_fma_f32 %0, %1, %2, %3" : "=v"(d) : "v"(a), "v"(b), "v"(c)); return d; }
DI float mul_(float a, float b) { float d; asm("v_mul_f32 %0, %1, %2" : "=v"(d) : "v"(a), "v"(b)); return d; }
template <int MODE> DI void phase_scan(const Params& p, LAS unsigned char* lds, int tid, int wave, int lane, int vcu) {
    constexpr int TC = 32, STEPF = 384, BUFF = TC * STEPF, NCH = NPOS / TC;
    const int s = vcu >> 2, qr = vcu & 3, b = s >> 4, h = (s >> 1) & 7, d = s & 1;
    const bf16* SH = (const bf16*)(p.ws + WS_SH); const bf16* SD = (const bf16*)(p.ws + (d ? WS_SD1 : WS_SD0));
    bf16* Pm = (bf16*)(p.ws + WS_P);
    LAS float* buf = (LAS float*)lds;
    if (wave >= 4) {
        const int lt = tid - 256;
        u32x4 rgA[6], rgB[6];
#define SCAN_LOAD(rg, c) do { _Pragma("unroll") for (int i = 0; i < 6; ++i) { const int idx = i * 256 + lt, st = idx / 48, part = idx % 48; const int row = scan_row((c) * TC + st, b, d); \
            const bf16* src = (part < 24 ? SH : SD) + ((size_t)row * 8 + h) * 192 + (part % 24) * 8; rg[i] = *(const u32x4*)src; } } while (0)
#define SCAN_WRITE(rg, bi) do { _Pragma("unroll") for (int i = 0; i < 6; ++i) { const int idx = i * 256 + lt, st = idx / 48, part = idx % 48; LAS float* dst = buf + (bi) * BUFF + st * STEPF + part * 8; \
            *(LAS f32x4*)dst = (f32x4){bf_lo(rg[i].x), bf_hi(rg[i].x), bf_lo(rg[i].y), bf_hi(rg[i].y)}; *(LAS f32x4*)(dst + 4) = (f32x4){bf_lo(rg[i].z), bf_hi(rg[i].z), bf_lo(rg[i].w), bf_hi(rg[i].w)}; } } while (0)
        SCAN_LOAD(rgA, 0); SCAN_WRITE(rgA, 0); SCAN_LOAD(rgA, 1); SCAN_LOAD(rgB, 2);
        AttRegs A; int a_task = MODE == 0 ? vcu * 4 + (wave - 4) : ATT_TASKS, a_it = 0, a_stage = 0; const int a_stride = 1024;
        __syncthreads();
        for (int c = 0; c < NCH; c += 2) {
            if (MODE != 1 && c + 1 < NCH) { SCAN_WRITE(rgA, 1); if (c + 3 < NCH) SCAN_LOAD(rgA, c + 3); }
            ATT_STEP(p, lane, A, a_task, a_stride, a_it, a_stage);
            __syncthreads();
            if (MODE != 1 && c + 2 < NCH) { SCAN_WRITE(rgB, 0); if (c + 4 < NCH) SCAN_LOAD(rgB, c + 4); }
            ATT_STEP(p, lane, A, a_task, a_stride, a_it, a_stage);
            __syncthreads();
        }
        while (a_task < ATT_TASKS) ATT_STEP(p, lane, A, a_task, a_stride, a_it, a_stage);
#undef SCAN_LOAD
#undef SCAN_WRITE
    } else {
        const int rl = wave * 4 + (lane >> 4), vidx = qr * 16 + rl, ks = (lane & 15) * 4, l15 = lane & 15;
        f32x2 S01 = {0.f, 0.f}, S23 = {0.f, 0.f};
        __builtin_amdgcn_s_setprio(2);
        bf16* ydst = MODE ? Pm + 2688 + d * 64 + vidx : Pm + 1024 + d * 512 + h * 64 + vidx;
        __syncthreads();
        for (int c = 0; c < NCH; ++c) {
            if (MODE == 2) { __syncthreads(); continue; }
            const LAS float* cb = buf + (c & 1) * BUFF + ks;
            const LAS float* cv = buf + (c & 1) * BUFF + 64 + vidx;
            const bool emit = c >= CTXL / TC;
            f32x4 R_[2], A_[2], W_[2], K_[2], B_[2]; float V_[2];
#define SCAN_LD(sl, st) do { const LAS float* bs = cb + (st) * STEPF; R_[sl] = *(const LAS f32x4*)(bs); A_[sl] = *(const LAS f32x4*)(bs + 128); W_[sl] = *(const LAS f32x4*)(bs + 192); \
            K_[sl] = *(const LAS f32x4*)(bs + 256); B_[sl] = *(const LAS f32x4*)(bs + 320); V_[sl] = cv[(st) * STEPF]; } while (0)
            SCAN_LD(0, 0); SCAN_LD(1, 1);
            float ykeep = 0.f;
#pragma unroll
            for (int st = 0; st < TC; ++st) {
                const int sl = st & 1;
                const f32x4 r4 = R_[sl], a4 = A_[sl], w4 = W_[sl], k4 = K_[sl], b4 = B_[sl]; const float vv = V_[sl];
                if (st + 2 < TC) SCAN_LD(sl, st + 2);
                f32x2 t = S01 * (f32x2){a4.x, a4.y}; t = S23 * (f32x2){a4.z, a4.w} + t;
                const float sa = rowsum16(t.x + t.y);
                S01 = (S01 * (f32x2){w4.x, w4.y} + (f32x2){k4.x, k4.y} * vv) + (f32x2){b4.x, b4.y} * sa;
                S23 = (S23 * (f32x2){w4.z, w4.w} + (f32x2){k4.z, k4.w} * vv) + (f32x2){b4.z, b4.w} * sa;
                f32x2 yq = S01 * (f32x2){r4.x, r4.y}; yq = S23 * (f32x2){r4.z, r4.w} + yq;
                const float y = rowsum16(yq.x + yq.y);
                ykeep = (l15 == (st & 15)) ? y : ykeep;
                if ((st & 15) == 15 && emit) { const int row = scan_row(c * TC + (st - 15) + l15, b, d); ydst[(size_t)row * PP] = (bf16)(pk2(ykeep, 0.f) & 0xffffu); }
            }
#undef SCAN_LD
            __syncthreads();
        }
        __builtin_amdgcn_s_setprio(0);
    }
}

template <int DUMMY> DI void phase_attention(const Params& p, LAS unsigned char* lds, int tid, int wave, int lane, int vcu, int G) {
    bf16* Pm = (bf16*)(p.ws + WS_P); const bf16* KP = (const bf16*)(p.ws + WS_KP); const bf16* VT = (const bf16*)(p.ws + WS_VT);
    LAS unsigned char* Kl = lds;
    LAS unsigned char* Vl = lds + 55296;
    const int r = lane & 31, hh = lane >> 5, g = wave >> 1, qsub = wave & 1;
    for (int u = vcu; u < 512; u += G) {
        const int b = u >> 7, kvh = (u >> 6) & 1, qb = u & 63, head = kvh * 4 + g, qlo = qb * 128 + qsub * 64;
        bf16x8 qf[2][4];
#pragma unroll
        for (int qblk = 0; qblk < 2; ++qblk) {
            const int t = qlo + qblk * 32 + r; const bf16* src = Pm + (size_t)(b * SEQ + t) * PP + head * 64 + 8 * hh;
            float qv[4][8];
#pragma unroll
            for (int c = 0; c < 4; ++c) unpack8(*(const u32x4*)(src + 16 * c), qv[c]);
            const float prow = (float)(t >> 6), pcol = (float)(t & 63);
            float n0[8], n1[8], n2[8], n3[8];
#pragma unroll
            for (int e = 0; e < 8; ++e) { const float inv = exp2f(-(float)(8 * hh + e) * 0.8304820237f);
                const float a1 = prow * inv, s1 = __sinf(a1), c1 = __cosf(a1), a2 = pcol * inv, s2 = __sinf(a2), c2 = __cosf(a2); const float sc = 0.125f * LOG2E;
                n0[e] = (qv[0][e] * c1 - qv[1][e] * s1) * sc; n1[e] = (qv[1][e] * c1 + qv[0][e] * s1) * sc; n2[e] = (qv[2][e] * c2 - qv[3][e] * s2) * sc; n3[e] = (qv[3][e] * c2 + qv[2][e] * s2) * sc; }
            qf[qblk][0] = pack8(n0); qf[qblk][1] = pack8(n1); qf[qblk][2] = pack8(n2); qf[qblk][3] = pack8(n3);
        }
        f32x16 O[2][2]; float m_[2], l_[2];
#pragma unroll
        for (int q = 0; q < 2; ++q) { m_[q] = p.att_sink[head] * LOG2E; l_[q] = hh == 0 ? 1.0f : 0.0f;
#pragma unroll
            for (int dblk = 0; dblk < 2; ++dblk)
#pragma unroll
                for (int i = 0; i < 16; ++i) O[q][dblk][i] = 0.f; }
        for (int round = 0; round < 2; ++round) {
            const int nslots = round ? 256 : 384;
            __syncthreads();
            for (int i = tid; i < nslots * 8; i += NTHR) { const int slot = i >> 3, ch = i & 7; int pos; bool valid = true;
                if (round == 0) { const int kl = (qb - 1) * 128 + slot; valid = kl >= 0 && kl < SEQ; pos = CTXL + kl; } else pos = slot;
                u32x4 v = {0u, 0u, 0u, 0u}; if (valid) v = *(const u32x4*)(KP + ((size_t)(b * 2 + kvh) * NPOS + pos) * 64 + ch * 8);
                *(LAS u32x4*)(Kl + slot * 144 + ch * 16) = v; }
            const int nch = nslots >> 3;
            for (int i = tid; i < 64 * nch; i += NTHR) { const int dd = i / nch, ch = i % nch, slot0 = ch * 8; int pos0; bool valid = true;
                if (round == 0) { const int kl0 = (qb - 1) * 128 + slot0; valid = kl0 >= 0 && kl0 < SEQ; pos0 = CTXL + kl0; } else pos0 = slot0;
                u32x4 v = {0u, 0u, 0u, 0u}; if (valid) v = *(const u32x4*)(VT + ((size_t)(b * 2 + kvh) * 64 + dd) * NPOS + pos0);
                LAS u32x2* dst = (LAS u32x2*)(Vl + dd * 776 + slot0 * 2); dst[0] = (u32x2){v.x, v.y}; dst[1] = (u32x2){v.z, v.w}; }
            __syncthreads();
            const int tlo = round ? 0 : 2 * qsub, thi = round ? 8 : 2 * qsub + 10;
            for (int T = tlo; T < thi; ++T) {
                bf16x8 kf[4], vf[2][2];
#pragma unroll
                for (int c = 0; c < 4; ++c) kf[c] = *(const LAS bf16x8*)(Kl + (T * 32 + r) * 144 + (16 * c + 8 * hh) * 2);
#pragma unroll
                for (int dblk = 0; dblk < 2; ++dblk)
#pragma unroll
                    for (int s = 0; s < 2; ++s) { const LAS u32x2* vp = (const LAS u32x2*)(Vl + (dblk * 32 + r) * 776 + (T * 32 + 16 * s + 4 * hh) * 2); const u32x2 lo = vp[0], hi = vp[2];
                        vf[dblk][s] = __builtin_bit_cast(bf16x8, (u32x4){lo.x, lo.y, hi.x, hi.y}); }
#pragma unroll
                for (int q = 0; q < 2; ++q) {
                    f32x16 S;
#pragma unroll
                    for (int i = 0; i < 16; ++i) S[i] = 0.f;
#pragma unroll
                    for (int c = 0; c < 4; ++c) S = __builtin_amdgcn_mfma_f32_32x32x16_bf16(kf[c], qf[q][c], S, 0, 0, 0);
                    const int kb0w = (qb - 1) * 128 + T * 32;
                    const bool need_mask = round == 0 && !(kb0w >= 0 && kb0w + 31 < SEQ && kb0w >= qlo - 65 && kb0w <= qlo + 97);
                    if (need_mask) { const int ql = qlo + q * 32 + r, kb0 = kb0w;
#pragma unroll
                        for (int i = 0; i < 16; ++i) { const int kl = kb0 + crow(i, hh); const int dlt = ql - kl; const bool ok = kl >= 0 && kl < SEQ && dlt <= 128 && dlt >= -128; S[i] = ok ? S[i] : -INFINITY; } }
                    float tmax = S[0];
#pragma unroll
                    for (int i = 1; i < 16; ++i) tmax = fmaxf(tmax, S[i]);
                    tmax = fmaxf(tmax, __shfl_xor(tmax, 32));
                    const float mnew = fmaxf(m_[q], tmax), alpha = __builtin_amdgcn_exp2f(m_[q] - mnew);
                    m_[q] = mnew;
                    float pe[16]; float ps = 0.f;
#pragma unroll
                    for (int i = 0; i < 16; ++i) { pe[i] = __builtin_amdgcn_exp2f(S[i] - mnew); ps += pe[i]; }
                    l_[q] = l_[q] * alpha + ps;
                    if (__any(alpha != 1.0f)) {
#pragma unroll
                    for (int dblk = 0; dblk < 2; ++dblk)
#pragma unroll
                        for (int i = 0; i < 16; ++i) O[q][dblk][i] *= alpha; }
                    bf16x8 pf[2];
#pragma unroll
                    for (int s = 0; s < 2; ++s) { u32x4 w; w.x = pk2(pe[8 * s], pe[8 * s + 1]); w.y = pk2(pe[8 * s + 2], pe[8 * s + 3]); w.z = pk2(pe[8 * s + 4], pe[8 * s + 5]); w.w = pk2(pe[8 * s + 6], pe[8 * s + 7]);
                        pf[s] = __builtin_bit_cast(bf16x8, w); }
#pragma unroll
                    for (int dblk = 0; dblk < 2; ++dblk)
#pragma unroll
                        for (int s = 0; s < 2; ++s) O[q][dblk] = __builtin_amdgcn_mfma_f32_32x32x16_bf16(vf[dblk][s], pf[s], O[q][dblk], 0, 0, 0);
                }
            }
        }
#pragma unroll
        for (int q = 0; q < 2; ++q) {
            const float lt = l_[q] + __shfl_xor(l_[q], 32), inv = __builtin_amdgcn_rcpf(lt);
            bf16* dst = Pm + (size_t)(b * SEQ + qlo + q * 32 + r) * PP + head * 64 + (DUMMY ? 1024 : 0);
#pragma unroll
            for (int dblk = 0; dblk < 2; ++dblk)
#pragma unroll
                for (int gi = 0; gi < 4; ++gi) { const f32x4 v = {O[q][dblk][4 * gi] * inv, O[q][dblk][4 * gi + 1] * inv, O[q][dblk][4 * gi + 2] * inv, O[q][dblk][4 * gi + 3] * inv};
                    st4bf(dst + dblk * 32 + 8 * gi + 4 * hh, v); }
        }
    }
}

DI void phase_rwkv_out(const Params& p, LAS unsigned char* lds, int tid, int wave, int lane, int vcu, int G) {
    bf16* Pm = (bf16*)(p.ws + WS_P); const bf16* SH = (const bf16*)(p.ws + WS_SH); const float* BC = (const float*)(p.ws + WS_BC); const bf16* G2T = (const bf16*)(p.ws + WS_G2T);
    constexpr int GP = 136;
    LAS bf16* T = (LAS bf16*)lds;
    const int h = wave, tq = lane >> 4, cl = lane & 15, c0 = h * 64 + 4 * cl;
    const f32x4 lnw = *(const f32x4*)(p.rwkv_ln_w + c0), lnb = *(const f32x4*)(p.rwkv_ln_b + c0);
    for (int u = vcu; u < ML / 16; u += G) {
        const int R0 = u * 16, seq0 = (R0 / SEQ) * SEQ;
        bf16x8 gw_[16];
#pragma unroll
        for (int q = 0; q < 16; ++q) gw_[q] = *(const bf16x8*)(G2T + (size_t)(c0 + (q & 3)) * 128 + (q >> 2) * 32 + tq * 8);
        u32x2 yf_[4], yb_[4], vw_[4]; float bc_[4];
#pragma unroll
        for (int j = 0; j < 4; ++j) { const int row = R0 + 4 * tq + j;
            yf_[j] = *(const u32x2*)(Pm + (size_t)row * PP + 1024 + c0); yb_[j] = *(const u32x2*)(Pm + (size_t)row * PP + 1536 + c0);
            vw_[j] = *(const u32x2*)(SH + ((size_t)row * 8 + h) * 192 + 64 + 4 * cl); bc_[j] = BC[row * 8 + h]; }
        __syncthreads();
        for (int i = tid; i < 18 * 16; i += NTHR) { const int rr = i >> 4, ch = i & 15, row = R0 - 1 + rr;
            u32x4 v = {0u, 0u, 0u, 0u}; if (row >= seq0 && row < seq0 + SEQ) v = *(const u32x4*)(Pm + (size_t)row * PP + RWC + 1792 + ch * 8);
            *(LAS u32x4*)(T + rr * GP + ch * 8) = v; }
        __syncthreads();
        f32x4 gate[4];
#pragma unroll
        for (int nt = 0; nt < 4; ++nt) gate[nt] = (f32x4){0.f, 0.f, 0.f, 0.f};
#pragma unroll
        for (int ks = 0; ks < 4; ++ks) {
            const int cb = ks * 32 + tq * 8, tok = lane & 15;
            float pv[8], cv[8], nv[8], a8[8];
            unpack8(*(const LAS u32x4*)(T + tok * GP + cb), pv); unpack8(*(const LAS u32x4*)(T + (tok + 1) * GP + cb), cv); unpack8(*(const LAS u32x4*)(T + (tok + 2) * GP + cb), nv);
            const f32x4 m0 = *(const f32x4*)(p.rwkv_mu + 1792 + cb), m1 = *(const f32x4*)(p.rwkv_mu + 1792 + cb + 4);
#pragma unroll
            for (int e = 0; e < 8; ++e) { const float mu = e < 4 ? m0[e] : m1[e - 4]; a8[e] = sigmoidf_(cv[e] + mu * (0.5f * (pv[e] + nv[e]) - cv[e])); }
            const bf16x8 a = pack8(a8);
#pragma unroll
            for (int nt = 0; nt < 4; ++nt) gate[nt] = __builtin_amdgcn_mfma_f32_16x16x32_bf16(a, gw_[ks * 4 + nt], gate[nt], 0, 0, 0);
        }
#pragma unroll
        for (int j = 0; j < 4; ++j) {
            const int row = R0 + 4 * tq + j;
            const u32x2 yf = yf_[j], yb = yb_[j];
            const f32x4 y = (f32x4){bf_lo(yf.x), bf_hi(yf.x), bf_lo(yf.y), bf_hi(yf.y)} + (f32x4){bf_lo(yb.x), bf_hi(yb.x), bf_lo(yb.y), bf_hi(yb.y)};
            const float mean = rowsum16((y.x + y.y) + (y.z + y.w)) * (1.0f / 64.0f);
            const f32x4 dv = y - mean;
            const float var = rowsum16((dv.x * dv.x + dv.y * dv.y) + (dv.z * dv.z + dv.w * dv.w)) * (1.0f / 64.0f);
            const float rstd = rsqrtf(var + 64e-5f);
            const u32x2 vw = vw_[j];
            const f32x4 v4 = {bf_lo(vw.x), bf_hi(vw.x), bf_lo(vw.y), bf_hi(vw.y)};
            const float bc = bc_[j];
            const f32x4 gt = {gate[0][j], gate[1][j], gate[2][j], gate[3][j]};
            const f32x4 o = (dv * rstd * lnw + lnb + v4 * bc) * gt;
            st4bf(Pm + (size_t)row * PP + 512 + c0, o);
        }
    }
}

DI void ld8f(const bf16* src, float (&o)[8]) { unpack8(*(const u32x4*)src, o); }
DI void phase_conv(const Params& p, int wave, int lane, int vcu, int G) {
    const bf16* Gm = (const bf16*)(p.ws + WS_G); bf16* Z = (bf16*)(p.ws + WS_Z);
    const int gw = vcu * NWAVES + wave, ngw = G * NWAVES;
    for (int row = gw; row < ML; row += ngw) {
        const int t = row % SEQ;
#pragma unroll
        for (int j = 0; j < 2; ++j) {
            const int col = 8 * lane + 512 * j; const bf16* base = Gm + (size_t)row * 3072 + col;
            float gb[8], gc[8], uu[8], qp[8], qn[8], z[8];
            ld8f(base, gb); ld8f(base + 1024, gc); ld8f(base + 2048, uu);
            if (t > 0) { float a[8], c[8]; ld8f(base - 3072 + 1024, a); ld8f(base - 3072 + 2048, c);
#pragma unroll
                for (int e = 0; e < 8; ++e) qp[e] = a[e] * c[e]; } else {
#pragma unroll
                for (int e = 0; e < 8; ++e) qp[e] = 0.f; }
            if (t < SEQ - 1) { float a[8], c[8]; ld8f(base + 3072 + 1024, a); ld8f(base + 3072 + 2048, c);
#pragma unroll
                for (int e = 0; e < 8; ++e) qn[e] = a[e] * c[e]; } else {
#pragma unroll
                for (int e = 0; e < 8; ++e) qn[e] = 0.f; }
#pragma unroll
            for (int e = 0; e < 8; ++e) z[e] = gb[e] * (p.conv_w[col + e] * qp[e] + p.conv_w[1024 + col + e] * (gc[e] * uu[e]) + p.conv_w[2048 + col + e] * qn[e]);
            *(u32x4*)(Z + (size_t)row * DM + col) = __builtin_bit_cast(u32x4, pack8(z));
        }
    }
}

#define RLX_AGENT __ATOMIC_RELAXED, __HIP_MEMORY_SCOPE_AGENT
#define XB_TMO      128
#define XB_XCNT(j)  (256  + 64 * (j))
#define XB_XSUB(j)  (1280 + 64 * (j))
#define XB_XGEN(j)  (2304 + 64 * (j))
#define XB_TOP      3328
#define XB_TOPGEN   3392
#define XCD_BAR_WORDS 3456
#define XB_SPIN_CAP (1u << 18)

__device__ __forceinline__ unsigned xb_ld(unsigned* p)              { return __hip_atomic_load(p, __ATOMIC_RELAXED, __HIP_MEMORY_SCOPE_AGENT); }
__device__ __forceinline__ unsigned xb_add(unsigned* p, unsigned v) { return __hip_atomic_fetch_add(p, v, __ATOMIC_RELAXED, __HIP_MEMORY_SCOPE_AGENT); }
__device__ __forceinline__ unsigned xb_xcc_id() { return (unsigned)__builtin_amdgcn_s_getreg((3 << 11) | 20) & 0xFu; }
#define XB_SPIN(cond, bar) do { unsigned _sp = 0; while (cond) { __builtin_amdgcn_s_sleep(1); \
    if ((++_sp & 255u) == 0u) { if (xb_ld(&(bar)[XB_TMO])) break; if (_sp > XB_SPIN_CAP) { atomicAdd(&(bar)[XB_TMO], 1u); break; } } } } while (0)

struct XcdBarrier {
    unsigned* bar; unsigned x;
    volatile LAS unsigned* st;
};

__device__ __forceinline__ XcdBarrier xcd_barrier_post(unsigned* bar, volatile LAS unsigned* st) {
    XcdBarrier b; b.bar = bar; b.x = xb_xcc_id(); b.st = st;
    if (threadIdx.x == 0) (void)xb_add(&bar[XB_XCNT(b.x)], 1u);
    return b;
}
__device__ __forceinline__ void xcd_barrier_complete(unsigned* bar, unsigned x, unsigned& nloc, unsigned& nx) {
    const unsigned G = gridDim.x * gridDim.y * gridDim.z;
    unsigned sum, cnt, mine, sp = 0u;
    for (;;) {
        sum = 0u; cnt = 0u; mine = 0u;
#pragma unroll
        for (unsigned j = 0; j < 16; ++j) { const unsigned c = xb_ld(&bar[XB_XCNT(j)]); sum += c; cnt += (c > 0u) ? 1u : 0u; mine = (j == x) ? c : mine; }
        if (sum == G) break;
        __builtin_amdgcn_s_sleep(1);
        if ((++sp & 255u) == 0u) { if (xb_ld(&bar[XB_TMO])) break; if (sp > XB_SPIN_CAP) { atomicAdd(&bar[XB_TMO], 1u); break; } }
    }
    nloc = mine > 0u ? mine : 1u; nx = cnt > 0u ? cnt : 1u;
}

__device__ __forceinline__ void xcd_barrier(const XcdBarrier& b) {
    asm volatile("s_waitcnt vmcnt(0)" ::: "memory");
    __syncthreads();
    if (threadIdx.x == 0) {
        unsigned* bar = b.bar;
        __builtin_amdgcn_s_waitcnt(0);
        unsigned nloc = b.st[0], nx = b.st[1];
        if (nloc == 0u) { xcd_barrier_complete(bar, b.x, nloc, nx); b.st[0] = nloc; b.st[1] = nx; }
        const unsigned old = xb_add(&bar[XB_XSUB(b.x)], 1u);
        const unsigned gen = old / nloc;
        if (old + 1u == (gen + 1u) * nloc) {
            __builtin_amdgcn_fence(__ATOMIC_RELEASE, "agent");
            asm volatile("s_waitcnt vmcnt(0)" ::: "memory");
            const unsigned og = xb_add(&bar[XB_TOP], 1u);
            const unsigned tg = og / nx;
            if (og + 1u == (tg + 1u) * nx) xb_add(&bar[XB_TOPGEN], 1u);
            else XB_SPIN(xb_ld(&bar[XB_TOPGEN]) == tg, bar);
            __builtin_amdgcn_fence(__ATOMIC_ACQUIRE, "agent");
            xb_add(&bar[XB_XGEN(b.x)], 1u);
            asm volatile("s_waitcnt vmcnt(0)" ::: "memory");
        } else {
            XB_SPIN(xb_ld(&bar[XB_XGEN(b.x)]) == gen, bar);
            __builtin_amdgcn_fence(__ATOMIC_ACQUIRE, "agent");
            asm volatile("s_waitcnt vmcnt(0)" ::: "memory");
        }
    }
    __syncthreads();
}

constexpr int N_PHASES = 18;
constexpr int PROBE = 0;
template <int ACT>
DI void run_gemm(LAS unsigned char* lds, const bf16* A, int lda, const bf16* Bt, int M, int N, int K, bf16* O, int ldc, int G) {
    pg8::Gemm g{A, Bt, M, N, K, lda}; pg8::StaticOrder S; S.init(M, N, G, (int)blockIdx.x);
    pg8::EpiBf16<ACT> E{O, ldc, nullptr, 0, 0, 1.f};
    pg8::gemm_phase<pg8::EpiBf16<ACT>, pg8::StaticOrder, true, true>(lds, g, S, E);
}

__global__ void __launch_bounds__(NTHR, 2) mega_fwd(Params p) {
    extern __shared__ __attribute__((aligned(16))) unsigned char lds_raw[];
    LAS unsigned char* lds = (LAS unsigned char*)lds_raw;
    cg::grid_group grid = cg::this_grid();
    const int tid = threadIdx.x, lane = tid & 63, wave = __builtin_amdgcn_readfirstlane(tid >> 6);
    const int G = gridDim.x, bx = blockIdx.x, vcu = (G % 8 == 0) ? (bx % 8) * (G / 8) + bx / 8 : bx;
    unsigned char* ws = p.ws;
    volatile LAS unsigned* misc = (volatile LAS unsigned*)(lds + 131072);
    if (tid < 32) misc[tid] = 0u;
    __syncthreads();
    if (bx == 0) for (int i = tid; i < (int)(WS_BAR_BYTES / 4); i += NTHR) ((unsigned*)(ws + WS_BAR))[i] = 0u;
    XcdBarrier xbar; xbar.bar = (unsigned*)(ws + WS_BAR); xbar.x = 0; xbar.st = misc + 8;
    const float* mod0 = (const float*)(ws + WS_MOD); const float* mod1 = mod0 + 5 * 6144;
    const float* ng0 = p.norm_g; const float* ng1 = p.norm_g + 4 * DM;
#define IN(k) (p.ph_lo <= (k) && (k) < p.ph_hi)
#define SEAM(k) do { if (IN(k) && IN((k) + 1)) { if ((k) == 0) grid.sync(); else xcd_barrier(xbar); } } while (0)
    if (IN(0)) { phase_prologue(p, lds, tid, wave, lane, vcu, G); if (PROBE == 7) { __syncthreads(); phase_prologue(p, lds, tid, wave, lane, vcu, G); } }
    SEAM(0);
    xbar = xcd_barrier_post((unsigned*)(ws + WS_BAR), misc + 8);
    if (IN(1)) phase_norm0(p, wave, lane, vcu, G);
    SEAM(1);
    if (IN(2)) run_gemm<0>(lds, (const bf16*)(ws + WS_A0), DM, (const bf16*)(ws + WS_WINT), MT, PP, DM, (bf16*)(ws + WS_P), PP, G);
    SEAM(2);
    if (IN(3)) { phase_features(p, lds, tid, wave, lane, vcu, G);  }
    SEAM(3);
    if (IN(4)) { if (PROBE == 8) { phase_attention<1>(p, lds, tid, wave, lane, vcu, G); __syncthreads(); }
        for (int su = vcu; su < 256; su += G) phase_scan<0>(p, lds, tid, wave, lane, su); __syncthreads(); if (PROBE == 2) { for (int su = vcu; su < 256; su += G) phase_scan<0>(p, lds, tid, wave, lane, su); __syncthreads(); }
        if (PROBE == 5) { for (int su = vcu; su < 256; su += G) phase_scan<1>(p, lds, tid, wave, lane, su); __syncthreads(); }
        if (PROBE == 6) { for (int su = vcu; su < 256; su += G) phase_scan<2>(p, lds, tid, wave, lane, su); __syncthreads(); } }
    SEAM(4);
    if (IN(5)) { phase_rwkv_out(p, lds, tid, wave, lane, vcu, G); __syncthreads(); phase_weights2(p, lds, wave, lane, vcu, G);
        if (PROBE == 9) { __syncthreads(); phase_rwkv_out(p, lds, tid, wave, lane, vcu, G); __syncthreads(); phase_weights2(p, lds, wave, lane, vcu, G); }
        if (PROBE == 3) { __syncthreads(); phase_weights2(p, lds, wave, lane, vcu, G); } if (PROBE == 4) { __syncthreads(); phase_rwkv_out(p, lds, tid, wave, lane, vcu, G); } }
    SEAM(5);
    if (IN(6)) run_gemm<0>(lds, (const bf16*)(ws + WS_P), PP, (const bf16*)(ws + WS_WOUTT), ML, DM, DM, (bf16*)(ws + WS_YL), DM, G);
    SEAM(6);
    if (IN(7)) { phase_norm1<false, true>((const bf16*)(ws + WS_YL), p.x, ws + WS_XLB, ng0 + DM, mod0, 2048, ng0 + 2 * DM, 3072, 4096, (bf16*)(ws + WS_A1), wave, lane, vcu, G);
        if (PROBE == 1) phase_norm1<false, true>((const bf16*)(ws + WS_YL), p.x, ws + WS_XLB, ng0 + DM, mod0, 2048, ng0 + 2 * DM, 3072, 4096, (bf16*)(ws + WS_A1), wave, lane, vcu, G); }
    SEAM(7);
    if (IN(8)) run_gemm<1>(lds, (const bf16*)(ws + WS_A1), DM, (const bf16*)(ws + WS_W1T0), ML, HID, DM, (bf16*)(ws + WS_H), HID, G);
    SEAM(8);
    if (IN(9)) run_gemm<0>(lds, (const bf16*)(ws + WS_H), HID, (const bf16*)(ws + WS_W2T0), ML, DM, HID, (bf16*)(ws + WS_YL), DM, G);
    SEAM(9);
    if (IN(10)) phase_norm1<true, true>((const bf16*)(ws + WS_YL), ws + WS_XLB, ws + WS_XLB, ng0 + 3 * DM, mod0, 5120, ng1, 30720, 30720 + 1024, (bf16*)(ws + WS_A1), wave, lane, vcu, G);
    SEAM(10);
    if (IN(11)) run_gemm<0>(lds, (const bf16*)(ws + WS_A1), DM, (const bf16*)(ws + WS_CINT), ML, 3 * DM, DM, (bf16*)(ws + WS_G), 3 * DM, G);
    SEAM(11);
    if (IN(12)) phase_conv(p, wave, lane, vcu, G);
    SEAM(12);
    if (IN(13)) run_gemm<0>(lds, (const bf16*)(ws + WS_Z), DM, (const bf16*)(ws + WS_COUTT), ML, DM, DM, (bf16*)(ws + WS_YL), DM, G);
    SEAM(13);
    if (IN(14)) phase_norm1<true, true>((const bf16*)(ws + WS_YL), ws + WS_XLB, ws + WS_XLB, ng1 + DM, mod1, 2048, ng1 + 2 * DM, 3072, 4096, (bf16*)(ws + WS_A1), wave, lane, vcu, G);
    SEAM(14);
    if (IN(15)) run_gemm<1>(lds, (const bf16*)(ws + WS_A1), DM, (const bf16*)(ws + WS_W1T1), ML, HID, DM, (bf16*)(ws + WS_H), HID, G);
    SEAM(15);
    if (IN(16)) run_gemm<0>(lds, (const bf16*)(ws + WS_H), HID, (const bf16*)(ws + WS_W2T1), ML, DM, HID, (bf16*)(ws + WS_YL), DM, G);
    SEAM(16);
    if (IN(17)) phase_norm1<true, false>((const bf16*)(ws + WS_YL), ws + WS_XLB, p.out, ng1 + 3 * DM, mod1, 5120, nullptr, 0, 0, nullptr, wave, lane, vcu, G);
#undef IN
#undef SEAM
}

extern "C" void kernel_launch(void* const* d_in, const int* in_sizes, int n_in, void* d_out, int out_size, void* d_ws, size_t ws_size, hipStream_t stream) {
    static int grid = 0;
    if (grid == 0) {
        if (n_in != 26 || out_size != ML * DM || ws_size < WS_END) { fprintf(stderr, "kernel_launch: unexpected shapes (n_in %d out %d ws %zu)\n", n_in, out_size, ws_size); grid = -1; return; }
        int dev = 0, cus = 0, per_cu = 0;
        (void)hipGetDevice(&dev); (void)hipDeviceGetAttribute(&cus, hipDeviceAttributeMultiprocessorCount, dev);
        if (hipFuncSetAttribute((const void*)mega_fwd, hipFuncAttributeMaxDynamicSharedMemorySize, LDS_BYTES) != hipSuccess) { fprintf(stderr, "kernel_launch: hipFuncSetAttribute failed\n"); grid = -1; return; }
        if (hipOccupancyMaxActiveBlocksPerMultiprocessor(&per_cu, (const void*)mega_fwd, NTHR, LDS_BYTES) != hipSuccess || per_cu < 1) per_cu = 1;
        (void)hipGetLastError();
        grid = cus * per_cu; if (grid > 256) grid = 256; if (grid < 1) grid = 256;
    }
    if (grid < 0) return;
    Params p{};
    const float** f = (const float**)&p;
    for (int i = 0; i < 26; ++i) f[i] = (const float*)d_in[i];
    p.out = (float*)d_out; p.ws = (unsigned char*)d_ws;
#ifndef MK_SPLIT
    p.ph_lo = 0; p.ph_hi = N_PHASES;
    void* args[] = {&p};
    hipError_t e = hipLaunchCooperativeKernel((void*)mega_fwd, dim3(grid), dim3(NTHR), args, LDS_BYTES, stream);
    if (e != hipSuccess) fprintf(stderr, "cooperative launch failed: %s (grid %d)\n", hipGetErrorString(e), grid);
#else
    for (int k = 0; k < N_PHASES; ++k) { p.ph_lo = k; p.ph_hi = k + 1; void* args[] = {&p};
        hipError_t e = hipLaunchCooperativeKernel((void*)mega_fwd, dim3(grid), dim3(NTHR), args, LDS_BYTES, stream);
        if (e != hipSuccess) { fprintf(stderr, "launch %d failed: %s\n", k, hipGetErrorString(e)); break; } }
#endif
}
```

```cpp
#include <hip/hip_runtime.h>
#include <hip/hip_cooperative_groups.h>
#include <cstdio>
#include <cstdint>
namespace cg = cooperative_groups;
namespace pg8 {
#define PG8_LAS __attribute__((address_space(3)))
typedef unsigned short bf16_t;
typedef short bf16x8 __attribute__((ext_vector_type(8)));
typedef float f32x4 __attribute__((ext_vector_type(4)));
typedef unsigned u32x4 __attribute__((ext_vector_type(4)));
constexpr int BM = 256, BK = 64, HALF = 128, HTB = HALF * BK * 2  , STAGE_BYTES = 8 * HTB, NXCD = 8, WGM = 4;

__host__ __device__ __forceinline__ int lds_byte(int r, int c) { const int st = (r >> 4) * 2 + (c >> 5), rr = r & 15, cc = c & 31, ob = rr * 64 + cc * 2; return st * 1024 + (ob ^ (((ob >> 9) & 1) << 5)); }
__host__ __device__ __forceinline__ void stage_rc(int b, int& R, int& C) { const int st = b / 1024, sb = b % 1024, swz = sb ^ (((sb >> 9) & 1) << 5); R = (st >> 1) * 16 + swz / 64; C = (st & 1) * 32 + (swz % 64) / 2; }
__host__ __device__ __forceinline__ int perm32(int rho) { const int n = rho >> 4, i = rho & 15; return 8 * (i >> 2) + 4 * n + (i & 3); }

struct Unit { int pm, pn; };
struct Gemm { const bf16_t* A; const bf16_t* Bt; int M, N, K, lda; };

struct StaticOrder {
    int nM, nN, nwg, G, c;
    __host__ __device__ void init(int M, int N, int G_, int c_) { nM = M / BM; nN = N / BM; nwg = nM * nN; G = G_; c = c_; }
    __host__ __device__ bool next(int i, Unit& u) const {
        const long L = (long)i * G + c; if (L >= nwg) return false;
        int wgid = (int)L; { const int q = nwg / NXCD, r = nwg % NXCD, xcd = wgid % NXCD, off = wgid / NXCD; wgid = (xcd < r ? xcd * (q + 1) : r * (q + 1) + (xcd - r) * q) + off; }
        const int nig = WGM * nN, gid = wgid / nig, fm = gid * WGM, gsz = (nM - fm) < WGM ? (nM - fm) : WGM;
        u.pm = fm + ((wgid % nig) % gsz); u.pn = (wgid % nig) / gsz; return true;
    }
    __device__ __forceinline__ void a_ready(const Unit&) const {}
    __device__ __forceinline__ void done(const Unit&) const {}
};

__device__ __forceinline__ unsigned cvt_pk_bf16(float lo, float hi) { unsigned r; asm volatile("v_cvt_pk_bf16_f32 %0, %1, %2" : "=v"(r) : "v"(lo), "v"(hi)); return r; }
typedef float f32x2 __attribute__((ext_vector_type(2)));
__device__ __forceinline__ f32x2 gelu_pk(f32x2 v) {
    const f32x2 av = __builtin_elementwise_abs(v), d = av * 0.2316418882f + 1.0f;
    f32x2 t; t.x = __builtin_amdgcn_rcpf(d.x); t.y = __builtin_amdgcn_rcpf(d.y);
    f32x2 q = t * 0.5307027145f + (-0.7265760135f); q = q * t + 0.7107068705f; q = q * t + (-0.142248368f); q = q * t + 0.127414796f; q = q * t;
    const f32x2 s = (v * v) * (-0.72134752044f);
    f32x2 e; e.x = __builtin_amdgcn_exp2f(s.x); e.y = __builtin_amdgcn_exp2f(s.y);
    const f32x2 m = v * (q * e), r = v - m;
    f32x2 o; o.x = v.x < 0.f ? m.x : r.x; o.y = v.y < 0.f ? m.y : r.y; return o;
}

template <int ACT  > struct EpiBf16 {
    static constexpr bool PERM = true, AFTER_DRAIN = false; static_assert(ACT == 0 || ACT == 1, "EpiBf16: ACT is 0 or 1");
    bf16_t* O; int ldc; const float* bias; int split_cols; size_t split_stride; float scale0;
    __device__ __forceinline__ void operator()(const f32x4 (&acc)[2][2][4][2], const Unit& u, int wr, int wc, int fr, int fq) const {
        const int row0 = u.pm * BM + wr * 64 + fr; int colt = u.pn * BM; bf16_t* base = O;
        float sc = 1.f; if (split_cols) { const int t = colt / split_cols; base += (size_t)t * split_stride; colt -= t * split_cols; if (t == 0) sc = scale0; }
        const int col0 = colt + wc * 32 + 8 * fq, bcol0 = u.pn * BM + wc * 32 + 8 * fq;
        f32x4 bv[2][2];
#pragma unroll
        for (int bj = 0; bj < 2; ++bj)
#pragma unroll
            for (int n = 0; n < 2; ++n) bv[bj][n] = bias ? *(const f32x4*)(bias + bcol0 + bj * HALF + 4 * n) : (f32x4){0.f, 0.f, 0.f, 0.f};
#pragma unroll
        for (int ai = 0; ai < 2; ++ai)
#pragma unroll
            for (int m = 0; m < 4; ++m) { bf16_t* rowp = base + (size_t)(row0 + ai * HALF + m * 16) * ldc + col0;
#pragma unroll
                for (int bj = 0; bj < 2; ++bj) { f32x4 v0 = acc[ai][bj][m][0] + bv[bj][0], v1 = acc[ai][bj][m][1] + bv[bj][1];
                    if (ACT == 1) { v0 = __builtin_elementwise_max(v0, (f32x4){0.f, 0.f, 0.f, 0.f}); v1 = __builtin_elementwise_max(v1, (f32x4){0.f, 0.f, 0.f, 0.f}); v0 = v0 * v0; v1 = v1 * v1; }
                    v0 = v0 * sc; v1 = v1 * sc; u32x4 w; w.x = cvt_pk_bf16(v0[0], v0[1]); w.y = cvt_pk_bf16(v0[2], v0[3]); w.z = cvt_pk_bf16(v1[0], v1[1]); w.w = cvt_pk_bf16(v1[2], v1[3]);
                    *(u32x4*)(rowp + bj * HALF) = w; } }
    }
};

template <class Epi, class Sched, bool ALIGN_EPI = false, bool SP2 = false>
__device__ __forceinline__ void gemm_phase(PG8_LAS unsigned char* lds, const Gemm g, const Sched& S, const Epi& E) {
    const int tid = threadIdx.x, wid = __builtin_amdgcn_readfirstlane(tid >> 6), lane = tid & 63, wr = wid >> 2, wc = wid & 3, fr = lane & 15, fq = lane >> 4;
    const int K = g.K, nt = K / BK;
    unsigned voffA[2], voffB[2];
#pragma unroll
    for (int i = 0; i < 2; ++i) { int R, C; stage_rc(tid * 16 + i * 8192, R, C); const int Rb = Epi::PERM ? ((R & ~31) + perm32(R & 31)) : R;
        voffA[i] = (unsigned)(R * g.lda + C) * 2u; voffB[i] = (unsigned)(Rb * K + C) * 2u; }
    const size_t kstep = (size_t)(BK * 2);
    const size_t hstep = (size_t)HALF * K * 2;
    const size_t tstep = 2 * hstep; const size_t hstepA = (size_t)HALF * g.lda * 2, tstepA = 2 * hstepA;
    const unsigned ldsw = (unsigned)wid * 1024u;
    const int aoff = lds_byte(wr * 64 + fr, fq * 8), boff = lds_byte(wc * 32 + fr, fq * 8);
#define PG8_SA(b, h) (((b) * 2 + (h)) * HTB)
#define PG8_SB(b, h) ((4 + (b) * 2 + (h)) * HTB)
#define PG8_STAGE(bufoff, gbase, voff) do { _Pragma("unroll") for (int _i = 0; _i < 2; ++_i) \
        __builtin_amdgcn_global_load_lds((const unsigned*)((const char*)(gbase) + (voff)[_i]), (PG8_LAS unsigned*)(lds + (bufoff) + ldsw + _i * 8192), 16, 0, 0); } while (0)
#define PG8_LDA(dst, b, h) do { _Pragma("unroll") for (int m = 0; m < 4; ++m) _Pragma("unroll") for (int k = 0; k < 2; ++k) dst[m][k] = *(const PG8_LAS bf16x8*)(lds + PG8_SA(b, h) + aoff + m * 2048 + k * 1024); } while (0)
#define PG8_LDB(dst, b, h) do { _Pragma("unroll") for (int n = 0; n < 2; ++n) _Pragma("unroll") for (int k = 0; k < 2; ++k) dst[n][k] = *(const PG8_LAS bf16x8*)(lds + PG8_SB(b, h) + boff + n * 2048 + k * 1024); } while (0)
#define PG8_MMA(ai, bj, At, Bt) do { __builtin_amdgcn_s_setprio(1); _Pragma("unroll") for (int m = 0; m < 4; ++m) _Pragma("unroll") for (int n = 0; n < 2; ++n) _Pragma("unroll") for (int k = 0; k < 2; ++k) \
        acc[ai][bj][m][n] = __builtin_amdgcn_mfma_f32_16x16x32_bf16(Bt[n][k], At[m][k], acc[ai][bj][m][n], 0, 0, 0); __builtin_amdgcn_s_setprio(0); } while (0)
#define PG8_WAIT_V(n) asm volatile("s_waitcnt vmcnt(" #n ")" ::: "memory")
#define PG8_WAIT_L(n) asm volatile("s_waitcnt lgkmcnt(" #n ")" ::: "memory")
#define PG8_BAR __builtin_amdgcn_s_barrier()
#define PG8_SCHED __builtin_amdgcn_sched_barrier(0)
    Unit cur, nxt; int ui = 0;
    if (!S.next(0, cur)) return;
    f32x4 acc[2][2][4][2];
#pragma unroll
    for (int a = 0; a < 2; ++a)
#pragma unroll
        for (int b = 0; b < 2; ++b)
#pragma unroll
            for (int m = 0; m < 4; ++m)
#pragma unroll
                for (int n = 0; n < 2; ++n) acc[a][b][m][n] = (f32x4){0.f, 0.f, 0.f, 0.f};
    bf16x8 At[4][2], B0[2][2], B1[2][2];
    const char* cA = (const char*)g.A + (size_t)cur.pm * tstepA; const char* cB = (const char*)g.Bt + (size_t)cur.pn * tstep;
    S.a_ready(cur);
    if constexpr (SP2) {
        PG8_STAGE(PG8_SB(0, 0), cB, voffB); PG8_STAGE(PG8_SB(0, 1), cB + hstep, voffB); PG8_STAGE(PG8_SA(0, 0), cA, voffA); PG8_STAGE(PG8_SA(0, 1), cA + hstepA, voffA);
        if (wr == 1) PG8_BAR;
        PG8_WAIT_V(2); PG8_BAR;
        PG8_STAGE(PG8_SB(1, 0), cB + kstep, voffB); PG8_STAGE(PG8_SA(1, 0), cA + kstep, voffA); PG8_STAGE(PG8_SB(1, 1), cB + hstep + kstep, voffB);
        PG8_WAIT_V(6); PG8_BAR;
    } else {
        PG8_STAGE(PG8_SB(0, 0), cB, voffB); PG8_STAGE(PG8_SA(0, 0), cA, voffA); PG8_STAGE(PG8_SB(0, 1), cB + hstep, voffB); PG8_STAGE(PG8_SA(0, 1), cA + hstepA, voffA);
        if (wr == 1) PG8_BAR;
        PG8_WAIT_V(4); PG8_BAR;
        PG8_STAGE(PG8_SB(1, 0), cB + kstep, voffB); PG8_STAGE(PG8_SA(1, 0), cA + kstep, voffA); PG8_STAGE(PG8_SB(1, 1), cB + hstep + kstep, voffB);
        PG8_WAIT_V(6); PG8_BAR;
    }
    for (;;) {
        const bool has_next = S.next(ui + 1, nxt);
        const char* nA = has_next ? (const char*)g.A + (size_t)nxt.pm * tstepA : cA; const char* nB = has_next ? (const char*)g.Bt + (size_t)nxt.pn * tstep : cB;
        for (int t = 0; t < nt; t += 2) {
            const bool last = (t == nt - 2);
            const char* a1 = cA + (size_t)(t + 1) * kstep;
            const char* a2 = last ? nA : cA + (size_t)(t + 2) * kstep; const char* b2 = last ? nB : cB + (size_t)(t + 2) * kstep;
            const char* a3 = a2 + kstep; const char* b3 = b2 + kstep;
            if (last && has_next) S.a_ready(nxt);
            if constexpr (SP2) {
            PG8_LDB(B0, 0, 0); PG8_LDB(B1, 0, 1); PG8_SCHED; PG8_LDA(At, 0, 0); PG8_STAGE(PG8_SA(1, 1), a1 + hstepA, voffA);
            PG8_WAIT_V(8); PG8_WAIT_L(0); PG8_BAR; PG8_MMA(0, 0, At, B0); PG8_MMA(0, 1, At, B1); PG8_BAR; PG8_SCHED;
            PG8_LDA(At, 0, 1); PG8_STAGE(PG8_SB(0, 0), b2, voffB); PG8_STAGE(PG8_SB(0, 1), b2 + hstep, voffB); PG8_STAGE(PG8_SA(0, 0), a2, voffA);
            PG8_WAIT_V(8); PG8_WAIT_L(0); PG8_BAR; PG8_MMA(1, 0, At, B0); PG8_MMA(1, 1, At, B1); PG8_BAR; PG8_SCHED;
            PG8_LDB(B0, 1, 0); PG8_LDB(B1, 1, 1); PG8_SCHED; PG8_LDA(At, 1, 0); PG8_STAGE(PG8_SA(0, 1), a2 + hstepA, voffA);
            PG8_WAIT_V(8); PG8_WAIT_L(0); PG8_BAR; PG8_MMA(0, 0, At, B0); PG8_MMA(0, 1, At, B1); PG8_BAR; PG8_SCHED;
            PG8_LDA(At, 1, 1); PG8_STAGE(PG8_SB(1, 0), b3, voffB); PG8_STAGE(PG8_SB(1, 1), b3 + hstep, voffB); PG8_STAGE(PG8_SA(1, 0), a3, voffA);
            PG8_WAIT_V(8); PG8_WAIT_L(0); PG8_BAR; PG8_MMA(1, 0, At, B0); PG8_MMA(1, 1, At, B1); PG8_BAR; PG8_SCHED;
            } else {
            PG8_LDB(B0, 0, 0); PG8_SCHED; PG8_LDA(At, 0, 0); PG8_STAGE(PG8_SA(1, 1), a1 + hstepA, voffA);
            PG8_WAIT_L(8); PG8_BAR; PG8_WAIT_L(0); PG8_MMA(0, 0, At, B0); PG8_BAR; PG8_SCHED;
            PG8_LDB(B1, 0, 1); PG8_STAGE(PG8_SB(0, 0), b2, voffB);
            PG8_BAR; PG8_WAIT_L(0); PG8_MMA(0, 1, At, B1); PG8_BAR;
            PG8_LDA(At, 0, 1); PG8_STAGE(PG8_SA(0, 0), a2, voffA);
            PG8_BAR; PG8_WAIT_L(0); PG8_MMA(1, 0, At, B0); PG8_BAR; PG8_SCHED;
            PG8_STAGE(PG8_SB(0, 1), b2 + hstep, voffB);
            PG8_WAIT_V(6); PG8_BAR; PG8_MMA(1, 1, At, B1); PG8_BAR;
            PG8_LDB(B0, 1, 0); PG8_SCHED; PG8_LDA(At, 1, 0); PG8_STAGE(PG8_SA(0, 1), a2 + hstepA, voffA);
            PG8_WAIT_L(8); PG8_BAR; PG8_WAIT_L(0); PG8_MMA(0, 0, At, B0); PG8_BAR; PG8_SCHED;
            PG8_LDB(B1, 1, 1); PG8_STAGE(PG8_SB(1, 0), b3, voffB);
            PG8_BAR; PG8_WAIT_L(0); PG8_MMA(0, 1, At, B1); PG8_BAR;
            PG8_LDA(At, 1, 1); PG8_STAGE(PG8_SA(1, 0), a3, voffA);
            PG8_BAR; PG8_WAIT_L(0); PG8_MMA(1, 0, At, B0); PG8_BAR; PG8_SCHED;
            PG8_STAGE(PG8_SB(1, 1), b3 + hstep, voffB);
            PG8_WAIT_V(6); PG8_BAR; PG8_MMA(1, 1, At, B1); PG8_BAR;
            }
        }
        if constexpr (ALIGN_EPI) { if (wr == 0) PG8_BAR; }
        if constexpr (!Epi::AFTER_DRAIN) { E(acc, cur, wr, wc, fr, fq); S.done(cur); }
        if (!has_next) break;
#pragma unroll
        for (int a = 0; a < 2; ++a)
#pragma unroll
            for (int b = 0; b < 2; ++b)
#pragma unroll
                for (int m = 0; m < 4; ++m)
#pragma unroll
                    for (int n = 0; n < 2; ++n) acc[a][b][m][n] = (f32x4){0.f, 0.f, 0.f, 0.f};
        cur = nxt; cA = nA; cB = nB; ++ui;
        if constexpr (ALIGN_EPI) { if (wr == 1) PG8_BAR; }
    }
    PG8_WAIT_V(0);
    if constexpr (!ALIGN_EPI) { if (wr == 0) PG8_BAR; }
    PG8_BAR;
    if constexpr (Epi::AFTER_DRAIN) { E.fused(acc, cur, wr, wc, fr, fq, lds, wid, lane); S.done(cur); }
#undef PG8_SA
#undef PG8_SB
#undef PG8_STAGE
#undef PG8_LDA
#undef PG8_LDB
#undef PG8_MMA
#undef PG8_WAIT_V
#undef PG8_WAIT_L
#undef PG8_BAR
#undef PG8_SCHED
}
}

#define DI __device__ __forceinline__
#define LAS __attribute__((address_space(3)))
typedef unsigned short bf16;
typedef float f32x2 __attribute__((ext_vector_type(2)));
typedef float f32x4 __attribute__((ext_vector_type(4)));
typedef float f32x16 __attribute__((ext_vector_type(16)));
typedef short bf16x8 __attribute__((ext_vector_type(8)));
typedef unsigned u32x2 __attribute__((ext_vector_type(2)));
typedef unsigned u32x4 __attribute__((ext_vector_type(4)));
typedef __bf16 bfv2 __attribute__((ext_vector_type(2)));

constexpr int NWAVES = 8, NTHR = 512;
constexpr int DM = 1024, NB = 4, SEQ = 8192, CTXL = 256, HID = 4096;
constexpr int ML = NB * SEQ, MC = NB * CTXL, MT = ML + MC;
constexpr int PP = 2816;
constexpr int RWC = 768;
constexpr int NPOS = CTXL + SEQ;
constexpr size_t MiB = 1u << 20;
constexpr size_t WS_BAR = 3 * MiB, WS_BAR_BYTES = 16384;
constexpr size_t WS_MOD = 0, WS_W2T = 256 * 1024, WS_A2T = 384 * 1024, WS_G2T = 512 * 1024, WS_BC = 1 * MiB;
constexpr size_t WS_CC = 4 * MiB;
constexpr size_t WS_WINT = 4 * MiB, WS_WOUTT = 10 * MiB, WS_P = 12 * MiB, WS_KP = 194 * MiB, WS_VT = 203 * MiB;
constexpr size_t WS_SH = 212 * MiB, WS_SD0 = 311 * MiB, WS_SD1 = 410 * MiB, WS_A0 = 212 * MiB;
constexpr size_t WS_W1T0 = 340 * MiB, WS_W2T0 = 348 * MiB, WS_W1T1 = 356 * MiB, WS_W2T1 = 364 * MiB, WS_CINT = 372 * MiB, WS_COUTT = 378 * MiB;
constexpr size_t WS_XLB = 268 * MiB;
constexpr size_t WS_YL = 380 * MiB, WS_A1 = 444 * MiB, WS_H = 12 * MiB, WS_G = 12 * MiB, WS_Z = 204 * MiB, WS_END = 509 * MiB;
constexpr int LDS_BYTES = 147456;
constexpr float LOG2E = 1.4426950408889634f;

struct Params {
    const float *x, *c, *ctx, *c_ctx, *mod_w, *mod_b, *norm_g, *mlp_w1, *mlp_w2, *ab_w_in, *ab_w_out, *att_sink;
    const float *rwkv_mu, *rwkv_w0, *rwkv_w2, *rwkv_a0, *rwkv_a2, *rwkv_g2, *rwkv_kk, *rwkv_ka, *rwkv_rk, *rwkv_ln_w, *rwkv_ln_b;
    const float *conv_w_in, *conv_w, *conv_w_out;
    float* out; unsigned char* ws;
    int ph_lo, ph_hi;
};

DI float bf_lo(unsigned p) { return __uint_as_float(p << 16); }
DI float bf_hi(unsigned p) { return __uint_as_float(p & 0xffff0000u); }
DI float bf1(bf16 v) { return __uint_as_float((unsigned)v << 16); }
DI unsigned pk2(float lo, float hi) { f32x2 v = {lo, hi}; bfv2 r = __builtin_convertvector(v, bfv2); return __builtin_bit_cast(unsigned, r); }
DI float wave_sum(float v) {
#pragma unroll
    for (int o = 1; o < 64; o <<= 1) v += __shfl_xor(v, o);
    return v;
}
#define DPP_ADD(x, ctrl) x += __builtin_bit_cast(float, __builtin_amdgcn_update_dpp(0, __builtin_bit_cast(int, x), ctrl, 0xf, 0xf, true))
DI float rowsum16(float x) { DPP_ADD(x, 0xB1); DPP_ADD(x, 0x4E); DPP_ADD(x, 0x141); DPP_ADD(x, 0x140); return x; }
DI float sigmoidf_(float z) { return __builtin_amdgcn_rcpf(1.0f + __expf(-z)); }
DI float tanhf_(float z) { const float e = __expf(-2.0f * fabsf(z)); const float t = (1.0f - e) * __builtin_amdgcn_rcpf(1.0f + e); return z < 0.f ? -t : t; }

DI void transpose_item(const float* W, int K, int N, bf16* WT, LAS float* scr, int item, int lane) {
    const int nblk = N / 32, kb = item / nblk, nb = item % nblk, k0 = 64 * kb, n0 = 32 * nb;
#pragma unroll 8
    for (int i = 0; i < 32; ++i) { const int kk = 2 * i + (lane >> 5); scr[kk * 33 + (lane & 31)] = W[(size_t)(k0 + kk) * N + n0 + (lane & 31)]; }
    asm volatile("s_waitcnt lgkmcnt(0)" ::: "memory");
    const int c = lane & 7;
#pragma unroll
    for (int j = 0; j < 4; ++j) { const int n = (lane >> 3) + 8 * j; const LAS float* s = scr + (8 * c) * 33 + n;
        u32x4 o; o.x = pk2(s[0 * 33], s[1 * 33]); o.y = pk2(s[2 * 33], s[3 * 33]); o.z = pk2(s[4 * 33], s[5 * 33]); o.w = pk2(s[6 * 33], s[7 * 33]);
        *(u32x4*)(WT + (size_t)(n0 + n) * K + k0 + 8 * c) = o; }
    asm volatile("s_waitcnt lgkmcnt(0)" ::: "memory");
}
DI void transpose_load(const float* W, int N, int item, int lane, float (&t)[32]) {
    const int nblk = N / 32, kb = item / nblk, nb = item % nblk, k0 = 64 * kb, n0 = 32 * nb;
#pragma unroll
    for (int i = 0; i < 32; ++i) t[i] = W[(size_t)(k0 + 2 * i + (lane >> 5)) * N + n0 + (lane & 31)];
}
DI void transpose_store(int K, int N, bf16* WT, LAS float* scr, int item, int lane, const float (&t)[32]) {
    const int nblk = N / 32, kb = item / nblk, nb = item % nblk, k0 = 64 * kb, n0 = 32 * nb;
#pragma unroll
    for (int i = 0; i < 32; ++i) scr[(2 * i + (lane >> 5)) * 33 + (lane & 31)] = t[i];
    asm volatile("s_waitcnt lgkmcnt(0)" ::: "memory");
    const int c = lane & 7;
#pragma unroll
    for (int j = 0; j < 4; ++j) { const int n = (lane >> 3) + 8 * j; const LAS float* s = scr + (8 * c) * 33 + n;
        u32x4 o; o.x = pk2(s[0 * 33], s[1 * 33]); o.y = pk2(s[2 * 33], s[3 * 33]); o.z = pk2(s[4 * 33], s[5 * 33]); o.w = pk2(s[6 * 33], s[7 * 33]);
        *(u32x4*)(WT + (size_t)(n0 + n) * K + k0 + 8 * c) = o; }
    asm volatile("s_waitcnt lgkmcnt(0)" ::: "memory");
}
DI void transpose_all(const float* W, int K, int N, bf16* WT, LAS float* scr, int gw, int ngw, int lane) {
    const int items = (K / 64) * (N / 32);
    for (int it = gw; it < items; it += 2 * ngw) {
        float ta[32], tb[32]; const bool two = it + ngw < items;
        transpose_load(W, N, it, lane, ta); if (two) transpose_load(W, N, it + ngw, lane, tb);
        transpose_store(K, N, WT, scr, it, lane, ta); if (two) transpose_store(K, N, WT, scr, it + ngw, lane, tb);
    }
}

DI void phase_prologue(const Params& p, LAS unsigned char* lds, int tid, int wave, int lane, int vcu, int G) {
    LAS float* sv = (LAS float*)lds;
    LAS float* part = (LAS float*)(lds + 20480);
    for (int i = tid; i < 5 * DM; i += NTHR) { const int v = i >> 10, k = i & 1023; const float cv = v < 4 ? p.c[v * DM + k] : p.c_ctx[k]; sv[i] = cv * __builtin_amdgcn_rcpf(1.0f + __expf(-cv)); }
    __syncthreads();
    float* mod = (float*)(p.ws + WS_MOD);
    for (int u = vcu; u < 192; u += G) {
        const int l = u / 96, n0 = (u % 96) * 64;
        const float* W = p.mod_w + (size_t)l * DM * 6144 + n0 + lane;
        float acc[5] = {0.f, 0.f, 0.f, 0.f, 0.f};
#pragma unroll 8
        for (int k = wave * 128; k < wave * 128 + 128; ++k) { const float w = W[(size_t)k * 6144];
#pragma unroll
            for (int v = 0; v < 5; ++v) acc[v] += sv[v * DM + k] * w; }
#pragma unroll
        for (int v = 0; v < 5; ++v) part[(wave * 5 + v) * 64 + lane] = acc[v];
        __syncthreads();
        if (tid < 320) { const int v = tid >> 6, n = tid & 63; float s = p.mod_b[l * 6144 + n0 + n];
#pragma unroll
            for (int w = 0; w < 8; ++w) s += part[(w * 5 + v) * 64 + n];
            mod[(l * 5 + v) * 6144 + n0 + n] = s; }
        __syncthreads();
    }
    __syncthreads();
    LAS float* scr = (LAS float*)(lds + wave * 16384);
    const int gw = vcu * NWAVES + wave, ngw = G * NWAVES;
    transpose_all(p.ab_w_in, DM, 2688, (bf16*)(p.ws + WS_WINT), scr, gw, ngw, lane);
    transpose_all(p.ab_w_out, DM, DM, (bf16*)(p.ws + WS_WOUTT), scr, gw, ngw, lane);
    for (int d = 0; d < 2; ++d) {
        transpose_all(p.rwkv_w2 + d * 64 * 512, 64, 512, (bf16*)(p.ws + WS_W2T) + d * 512 * 64, scr, gw, ngw, lane);
        transpose_all(p.rwkv_a2 + d * 64 * 512, 64, 512, (bf16*)(p.ws + WS_A2T) + d * 512 * 64, scr, gw, ngw, lane);
    }
    transpose_all(p.rwkv_g2, 128, 512, (bf16*)(p.ws + WS_G2T), scr, gw, ngw, lane);
    { u32x4* z = (u32x4*)((bf16*)(p.ws + WS_WINT) + (size_t)2688 * DM); const int n16 = 128 * DM * 2 / 16;
      for (int i = gw * 64 + lane; i < n16; i += ngw * 64) z[i] = (u32x4){0u, 0u, 0u, 0u}; }
}
DI void phase_weights2(const Params& p, LAS unsigned char* lds, int wave, int lane, int vcu, int G) {
    LAS float* scr = (LAS float*)(lds + wave * 16384);
    const int gw = vcu * NWAVES + wave, ngw = G * NWAVES;
    transpose_all(p.mlp_w1, DM, HID, (bf16*)(p.ws + WS_W1T0), scr, gw, ngw, lane);
    transpose_all(p.mlp_w2, HID, DM, (bf16*)(p.ws + WS_W2T0), scr, gw, ngw, lane);
    transpose_all(p.mlp_w1 + (size_t)DM * HID, DM, HID, (bf16*)(p.ws + WS_W1T1), scr, gw, ngw, lane);
    transpose_all(p.mlp_w2 + (size_t)DM * HID, HID, DM, (bf16*)(p.ws + WS_W2T1), scr, gw, ngw, lane);
    transpose_all(p.conv_w_in, DM, 3 * DM, (bf16*)(p.ws + WS_CINT), scr, gw, ngw, lane);
    transpose_all(p.conv_w_out, DM, DM, (bf16*)(p.ws + WS_COUTT), scr, gw, ngw, lane);
}

DI void store_row_bf16(bf16* orow, int lane, const f32x4 (&v)[4]) {
    unsigned long long* o8 = (unsigned long long*)orow + lane;
#pragma unroll
    for (int j = 0; j < 4; ++j) o8[64 * j] = (unsigned long long)pk2(v[j].x, v[j].y) | ((unsigned long long)pk2(v[j].z, v[j].w) << 32);
}
DI float wave_sum2(float v) { v = rowsum16(v); v += __shfl_xor(v, 16); v += __shfl_xor(v, 32); return v; }
DI void phase_norm0(const Params& p, int wave, int lane, int vcu, int G) {
    constexpr int NR = 4;
    const int gw = vcu * NWAVES + wave, ngw = G * NWAVES;
    const float* mod = (const float*)(p.ws + WS_MOD);
    bf16* A0 = (bf16*)(p.ws + WS_A0);
    for (int row0 = gw; row0 < MT; row0 += NR * ngw) {
        f32x4 xv[NR][4]; float ss[NR]; int rows[NR];
#pragma unroll
        for (int q = 0; q < NR; ++q) { int row = row0 + q * ngw; if (row >= MT) row = row0; rows[q] = row; ss[q] = 0.f;
            const float* xr = row < ML ? p.x + (size_t)row * DM : p.ctx + (size_t)(row - ML) * DM;
#pragma unroll
            for (int j = 0; j < 4; ++j) xv[q][j] = __builtin_nontemporal_load((const f32x4*)xr + lane + 64 * j); }
#pragma unroll
        for (int q = 0; q < NR; ++q) {
#pragma unroll
            for (int j = 0; j < 4; ++j) ss[q] += (xv[q][j].x * xv[q][j].x + xv[q][j].y * xv[q][j].y) + (xv[q][j].z * xv[q][j].z + xv[q][j].w * xv[q][j].w); }
#pragma unroll
        for (int q = 0; q < NR; ++q) {
            if (row0 + q * ngw >= MT) break;
            const int row = rows[q], v = row < ML ? row / SEQ : 4;
            const float* sh = mod + v * 6144, *sc = sh + 1024;
            const float rs = rsqrtf(wave_sum2(ss[q]) * (1.0f / DM) + 1e-6f);
#pragma unroll
            for (int j = 0; j < 4; ++j) { const f32x4 g = *((const f32x4*)p.norm_g + lane + 64 * j), s1 = *((const f32x4*)sc + lane + 64 * j), s0 = *((const f32x4*)sh + lane + 64 * j);
                xv[q][j] = (xv[q][j] * rs) * g * (s1 + 1.0f) + s0; }
            store_row_bf16(A0 + (size_t)row * DM, lane, xv[q]);
        }
    }
}
template <bool XIN_BF, bool XOUT_BF>
DI void phase_norm1(const bf16* Y, const void* xin_, void* xout_, const float* gA, const float* modl, int gt_off, const float* gB, int sh_off, int sc_off, bf16* aout,
                    int wave, int lane, int vcu, int G) {
    constexpr int NR = 4;
    const int gw = vcu * NWAVES + wave, ngw = G * NWAVES;
    for (int row0 = gw; row0 < ML; row0 += NR * ngw) {
        f32x4 yv[NR][4], xv[NR][4]; int rows[NR]; float ss[NR];
#pragma unroll
        for (int q = 0; q < NR; ++q) ss[q] = 0.f;
#pragma unroll
        for (int q = 0; q < NR; ++q) { int row = row0 + q * ngw; if (row >= ML) row = row0; rows[q] = row;
#pragma unroll
            for (int j = 0; j < 4; ++j) { const u32x2 w = __builtin_nontemporal_load((const u32x2*)(Y + (size_t)row * DM) + lane + 64 * j); yv[q][j] = (f32x4){bf_lo(w.x), bf_hi(w.x), bf_lo(w.y), bf_hi(w.y)};
                if (XIN_BF) { const u32x2 xw = __builtin_nontemporal_load((const u32x2*)((const bf16*)xin_ + (size_t)row * DM) + lane + 64 * j); xv[q][j] = (f32x4){bf_lo(xw.x), bf_hi(xw.x), bf_lo(xw.y), bf_hi(xw.y)}; }
                else xv[q][j] = __builtin_nontemporal_load((const f32x4*)((const float*)xin_ + (size_t)row * DM) + lane + 64 * j); } }
#pragma unroll
        for (int q = 0; q < NR; ++q)
#pragma unroll
            for (int j = 0; j < 4; ++j) ss[q] += (yv[q][j].x * yv[q][j].x + yv[q][j].y * yv[q][j].y) + (yv[q][j].z * yv[q][j].z + yv[q][j].w * yv[q][j].w);
        float rs[NR], s2[NR];
#pragma unroll
        for (int q = 0; q < NR; ++q) s2[q] = 0.f;
#pragma unroll
        for (int q = 0; q < NR; ++q) rs[q] = rsqrtf(wave_sum2(ss[q]) * (1.0f / DM) + 1e-6f);
#pragma unroll
        for (int q = 0; q < NR; ++q) { const float* mv = modl + (rows[q] / SEQ) * 6144;
            if (row0 + q * ngw >= ML) break;
#pragma unroll
            for (int j = 0; j < 4; ++j) { const f32x4 g = *((const f32x4*)gA + lane + 64 * j), gt = *((const f32x4*)(mv + gt_off) + lane + 64 * j);
                xv[q][j] = xv[q][j] + gt * ((yv[q][j] * rs[q]) * g);
                if (XOUT_BF) { u32x2 w; w.x = pk2(xv[q][j].x, xv[q][j].y); w.y = pk2(xv[q][j].z, xv[q][j].w); __builtin_nontemporal_store(w, (u32x2*)((bf16*)xout_ + (size_t)rows[q] * DM) + lane + 64 * j); }
                else __builtin_nontemporal_store(xv[q][j], (f32x4*)((float*)xout_ + (size_t)rows[q] * DM) + lane + 64 * j);
                s2[q] += (xv[q][j].x * xv[q][j].x + xv[q][j].y * xv[q][j].y) + (xv[q][j].z * xv[q][j].z + xv[q][j].w * xv[q][j].w); } }
        if (aout) {
            float r2[NR];
#pragma unroll
            for (int q = 0; q < NR; ++q) r2[q] = rsqrtf(wave_sum2(s2[q]) * (1.0f / DM) + 1e-6f);
#pragma unroll
            for (int q = 0; q < NR; ++q) { const float* mv = modl + (rows[q] / SEQ) * 6144;
                if (row0 + q * ngw >= ML) break;
#pragma unroll
                for (int j = 0; j < 4; ++j) { const f32x4 g = *((const f32x4*)gB + lane + 64 * j), s1 = *((const f32x4*)(mv + sc_off) + lane + 64 * j), s0 = *((const f32x4*)(mv + sh_off) + lane + 64 * j);
                    yv[q][j] = (xv[q][j] * r2[q]) * g * (s1 + 1.0f) + s0; }
                store_row_bf16(aout + (size_t)rows[q] * DM, lane, yv[q]); }
        }
    }
}

constexpr int FP = 1936;
DI f32x4 mix4(const LAS bf16* T, int t, int col, const f32x4 mu) {
    const u32x2 pv = *(const LAS u32x2*)(T + t * FP + col), cv = *(const LAS u32x2*)(T + (t + 1) * FP + col), nv = *(const LAS u32x2*)(T + (t + 2) * FP + col);
    const f32x4 p4 = {bf_lo(pv.x), bf_hi(pv.x), bf_lo(pv.y), bf_hi(pv.y)}, c4 = {bf_lo(cv.x), bf_hi(cv.x), bf_lo(cv.y), bf_hi(cv.y)}, n4 = {bf_lo(nv.x), bf_hi(nv.x), bf_lo(nv.y), bf_hi(nv.y)};
    return c4 + mu * ((p4 + n4) * 0.5f - c4);
}
DI void st4bf(bf16* dst, const f32x4 v) { u32x2 w; w.x = pk2(v.x, v.y); w.y = pk2(v.z, v.w); *(u32x2*)dst = w; }
DI void st4bf_nt(bf16* dst, const f32x4 v) { u32x2 w; w.x = pk2(v.x, v.y); w.y = pk2(v.z, v.w); __builtin_nontemporal_store(w, (u32x2*)dst); }
DI void unpack8(const u32x4 w, float (&o)[8]) { o[0] = bf_lo(w.x); o[1] = bf_hi(w.x); o[2] = bf_lo(w.y); o[3] = bf_hi(w.y); o[4] = bf_lo(w.z); o[5] = bf_hi(w.z); o[6] = bf_lo(w.w); o[7] = bf_hi(w.w); }
DI bf16x8 pack8(const float (&v)[8]) { u32x4 w; w.x = pk2(v[0], v[1]); w.y = pk2(v[2], v[3]); w.z = pk2(v[4], v[5]); w.w = pk2(v[6], v[7]); return __builtin_bit_cast(bf16x8, w); }

DI void phase_features(const Params& p, LAS unsigned char* lds, int tid, int wave, int lane, int vcu, int G) {
    const bf16* P = (const bf16*)(p.ws + WS_P);
    LAS bf16* T = (LAS bf16*)lds;
    bf16* SH = (bf16*)(p.ws + WS_SH); bf16* SD0 = (bf16*)(p.ws + WS_SD0); bf16* SD1 = (bf16*)(p.ws + WS_SD1);
    float* BC = (float*)(p.ws + WS_BC); bf16* KP = (bf16*)(p.ws + WS_KP); bf16* VT = (bf16*)(p.ws + WS_VT);
    const bf16* W2T = (const bf16*)(p.ws + WS_W2T); const bf16* A2T = (const bf16*)(p.ws + WS_A2T);
    const int h = wave, tq = lane >> 4, cl = lane & 15, c0 = h * 64 + 4 * cl;
    for (int u = vcu; u < MT / 16; u += G) {
        const int R0 = u * 16;
        int seq0, seqlen; if (R0 < ML) { seq0 = (R0 / SEQ) * SEQ; seqlen = SEQ; } else { seq0 = ML + ((R0 - ML) / CTXL) * CTXL; seqlen = CTXL; }
        bf16x8 bw[16];
#pragma unroll
        for (int q = 0; q < 16; ++q) { const int L = q >> 3, ks = (q >> 2) & 1, nt = q & 3; bw[q] = *(const bf16x8*)(W2T + (size_t)(L & 1) * 512 * 64 + (size_t)(c0 + nt) * 64 + ks * 32 + tq * 8); }
        __syncthreads();
        for (int i = tid; i < 18 * 240; i += NTHR) { const int rr = i / 240, ch = i % 240, row = R0 - 1 + rr;
            u32x4 v = {0u, 0u, 0u, 0u}; if (row >= seq0 && row < seq0 + seqlen) v = *(const u32x4*)(P + (size_t)row * PP + RWC + ch * 8);
            *(LAS u32x4*)(T + rr * FP + ch * 8) = v; }
        __syncthreads();
        f32x4 lo[4][4];
#pragma unroll
        for (int half = 0; half < 2; ++half) {
            if (half == 1) {
#pragma unroll
                for (int q = 0; q < 16; ++q) { const int L = 2 + (q >> 3), ks = (q >> 2) & 1, nt = q & 3; bw[q] = *(const bf16x8*)(A2T + (size_t)(L & 1) * 512 * 64 + (size_t)(c0 + nt) * 64 + ks * 32 + tq * 8); }
            }
#pragma unroll
            for (int LL = 0; LL < 2; ++LL) {
                const int L = half * 2 + LL;
#pragma unroll
                for (int nt = 0; nt < 4; ++nt) lo[L][nt] = (f32x4){0.f, 0.f, 0.f, 0.f};
#pragma unroll
                for (int ks = 0; ks < 2; ++ks) {
                    const int cb = 1536 + 64 * L + ks * 32 + tq * 8, tok = lane & 15;
                    float pv[8], cv[8], nv[8], a8[8];
                    unpack8(*(const LAS u32x4*)(T + tok * FP + cb), pv); unpack8(*(const LAS u32x4*)(T + (tok + 1) * FP + cb), cv); unpack8(*(const LAS u32x4*)(T + (tok + 2) * FP + cb), nv);
                    const f32x4 m0 = *(const f32x4*)(p.rwkv_mu + cb), m1 = *(const f32x4*)(p.rwkv_mu + cb + 4);
#pragma unroll
                    for (int e = 0; e < 8; ++e) { const float mu = e < 4 ? m0[e] : m1[e - 4]; float m = cv[e] + mu * (0.5f * (pv[e] + nv[e]) - cv[e]); if (L < 2) m = tanhf_(m); a8[e] = m; }
                    const bf16x8 a = pack8(a8);
#pragma unroll
                    for (int nt = 0; nt < 4; ++nt) lo[L][nt] = __builtin_amdgcn_mfma_f32_16x16x32_bf16(a, bw[LL * 8 + ks * 4 + nt], lo[L][nt], 0, 0, 0);
                }
            }
        }
        const f32x4 mu_r = *(const f32x4*)(p.rwkv_mu + c0), mu_k = *(const f32x4*)(p.rwkv_mu + 512 + c0), mu_v = *(const f32x4*)(p.rwkv_mu + 1024 + c0);
        const f32x4 kkw = *(const f32x4*)(p.rwkv_kk + c0), kaw = *(const f32x4*)(p.rwkv_ka + c0), rkw = *(const f32x4*)(p.rwkv_rk + c0);
        const f32x4 w0f = *(const f32x4*)(p.rwkv_w0 + c0), w0b = *(const f32x4*)(p.rwkv_w0 + 512 + c0), a0f = *(const f32x4*)(p.rwkv_a0 + c0), a0b = *(const f32x4*)(p.rwkv_a0 + 512 + c0);
#pragma unroll
        for (int j = 0; j < 4; ++j) {
            const int t = 4 * tq + j, row = R0 + t;
            const f32x4 r4 = mix4(T, t, c0, mu_r), k4 = mix4(T, t, 512 + c0, mu_k), v4 = mix4(T, t, 1024 + c0, mu_v);
            const f32x4 kkv = k4 * kkw;
            const float ss = rowsum16((kkv.x * kkv.x + kkv.y * kkv.y) + (kkv.z * kkv.z + kkv.w * kkv.w));
            const f32x4 kk4 = kkv * __builtin_amdgcn_rcpf(fmaxf(__builtin_amdgcn_sqrtf(ss), 1e-12f));
            f32x4 df, db, kf, kb, bf, bb_;
#pragma unroll
            for (int i = 0; i < 4; ++i) {
                const float zf = w0f[i] + lo[0][i][j], zb = w0b[i] + lo[1][i][j];
                df[i] = __expf(-0.6065306597f * sigmoidf_(zf)); db[i] = __expf(-0.6065306597f * sigmoidf_(zb));
                const float af = sigmoidf_(a0f[i] + lo[2][i][j]), ab = sigmoidf_(a0b[i] + lo[3][i][j]);
                kf[i] = k4[i] * (1.0f + (af - 1.0f) * kaw[i]); kb[i] = k4[i] * (1.0f + (ab - 1.0f) * kaw[i]);
                bf[i] = kk4[i] * af; bb_[i] = kk4[i] * ab;
            }
            const f32x4 bt = r4 * (kf + kb) * rkw;
            const float bonus = rowsum16((bt.x + bt.y) + (bt.z + bt.w));
            if (cl == 0) BC[row * 8 + h] = bonus;
            const size_t rec = ((size_t)row * 8 + h) * 192 + 4 * cl;
            st4bf_nt(SH + rec, r4); st4bf_nt(SH + rec + 64, v4); st4bf_nt(SH + rec + 128, -kk4);
            st4bf_nt(SD0 + rec, df); st4bf_nt(SD0 + rec + 64, kf); st4bf_nt(SD0 + rec + 128, bf);
            st4bf_nt(SD1 + rec, db); st4bf_nt(SD1 + rec + 64, kb); st4bf_nt(SD1 + rec + 128, bb_);
        }
        if (tid < 256) {
            const int t = tid >> 4, g = tid & 15, row = R0 + t, kvh = g >> 3, d0 = (g & 7) * 8;
            const bf16* src = P + (size_t)row * PP + 512 + kvh * 64;
            const bool lat = row < ML; int b_, pos, tt = 0;
            if (lat) { b_ = row / SEQ; tt = row % SEQ; pos = CTXL + tt; } else { b_ = (row - ML) / CTXL; pos = (row - ML) % CTXL; }
            u32x4 ov = *(const u32x4*)(src + d0);
            if (lat) {
                const int dd = d0 & 31; const bool first = dd < 16;
                float o8[8], q8[8], r8[8]; unpack8(ov, o8); unpack8(*(const u32x4*)(src + (first ? d0 + 16 : d0 - 16)), q8);
                const float posf = (d0 < 32) ? (float)(tt >> 6) : (float)(tt & 63);
#pragma unroll
                for (int e = 0; e < 8; ++e) { const float inv = exp2f(-(float)((dd & 15) + e) * 0.8304820237f), ang = posf * inv, sn = __sinf(ang), cs = __cosf(ang);
                    r8[e] = first ? o8[e] * cs - q8[e] * sn : o8[e] * cs + q8[e] * sn; }
                ov = __builtin_bit_cast(u32x4, pack8(r8));
            }
            *(u32x4*)(KP + ((size_t)(b_ * 2 + kvh) * NPOS + pos) * 64 + d0) = ov;
        }
        { const int t = tid & 15, dq = tid >> 4, row = R0 + t, kvh = dq >> 4, d = (dq & 15) * 4;
          int b_, pos; if (row < ML) { b_ = row / SEQ; pos = CTXL + row % SEQ; } else { b_ = (row - ML) / CTXL; pos = (row - ML) % CTXL; }
          const u32x2 w = *(const u32x2*)(P + (size_t)row * PP + 640 + 4 * dq);
          bf16* dst = VT + (((size_t)(b_ * 2 + kvh) * (NPOS / 32) + (pos >> 5)) * 64 + d) * 32 + (pos & 31);
          dst[0] = (bf16)(w.x & 0xffffu); dst[32] = (bf16)(w.x >> 16); dst[64] = (bf16)(w.y & 0xffffu); dst[96] = (bf16)(w.y >> 16); }
    }
}

DI int crow(int r, int hi) { return (r & 3) + 8 * (r >> 2) + 4 * hi; }
constexpr int ATT_TASKS = 8192;
struct AttRegs { f32x16 O[2]; float m_, l_; bf16x8 qf[4], kf[4], vf[2][2]; int b, kvh, head, ql0, kb0, it_lo, it_hi; bool local; };
DI void att_setup(const Params& p, int task, int lane, AttRegs& A) {
    const bf16* Pm = (const bf16*)(p.ws + WS_P);
    const int qblk = task & 1, qsub = (task >> 1) & 1, g = (task >> 2) & 3, qb = (task >> 4) & 63; A.kvh = (task >> 10) & 1; A.b = task >> 11;
    A.head = A.kvh * 4 + g; A.ql0 = qb * 128 + qsub * 64 + qblk * 32; A.kb0 = 0; A.local = false;
    A.it_lo = A.ql0 < 128 ? (128 - A.ql0) >> 5 : 0; A.it_hi = A.ql0 + 160 > SEQ ? (SEQ - A.ql0 + 128) >> 5 : 9;
    const int r = lane & 31, hh = lane >> 5;
    const int t = A.ql0 + r; const bf16* src = Pm + (size_t)(A.b * SEQ + t) * PP + A.head * 64 + 8 * hh;
    float qv[4][8];
#pragma unroll
    for (int c = 0; c < 4; ++c) unpack8(*(const u32x4*)(src + 16 * c), qv[c]);
    const float prow = (float)(t >> 6), pcol = (float)(t & 63);
    float n0[8], n1[8], n2[8], n3[8];
#pragma unroll
    for (int e = 0; e < 8; ++e) { const float inv = exp2f(-(float)(8 * hh + e) * 0.8304820237f);
        const float a1 = prow * inv, s1 = __sinf(a1), c1 = __cosf(a1), a2 = pcol * inv, s2 = __sinf(a2), c2 = __cosf(a2); const float sc = 0.125f * LOG2E;
        n0[e] = (qv[0][e] * c1 - qv[1][e] * s1) * sc; n1[e] = (qv[1][e] * c1 + qv[0][e] * s1) * sc; n2[e] = (qv[2][e] * c2 - qv[3][e] * s2) * sc; n3[e] = (qv[3][e] * c2 + qv[2][e] * s2) * sc; }
    A.qf[0] = pack8(n0); A.qf[1] = pack8(n1); A.qf[2] = pack8(n2); A.qf[3] = pack8(n3);
    A.m_ = p.att_sink[A.head] * LOG2E; A.l_ = hh == 0 ? 1.0f : 0.0f;
#pragma unroll
    for (int dblk = 0; dblk < 2; ++dblk)
#pragma unroll
        for (int i = 0; i < 16; ++i) A.O[dblk][i] = 0.f;
}
DI void att_issue(const Params& p, int it, int lane, AttRegs& A) {
    const bf16* KP = (const bf16*)(p.ws + WS_KP); const bf16* VT = (const bf16*)(p.ws + WS_VT);
    const int r = lane & 31, hh = lane >> 5;
    int pos0; A.local = it < 9;
    if (A.local) { A.kb0 = A.ql0 - 128 + it * 32; pos0 = CTXL + A.kb0; } else pos0 = (it - 9) * 32;
    const bf16* Kb = KP + (size_t)(A.b * 2 + A.kvh) * NPOS * 64; const bf16* Vb = VT + (size_t)(A.b * 2 + A.kvh) * (NPOS / 32) * 2048;
#pragma unroll
    for (int c = 0; c < 4; ++c) A.kf[c] = *(const bf16x8*)(Kb + (size_t)(pos0 + r) * 64 + 16 * c + 8 * hh);
#pragma unroll
    for (int dblk = 0; dblk < 2; ++dblk)
#pragma unroll
        for (int s = 0; s < 2; ++s) { const u32x2* vp = (const u32x2*)(Vb + (size_t)(pos0 >> 5) * 2048 + (dblk * 32 + r) * 32 + 16 * s + 4 * hh); const u32x2 lo = vp[0], hi = vp[2];
            A.vf[dblk][s] = __builtin_bit_cast(bf16x8, (u32x4){lo.x, lo.y, hi.x, hi.y}); }
}
DI void att_compute(int lane, AttRegs& A) {
    const int r = lane & 31, hh = lane >> 5;
    const bool need_mask = A.local && !(A.kb0 >= A.ql0 - 97 && A.kb0 <= A.ql0 + 97);
    f32x16 S;
#pragma unroll
    for (int i = 0; i < 16; ++i) S[i] = 0.f;
#pragma unroll
    for (int c = 0; c < 4; ++c) S = __builtin_amdgcn_mfma_f32_32x32x16_bf16(A.kf[c], A.qf[c], S, 0, 0, 0);
    if (need_mask) { const int ql = A.ql0 + r;
#pragma unroll
        for (int i = 0; i < 16; ++i) { const int kl = A.kb0 + crow(i, hh); const int dlt = ql - kl; const bool ok = dlt <= 128 && dlt >= -128; S[i] = ok ? S[i] : -INFINITY; } }
    float tmax = S[0];
#pragma unroll
    for (int i = 1; i < 16; ++i) tmax = fmaxf(tmax, S[i]);
    tmax = fmaxf(tmax, __shfl_xor(tmax, 32));
    const float mnew = fmaxf(A.m_, tmax), alpha = __builtin_amdgcn_exp2f(A.m_ - mnew);
    A.m_ = mnew;
    float pe[16]; float ps = 0.f;
#pragma unroll
    for (int i = 0; i < 16; ++i) { pe[i] = __builtin_amdgcn_exp2f(S[i] - mnew); ps += pe[i]; }
    A.l_ = A.l_ * alpha + ps;
    if (__any(alpha != 1.0f)) {
#pragma unroll
        for (int dblk = 0; dblk < 2; ++dblk)
#pragma unroll
            for (int i = 0; i < 16; ++i) A.O[dblk][i] *= alpha; }
    bf16x8 pf[2];
#pragma unroll
    for (int s = 0; s < 2; ++s) { u32x4 w; w.x = pk2(pe[8 * s], pe[8 * s + 1]); w.y = pk2(pe[8 * s + 2], pe[8 * s + 3]); w.z = pk2(pe[8 * s + 4], pe[8 * s + 5]); w.w = pk2(pe[8 * s + 6], pe[8 * s + 7]);
        pf[s] = __builtin_bit_cast(bf16x8, w); }
#pragma unroll
    for (int dblk = 0; dblk < 2; ++dblk)
#pragma unroll
        for (int s = 0; s < 2; ++s) A.O[dblk] = __builtin_amdgcn_mfma_f32_32x32x16_bf16(A.vf[dblk][s], pf[s], A.O[dblk], 0, 0, 0);
}
DI void att_finish(const Params& p, int lane, AttRegs& A) {
    bf16* Pm = (bf16*)(p.ws + WS_P);
    const int r = lane & 31, hh = lane >> 5;
    const float lt = A.l_ + __shfl_xor(A.l_, 32), inv = __builtin_amdgcn_rcpf(lt);
    bf16* dst = Pm + (size_t)(A.b * SEQ + A.ql0 + r) * PP + A.head * 64;
#pragma unroll
    for (int dblk = 0; dblk < 2; ++dblk)
#pragma unroll
        for (int gi = 0; gi < 4; ++gi) { const f32x4 v = {A.O[dblk][4 * gi] * inv, A.O[dblk][4 * gi + 1] * inv, A.O[dblk][4 * gi + 2] * inv, A.O[dblk][4 * gi + 3] * inv};
            st4bf(dst + dblk * 32 + 8 * gi + 4 * hh, v); }
}
#define ATT_STEP(p, lane, A, a_task, a_stride, a_it, a_stage) do { if (a_task < ATT_TASKS) { \
        if (a_stage == 0) { att_setup(p, a_task, lane, A); a_it = A.it_lo; att_issue(p, a_it, lane, A); a_stage = 1; } \
        else { att_compute(lane, A); ++a_it; if (a_it == A.it_hi) a_it = 9; \
            if (a_it < 17) att_issue(p, a_it, lane, A); else { att_finish(p, lane, A); a_task += a_stride; a_stage = 0; } } } } while (0)
DI void phase_attention2(const Params& p, int wave, int lane, int vcu, int G) {
    AttRegs A; int a_task = vcu * NWAVES + wave, a_it = 0, a_stage = 0; const int a_stride = G * NWAVES;
    while (a_task < ATT_TASKS) ATT_STEP(p, lane, A, a_task, a_stride, a_it, a_stage);
}

DI int scan_row(int step, int b, int d) { if (step < CTXL) return ML + b * CTXL + (d ? CTXL - 1 - step : step); const int t = step - CTXL; return b * SEQ + (d ? SEQ - 1 - t : t); }
DI int prev_row(int row, int d, bool& none) {
    none = false;
    if (row < ML) { const int b = row / SEQ, t = row % SEQ; if (d == 0) return t > 0 ? row - 1 : ML + b * CTXL + CTXL - 1; return t < SEQ - 1 ? row + 1 : ML + b * CTXL; }
    const int j = (row - ML) % CTXL; if (d == 0) { none = j == 0; return none ? row : row - 1; } none = j == CTXL - 1; return none ? row : row + 1;
}
DI f32x4 ld4bf(const bf16* src) { const u32x2 w = *(const u32x2*)src; return (f32x4){bf_lo(w.x), bf_hi(w.x), bf_lo(w.y), bf_hi(w.y)}; }
DI float dot4(const f32x4 a, const f32x4 b) { return (a.x * b.x + a.y * b.y) + (a.z * b.z + a.w * b.w); }
DI void phase_pairs(const Params& p, int wave, int lane, int vcu, int G) {
    const bf16* SH = (const bf16*)(p.ws + WS_SH); const bf16* SD0 = (const bf16*)(p.ws + WS_SD0); const bf16* SD1 = (const bf16*)(p.ws + WS_SD1); float* CC = (float*)(p.ws + WS_CC);
    const int gw = vcu * NWAVES + wave, ngw = G * NWAVES, sub = lane >> 4, ks = (lane & 15) * 4;
    constexpr int NIT = 4;
    for (int base = gw * 4 * NIT; base < MT * 8; base += ngw * 4 * NIT) {
        f32x4 a4[NIT], kf[NIT], bf_[NIT], kb[NIT], bb[NIT]; bool nf[NIT], nb[NIT]; int it[NIT];
#pragma unroll
        for (int q = 0; q < NIT; ++q) {
            int item = base + q * 4 + sub; if (item >= MT * 8) item = MT * 8 - 1;
            it[q] = item; const int row = item >> 3, h = item & 7;
            const int pf = prev_row(row, 0, nf[q]), pb = prev_row(row, 1, nb[q]);
            a4[q] = ld4bf(SH + ((size_t)row * 8 + h) * 192 + 128 + ks);
            kf[q] = ld4bf(SD0 + ((size_t)pf * 8 + h) * 192 + 64 + ks); bf_[q] = ld4bf(SD0 + ((size_t)pf * 8 + h) * 192 + 128 + ks);
            kb[q] = ld4bf(SD1 + ((size_t)pb * 8 + h) * 192 + 64 + ks); bb[q] = ld4bf(SD1 + ((size_t)pb * 8 + h) * 192 + 128 + ks);
        }
#pragma unroll
        for (int q = 0; q < NIT; ++q) {
            float c1f = rowsum16(dot4(bf_[q], a4[q])), c2f = rowsum16(dot4(kf[q], a4[q])), c1b = rowsum16(dot4(bb[q], a4[q])), c2b = rowsum16(dot4(kb[q], a4[q]));
            if (nf[q]) { c1f = 0.f; c2f = 0.f; } if (nb[q]) { c1b = 0.f; c2b = 0.f; }
            if ((lane & 15) == 0 && base + q * 4 + sub < MT * 8) { *(f32x2*)(CC + (size_t)it[q] * 2) = (f32x2){c1f, c2f}; *(f32x2*)(CC + ((size_t)MT * 8 + it[q]) * 2) = (f32x2){c1b, c2b}; }
        }
    }
}
DI float fma_(float a, float b, float c) { float d; asm("v_fma_f32 %0, %1, %2, %3" : "=v"(d) : "v"(a), "v"(b), "v"(c)); return d; }
DI float mul_(float a, float b) { float d; asm("v_mul_f32 %0, %1, %2" : "=v"(d) : "v"(a), "v"(b)); return d; }
template <int MODE> DI void phase_scan(const Params& p, LAS unsigned char* lds, int tid, int wave, int lane, int vcu) {
    constexpr int TC = 32, STEPF = 384, BUFF = TC * STEPF, NCH = NPOS / TC;
    const int s = vcu >> 2, qr = vcu & 3, b = s >> 4, h = (s >> 1) & 7, d = s & 1;
    const bf16* SH = (const bf16*)(p.ws + WS_SH); const bf16* SD = (const bf16*)(p.ws + (d ? WS_SD1 : WS_SD0));
    bf16* Pm = (bf16*)(p.ws + WS_P);
    LAS float* buf = (LAS float*)lds;
    if (wave >= 4) {
        const int lt = tid - 256;
        u32x4 rgA[6], rgB[6];
#define SCAN_LOAD(rg, c) do { _Pragma("unroll") for (int i = 0; i < 6; ++i) { const int idx = i * 256 + lt, st = idx / 48, part = idx % 48; const int row = scan_row((c) * TC + st, b, d); \
            const bf16* src = (part < 24 ? SH : SD) + ((size_t)row * 8 + h) * 192 + (part % 24) * 8; rg[i] = *(const u32x4*)src; } } while (0)
#define SCAN_WRITE(rg, bi) do { _Pragma("unroll") for (int i = 0; i < 6; ++i) { const int idx = i * 256 + lt, st = idx / 48, part = idx % 48; LAS float* dst = buf + (bi) * BUFF + st * STEPF + part * 8; \
            *(LAS f32x4*)dst = (f32x4){bf_lo(rg[i].x), bf_hi(rg[i].x), bf_lo(rg[i].y), bf_hi(rg[i].y)}; *(LAS f32x4*)(dst + 4) = (f32x4){bf_lo(rg[i].z), bf_hi(rg[i].z), bf_lo(rg[i].w), bf_hi(rg[i].w)}; } } while (0)
        SCAN_LOAD(rgA, 0); SCAN_WRITE(rgA, 0); SCAN_LOAD(rgA, 1); SCAN_LOAD(rgB, 2);
        AttRegs A; int a_task = MODE == 0 ? vcu * 4 + (wave - 4) : ATT_TASKS, a_it = 0, a_stage = 0; const int a_stride = 1024;
        __syncthreads();
        for (int c = 0; c < NCH; c += 2) {
            if (MODE != 1 && c + 1 < NCH) { SCAN_WRITE(rgA, 1); if (c + 3 < NCH) SCAN_LOAD(rgA, c + 3); }
            ATT_STEP(p, lane, A, a_task, a_stride, a_it, a_stage);
            __syncthreads();
            if (MODE != 1 && c + 2 < NCH) { SCAN_WRITE(rgB, 0); if (c + 4 < NCH) SCAN_LOAD(rgB, c + 4); }
            ATT_STEP(p, lane, A, a_task, a_stride, a_it, a_stage);
            __syncthreads();
        }
        while (a_task < ATT_TASKS) ATT_STEP(p, lane, A, a_task, a_stride, a_it, a_stage);
#undef SCAN_LOAD
#undef SCAN_WRITE
    } else {
        const int rl = wave * 4 + (lane >> 4), vidx = qr * 16 + rl, ks = (lane & 15) * 4, l15 = lane & 15;
        f32x2 S01 = {0.f, 0.f}, S23 = {0.f, 0.f};
        __builtin_amdgcn_s_setprio(2);
        bf16* ydst = MODE ? Pm + 2688 + d * 64 + vidx : Pm + 1024 + d * 512 + h * 64 + vidx;
        __syncthreads();
        for (int c = 0; c < NCH; ++c) {
            if (MODE == 2) { __syncthreads(); continue; }
            const LAS float* cb = buf + (c & 1) * BUFF + ks;
            const LAS float* cv = buf + (c & 1) * BUFF + 64 + vidx;
            const bool emit = c >= CTXL / TC;
            f32x4 R_[2], A_[2], W_[2], K_[2], B_[2]; float V_[2];
#define SCAN_LD(sl, st) do { const LAS float* bs = cb + (st) * STEPF; R_[sl] = *(const LAS f32x4*)(bs); A_[sl] = *(const LAS f32x4*)(bs + 128); W_[sl] = *(const LAS f32x4*)(bs + 192); \
            K_[sl] = *(const LAS f32x4*)(bs + 256); B_[sl] = *(const LAS f32x4*)(bs + 320); V_[sl] = cv[(st) * STEPF]; } while (0)
            SCAN_LD(0, 0); SCAN_LD(1, 1);
            float ykeep = 0.f;
#pragma unroll
            for (int st = 0; st < TC; ++st) {
                const int sl = st & 1;
                const f32x4 r4 = R_[sl], a4 = A_[sl], w4 = W_[sl], k4 = K_[sl], b4 = B_[sl]; const float vv = V_[sl];
                if (st + 2 < TC) SCAN_LD(sl, st + 2);
                f32x2 t = S01 * (f32x2){a4.x, a4.y}; t = S23 * (f32x2){a4.z, a4.w} + t;
                const float sa = rowsum16(t.x + t.y);
                S01 = (S01 * (f32x2){w4.x, w4.y} + (f32x2){k4.x, k4.y} * vv) + (f32x2){b4.x, b4.y} * sa;
                S23 = (S23 * (f32x2){w4.z, w4.w} + (f32x2){k4.z, k4.w} * vv) + (f32x2){b4.z, b4.w} * sa;
                f32x2 yq = S01 * (f32x2){r4.x, r4.y}; yq = S23 * (f32x2){r4.z, r4.w} + yq;
                const float y = rowsum16(yq.x + yq.y);
                ykeep = (l15 == (st & 15)) ? y : ykeep;
                if ((st & 15) == 15 && emit) { const int row = scan_row(c * TC + (st - 15) + l15, b, d); ydst[(size_t)row * PP] = (bf16)(pk2(ykeep, 0.f) & 0xffffu); }
            }
#undef SCAN_LD
            __syncthreads();
        }
        __builtin_amdgcn_s_setprio(0);
    }
}

template <int DUMMY> DI void phase_attention(const Params& p, LAS unsigned char* lds, int tid, int wave, int lane, int vcu, int G) {
    bf16* Pm = (bf16*)(p.ws + WS_P); const bf16* KP = (const bf16*)(p.ws + WS_KP); const bf16* VT = (const bf16*)(p.ws + WS_VT);
    LAS unsigned char* Kl = lds;
    LAS unsigned char* Vl = lds + 55296;
    const int r = lane & 31, hh = lane >> 5, g = wave >> 1, qsub = wave & 1;
    for (int u = vcu; u < 512; u += G) {
        const int b = u >> 7, kvh = (u >> 6) & 1, qb = u & 63, head = kvh * 4 + g, qlo = qb * 128 + qsub * 64;
        bf16x8 qf[2][4];
#pragma unroll
        for (int qblk = 0; qblk < 2; ++qblk) {
            const int t = qlo + qblk * 32 + r; const bf16* src = Pm + (size_t)(b * SEQ + t) * PP + head * 64 + 8 * hh;
            float qv[4][8];
#pragma unroll
            for (int c = 0; c < 4; ++c) unpack8(*(const u32x4*)(src + 16 * c), qv[c]);
            const float prow = (float)(t >> 6), pcol = (float)(t & 63);
            float n0[8], n1[8], n2[8], n3[8];
#pragma unroll
            for (int e = 0; e < 8; ++e) { const float inv = exp2f(-(float)(8 * hh + e) * 0.8304820237f);
                const float a1 = prow * inv, s1 = __sinf(a1), c1 = __cosf(a1), a2 = pcol * inv, s2 = __sinf(a2), c2 = __cosf(a2); const float sc = 0.125f * LOG2E;
                n0[e] = (qv[0][e] * c1 - qv[1][e] * s1) * sc; n1[e] = (qv[1][e] * c1 + qv[0][e] * s1) * sc; n2[e] = (qv[2][e] * c2 - qv[3][e] * s2) * sc; n3[e] = (qv[3][e] * c2 + qv[2][e] * s2) * sc; }
            qf[qblk][0] = pack8(n0); qf[qblk][1] = pack8(n1); qf[qblk][2] = pack8(n2); qf[qblk][3] = pack8(n3);
        }
        f32x16 O[2][2]; float m_[2], l_[2];
#pragma unroll
        for (int q = 0; q < 2; ++q) { m_[q] = p.att_sink[head] * LOG2E; l_[q] = hh == 0 ? 1.0f : 0.0f;
#pragma unroll
            for (int dblk = 0; dblk < 2; ++dblk)
#pragma unroll
                for (int i = 0; i < 16; ++i) O[q][dblk][i] = 0.f; }
        for (int round = 0; round < 2; ++round) {
            const int nslots = round ? 256 : 384;
            __syncthreads();
            for (int i = tid; i < nslots * 8; i += NTHR) { const int slot = i >> 3, ch = i & 7; int pos; bool valid = true;
                if (round == 0) { const int kl = (qb - 1) * 128 + slot; valid = kl >= 0 && kl < SEQ; pos = CTXL + kl; } else pos = slot;
                u32x4 v = {0u, 0u, 0u, 0u}; if (valid) v = *(const u32x4*)(KP + ((size_t)(b * 2 + kvh) * NPOS + pos) * 64 + ch * 8);
                *(LAS u32x4*)(Kl + slot * 144 + ch * 16) = v; }
            const int nch = nslots >> 3;
            for (int i = tid; i < 64 * nch; i += NTHR) { const int dd = i / nch, ch = i % nch, slot0 = ch * 8; int pos0; bool valid = true;
                if (round == 0) { const int kl0 = (qb - 1) * 128 + slot0; valid = kl0 >= 0 && kl0 < SEQ; pos0 = CTXL + kl0; } else pos0 = slot0;
                u32x4 v = {0u, 0u, 0u, 0u}; if (valid) v = *(const u32x4*)(VT + ((size_t)(b * 2 + kvh) * 64 + dd) * NPOS + pos0);
                LAS u32x2* dst = (LAS u32x2*)(Vl + dd * 776 + slot0 * 2); dst[0] = (u32x2){v.x, v.y}; dst[1] = (u32x2){v.z, v.w}; }
            __syncthreads();
            const int tlo = round ? 0 : 2 * qsub, thi = round ? 8 : 2 * qsub + 10;
            for (int T = tlo; T < thi; ++T) {
                bf16x8 kf[4], vf[2][2];
#pragma unroll
                for (int c = 0; c < 4; ++c) kf[c] = *(const LAS bf16x8*)(Kl + (T * 32 + r) * 144 + (16 * c + 8 * hh) * 2);
#pragma unroll
                for (int dblk = 0; dblk < 2; ++dblk)
#pragma unroll
                    for (int s = 0; s < 2; ++s) { const LAS u32x2* vp = (const LAS u32x2*)(Vl + (dblk * 32 + r) * 776 + (T * 32 + 16 * s + 4 * hh) * 2); const u32x2 lo = vp[0], hi = vp[2];
                        vf[dblk][s] = __builtin_bit_cast(bf16x8, (u32x4){lo.x, lo.y, hi.x, hi.y}); }
#pragma unroll
                for (int q = 0; q < 2; ++q) {
                    f32x16 S;
#pragma unroll
                    for (int i = 0; i < 16; ++i) S[i] = 0.f;
#pragma unroll
                    for (int c = 0; c < 4; ++c) S = __builtin_amdgcn_mfma_f32_32x32x16_bf16(kf[c], qf[q][c], S, 0, 0, 0);
                    const int kb0w = (qb - 1) * 128 + T * 32;
                    const bool need_mask = round == 0 && !(kb0w >= 0 && kb0w + 31 < SEQ && kb0w >= qlo - 65 && kb0w <= qlo + 97);
                    if (need_mask) { const int ql = qlo + q * 32 + r, kb0 = kb0w;
#pragma unroll
                        for (int i = 0; i < 16; ++i) { const int kl = kb0 + crow(i, hh); const int dlt = ql - kl; const bool ok = kl >= 0 && kl < SEQ && dlt <= 128 && dlt >= -128; S[i] = ok ? S[i] : -INFINITY; } }
                    float tmax = S[0];
#pragma unroll
                    for (int i = 1; i < 16; ++i) tmax = fmaxf(tmax, S[i]);
                    tmax = fmaxf(tmax, __shfl_xor(tmax, 32));
                    const float mnew = fmaxf(m_[q], tmax), alpha = __builtin_amdgcn_exp2f(m_[q] - mnew);
                    m_[q] = mnew;
                    float pe[16]; float ps = 0.f;
#pragma unroll
                    for (int i = 0; i < 16; ++i) { pe[i] = __builtin_amdgcn_exp2f(S[i] - mnew); ps += pe[i]; }
                    l_[q] = l_[q] * alpha + ps;
                    if (__any(alpha != 1.0f)) {
#pragma unroll
                    for (int dblk = 0; dblk < 2; ++dblk)
#pragma unroll
                        for (int i = 0; i < 16; ++i) O[q][dblk][i] *= alpha; }
                    bf16x8 pf[2];
#pragma unroll
                    for (int s = 0; s < 2; ++s) { u32x4 w; w.x = pk2(pe[8 * s], pe[8 * s + 1]); w.y = pk2(pe[8 * s + 2], pe[8 * s + 3]); w.z = pk2(pe[8 * s + 4], pe[8 * s + 5]); w.w = pk2(pe[8 * s + 6], pe[8 * s + 7]);
                        pf[s] = __builtin_bit_cast(bf16x8, w); }
#pragma unroll
                    for (int dblk = 0; dblk < 2; ++dblk)
#pragma unroll
                        for (int s = 0; s < 2; ++s) O[q][dblk] = __builtin_amdgcn_mfma_f32_32x32x16_bf16(vf[dblk][s], pf[s], O[q][dblk], 0, 0, 0);
                }
            }
        }
#pragma unroll
        for (int q = 0; q < 2; ++q) {
            const float lt = l_[q] + __shfl_xor(l_[q], 32), inv = __builtin_amdgcn_rcpf(lt);
            bf16* dst = Pm + (size_t)(b * SEQ + qlo + q * 32 + r) * PP + head * 64 + (DUMMY ? 1024 : 0);
#pragma unroll
            for (int dblk = 0; dblk < 2; ++dblk)
#pragma unroll
                for (int gi = 0; gi < 4; ++gi) { const f32x4 v = {O[q][dblk][4 * gi] * inv, O[q][dblk][4 * gi + 1] * inv, O[q][dblk][4 * gi + 2] * inv, O[q][dblk][4 * gi + 3] * inv};
                    st4bf(dst + dblk * 32 + 8 * gi + 4 * hh, v); }
        }
    }
}

DI void phase_rwkv_out(const Params& p, LAS unsigned char* lds, int tid, int wave, int lane, int vcu, int G) {
    bf16* Pm = (bf16*)(p.ws + WS_P); const bf16* SH = (const bf16*)(p.ws + WS_SH); const float* BC = (const float*)(p.ws + WS_BC); const bf16* G2T = (const bf16*)(p.ws + WS_G2T);
    constexpr int GP = 136;
    LAS bf16* T = (LAS bf16*)lds;
    const int h = wave, tq = lane >> 4, cl = lane & 15, c0 = h * 64 + 4 * cl;
    const f32x4 lnw = *(const f32x4*)(p.rwkv_ln_w + c0), lnb = *(const f32x4*)(p.rwkv_ln_b + c0);
    for (int u = vcu; u < ML / 16; u += G) {
        const int R0 = u * 16, seq0 = (R0 / SEQ) * SEQ;
        bf16x8 gw_[16];
#pragma unroll
        for (int q = 0; q < 16; ++q) gw_[q] = *(const bf16x8*)(G2T + (size_t)(c0 + (q & 3)) * 128 + (q >> 2) * 32 + tq * 8);
        u32x2 yf_[4], yb_[4], vw_[4]; float bc_[4];
#pragma unroll
        for (int j = 0; j < 4; ++j) { const int row = R0 + 4 * tq + j;
            yf_[j] = *(const u32x2*)(Pm + (size_t)row * PP + 1024 + c0); yb_[j] = *(const u32x2*)(Pm + (size_t)row * PP + 1536 + c0);
            vw_[j] = *(const u32x2*)(SH + ((size_t)row * 8 + h) * 192 + 64 + 4 * cl); bc_[j] = BC[row * 8 + h]; }
        __syncthreads();
        for (int i = tid; i < 18 * 16; i += NTHR) { const int rr = i >> 4, ch = i & 15, row = R0 - 1 + rr;
            u32x4 v = {0u, 0u, 0u, 0u}; if (row >= seq0 && row < seq0 + SEQ) v = *(const u32x4*)(Pm + (size_t)row * PP + RWC + 1792 + ch * 8);
            *(LAS u32x4*)(T + rr * GP + ch * 8) = v; }
        __syncthreads();
        f32x4 gate[4];
#pragma unroll
        for (int nt = 0; nt < 4; ++nt) gate[nt] = (f32x4){0.f, 0.f, 0.f, 0.f};
#pragma unroll
        for (int ks = 0; ks < 4; ++ks) {
            const int cb = ks * 32 + tq * 8, tok = lane & 15;
            float pv[8], cv[8], nv[8], a8[8];
            unpack8(*(const LAS u32x4*)(T + tok * GP + cb), pv); unpack8(*(const LAS u32x4*)(T + (tok + 1) * GP + cb), cv); unpack8(*(const LAS u32x4*)(T + (tok + 2) * GP + cb), nv);
            const f32x4 m0 = *(const f32x4*)(p.rwkv_mu + 1792 + cb), m1 = *(const f32x4*)(p.rwkv_mu + 1792 + cb + 4);
#pragma unroll
            for (int e = 0; e < 8; ++e) { const float mu = e < 4 ? m0[e] : m1[e - 4]; a8[e] = sigmoidf_(cv[e] + mu * (0.5f * (pv[e] + nv[e]) - cv[e])); }
            const bf16x8 a = pack8(a8);
#pragma unroll
            for (int nt = 0; nt < 4; ++nt) gate[nt] = __builtin_amdgcn_mfma_f32_16x16x32_bf16(a, gw_[ks * 4 + nt], gate[nt], 0, 0, 0);
        }
#pragma unroll
        for (int j = 0; j < 4; ++j) {
            const int row = R0 + 4 * tq + j;
            const u32x2 yf = yf_[j], yb = yb_[j];
            const f32x4 y = (f32x4){bf_lo(yf.x), bf_hi(yf.x), bf_lo(yf.y), bf_hi(yf.y)} + (f32x4){bf_lo(yb.x), bf_hi(yb.x), bf_lo(yb.y), bf_hi(yb.y)};
            const float mean = rowsum16((y.x + y.y) + (y.z + y.w)) * (1.0f / 64.0f);
            const f32x4 dv = y - mean;
            const float var = rowsum16((dv.x * dv.x + dv.y * dv.y) + (dv.z * dv.z + dv.w * dv.w)) * (1.0f / 64.0f);
            const float rstd = rsqrtf(var + 64e-5f);
            const u32x2 vw = vw_[j];
            const f32x4 v4 = {bf_lo(vw.x), bf_hi(vw.x), bf_lo(vw.y), bf_hi(vw.y)};
            const float bc = bc_[j];
            const f32x4 gt = {gate[0][j], gate[1][j], gate[2][j], gate[3][j]};
            const f32x4 o = (dv * rstd * lnw + lnb + v4 * bc) * gt;
            st4bf(Pm + (size_t)row * PP + 512 + c0, o);
        }
    }
}

DI void ld8f(const bf16* src, float (&o)[8]) { unpack8(*(const u32x4*)src, o); }
DI void phase_conv(const Params& p, int wave, int lane, int vcu, int G) {
    const bf16* Gm = (const bf16*)(p.ws + WS_G); bf16* Z = (bf16*)(p.ws + WS_Z);
    const int gw = vcu * NWAVES + wave, ngw = G * NWAVES;
    for (int row = gw; row < ML; row += ngw) {
        const int t = row % SEQ;
#pragma unroll
        for (int j = 0; j < 2; ++j) {
            const int col = 8 * lane + 512 * j; const bf16* base = Gm + (size_t)row * 3072 + col;
            float gb[8], gc[8], uu[8], qp[8], qn[8], z[8];
            ld8f(base, gb); ld8f(base + 1024, gc); ld8f(base + 2048, uu);
            if (t > 0) { float a[8], c[8]; ld8f(base - 3072 + 1024, a); ld8f(base - 3072 + 2048, c);
#pragma unroll
                for (int e = 0; e < 8; ++e) qp[e] = a[e] * c[e]; } else {
#pragma unroll
                for (int e = 0; e < 8; ++e) qp[e] = 0.f; }
            if (t < SEQ - 1) { float a[8], c[8]; ld8f(base + 3072 + 1024, a); ld8f(base + 3072 + 2048, c);
#pragma unroll
                for (int e = 0; e < 8; ++e) qn[e] = a[e] * c[e]; } else {
#pragma unroll
                for (int e = 0; e < 8; ++e) qn[e] = 0.f; }
#pragma unroll
            for (int e = 0; e < 8; ++e) z[e] = gb[e] * (p.conv_w[col + e] * qp[e] + p.conv_w[1024 + col + e] * (gc[e] * uu[e]) + p.conv_w[2048 + col + e] * qn[e]);
            *(u32x4*)(Z + (size_t)row * DM + col) = __builtin_bit_cast(u32x4, pack8(z));
        }
    }
}

#define RLX_AGENT __ATOMIC_RELAXED, __HIP_MEMORY_SCOPE_AGENT
#define XB_TMO      128
#define XB_XCNT(j)  (256  + 64 * (j))
#define XB_XSUB(j)  (1280 + 64 * (j))
#define XB_XGEN(j)  (2304 + 64 * (j))
#define XB_TOP      3328
#define XB_TOPGEN   3392
#define XCD_BAR_WORDS 3456
#define XB_SPIN_CAP (1u << 18)

__device__ __forceinline__ unsigned xb_ld(unsigned* p)              { return __hip_atomic_load(p, __ATOMIC_RELAXED, __HIP_MEMORY_SCOPE_AGENT); }
__device__ __forceinline__ unsigned xb_add(unsigned* p, unsigned v) { return __hip_atomic_fetch_add(p, v, __ATOMIC_RELAXED, __HIP_MEMORY_SCOPE_AGENT); }
__device__ __forceinline__ unsigned xb_xcc_id() { return (unsigned)__builtin_amdgcn_s_getreg((3 << 11) | 20) & 0xFu; }
#define XB_SPIN(cond, bar) do { unsigned _sp = 0; while (cond) { __builtin_amdgcn_s_sleep(1); \
    if ((++_sp & 255u) == 0u) { if (xb_ld(&(bar)[XB_TMO])) break; if (_sp > XB_SPIN_CAP) { atomicAdd(&(bar)[XB_TMO], 1u); break; } } } } while (0)

struct XcdBarrier {
    unsigned* bar; unsigned x;
    volatile LAS unsigned* st;
};

__device__ __forceinline__ XcdBarrier xcd_barrier_post(unsigned* bar, volatile LAS unsigned* st) {
    XcdBarrier b; b.bar = bar; b.x = xb_xcc_id(); b.st = st;
    if (threadIdx.x == 0) (void)xb_add(&bar[XB_XCNT(b.x)], 1u);
    return b;
}
__device__ __forceinline__ void xcd_barrier_complete(unsigned* bar, unsigned x, unsigned& nloc, unsigned& nx) {
    const unsigned G = gridDim.x * gridDim.y * gridDim.z;
    unsigned sum, cnt, mine, sp = 0u;
    for (;;) {
        sum = 0u; cnt = 0u; mine = 0u;
#pragma unroll
        for (unsigned j = 0; j < 16; ++j) { const unsigned c = xb_ld(&bar[XB_XCNT(j)]); sum += c; cnt += (c > 0u) ? 1u : 0u; mine = (j == x) ? c : mine; }
        if (sum == G) break;
        __builtin_amdgcn_s_sleep(1);
        if ((++sp & 255u) == 0u) { if (xb_ld(&bar[XB_TMO])) break; if (sp > XB_SPIN_CAP) { atomicAdd(&bar[XB_TMO], 1u); break; } }
    }
    nloc = mine > 0u ? mine : 1u; nx = cnt > 0u ? cnt : 1u;
}

__device__ __forceinline__ void xcd_barrier(const XcdBarrier& b) {
    asm volatile("s_waitcnt vmcnt(0)" ::: "memory");
    __syncthreads();
    if (threadIdx.x == 0) {
        unsigned* bar = b.bar;
        __builtin_amdgcn_s_waitcnt(0);
        unsigned nloc = b.st[0], nx = b.st[1];
        if (nloc == 0u) { xcd_barrier_complete(bar, b.x, nloc, nx); b.st[0] = nloc; b.st[1] = nx; }
        const unsigned old = xb_add(&bar[XB_XSUB(b.x)], 1u);
        const unsigned gen = old / nloc;
        if (old + 1u == (gen + 1u) * nloc) {
            __builtin_amdgcn_fence(__ATOMIC_RELEASE, "agent");
            asm volatile("s_waitcnt vmcnt(0)" ::: "memory");
            const unsigned og = xb_add(&bar[XB_TOP], 1u);
            const unsigned tg = og / nx;
            if (og + 1u == (tg + 1u) * nx) xb_add(&bar[XB_TOPGEN], 1u);
            else XB_SPIN(xb_ld(&bar[XB_TOPGEN]) == tg, bar);
            __builtin_amdgcn_fence(__ATOMIC_ACQUIRE, "agent");
            xb_add(&bar[XB_XGEN(b.x)], 1u);
            asm volatile("s_waitcnt vmcnt(0)" ::: "memory");
        } else {
            XB_SPIN(xb_ld(&bar[XB_XGEN(b.x)]) == gen, bar);
            __builtin_amdgcn_fence(__ATOMIC_ACQUIRE, "agent");
            asm volatile("s_waitcnt vmcnt(0)" ::: "memory");
        }
    }
    __syncthreads();
}

constexpr int N_PHASES = 18;
constexpr int PROBE = 0;
template <int ACT>
DI void run_gemm(LAS unsigned char* lds, const bf16* A, int lda, const bf16* Bt, int M, int N, int K, bf16* O, int ldc, int G) {
    pg8::Gemm g{A, Bt, M, N, K, lda}; pg8::StaticOrder S; S.init(M, N, G, (int)blockIdx.x);
    pg8::EpiBf16<ACT> E{O, ldc, nullptr, 0, 0, 1.f};
    pg8::gemm_phase<pg8::EpiBf16<ACT>, pg8::StaticOrder, true, true>(lds, g, S, E);
}

__global__ void __launch_bounds__(NTHR, 2) mega_fwd(Params p) {
    extern __shared__ __attribute__((aligned(16))) unsigned char lds_raw[];
    LAS unsigned char* lds = (LAS unsigned char*)lds_raw;
    cg::grid_group grid = cg::this_grid();
    const int tid = threadIdx.x, lane = tid & 63, wave = __builtin_amdgcn_readfirstlane(tid >> 6);
    const int G = gridDim.x, bx = blockIdx.x, vcu = (G % 8 == 0) ? (bx % 8) * (G / 8) + bx / 8 : bx;
    unsigned char* ws = p.ws;
    volatile LAS unsigned* misc = (volatile LAS unsigned*)(lds + 131072);
    if (tid < 32) misc[tid] = 0u;
    __syncthreads();
    if (bx == 0) for (int i = tid; i < (int)(WS_BAR_BYTES / 4); i += NTHR) ((unsigned*)(ws + WS_BAR))[i] = 0u;
    XcdBarrier xbar; xbar.bar = (unsigned*)(ws + WS_BAR); xbar.x = 0; xbar.st = misc + 8;
    const float* mod0 = (const float*)(ws + WS_MOD); const float* mod1 = mod0 + 5 * 6144;
    const float* ng0 = p.norm_g; const float* ng1 = p.norm_g + 4 * DM;
#define IN(k) (p.ph_lo <= (k) && (k) < p.ph_hi)
#define SEAM(k) do { if (IN(k) && IN((k) + 1)) { if ((k) == 0) grid.sync(); else xcd_barrier(xbar); } } while (0)
    if (IN(0)) { phase_prologue(p, lds, tid, wave, lane, vcu, G); if (PROBE == 7) { __syncthreads(); phase_prologue(p, lds, tid, wave, lane, vcu, G); } }
    SEAM(0);
    xbar = xcd_barrier_post((unsigned*)(ws + WS_BAR), misc + 8);
    if (IN(1)) phase_norm0(p, wave, lane, vcu, G);
    SEAM(1);
    if (IN(2)) run_gemm<0>(lds, (const bf16*)(ws + WS_A0), DM, (const bf16*)(ws + WS_WINT), MT, PP, DM, (bf16*)(ws + WS_P), PP, G);
    SEAM(2);
    if (IN(3)) { phase_features(p, lds, tid, wave, lane, vcu, G);  }
    SEAM(3);
    if (IN(4)) { if (PROBE == 8) { phase_attention<1>(p, lds, tid, wave, lane, vcu, G); __syncthreads(); }
        for (int su = vcu; su < 256; su += G) phase_scan<0>(p, lds, tid, wave, lane, su); __syncthreads(); if (PROBE == 2) { for (int su = vcu; su < 256; su += G) phase_scan<0>(p, lds, tid, wave, lane, su); __syncthreads(); }
        if (PROBE == 5) { for (int su = vcu; su < 256; su += G) phase_scan<1>(p, lds, tid, wave, lane, su); __syncthreads(); }
        if (PROBE == 6) { for (int su = vcu; su < 256; su += G) phase_scan<2>(p, lds, tid, wave, lane, su); __syncthreads(); } }
    SEAM(4);
    if (IN(5)) { phase_rwkv_out(p, lds, tid, wave, lane, vcu, G); __syncthreads(); phase_weights2(p, lds, wave, lane, vcu, G);
        if (PROBE == 9) { __syncthreads(); phase_rwkv_out(p, lds, tid, wave, lane, vcu, G); __syncthreads(); phase_weights2(p, lds, wave, lane, vcu, G); }
        if (PROBE == 3) { __syncthreads(); phase_weights2(p, lds, wave, lane, vcu, G); } if (PROBE == 4) { __syncthreads(); phase_rwkv_out(p, lds, tid, wave, lane, vcu, G); } }
    SEAM(5);
    if (IN(6)) run_gemm<0>(lds, (const bf16*)(ws + WS_P), PP, (const bf16*)(ws + WS_WOUTT), ML, DM, DM, (bf16*)(ws + WS_YL), DM, G);
    SEAM(6);
    if (IN(7)) { phase_norm1<false, true>((const bf16*)(ws + WS_YL), p.x, ws + WS_XLB, ng0 + DM, mod0, 2048, ng0 + 2 * DM, 3072, 4096, (bf16*)(ws + WS_A1), wave, lane, vcu, G);
        if (PROBE == 1) phase_norm1<false, true>((const bf16*)(ws + WS_YL), p.x, ws + WS_XLB, ng0 + DM, mod0, 2048, ng0 + 2 * DM, 3072, 4096, (bf16*)(ws + WS_A1), wave, lane, vcu, G); }
    SEAM(7);
    if (IN(8)) run_gemm<1>(lds, (const bf16*)(ws + WS_A1), DM, (const bf16*)(ws + WS_W1T0), ML, HID, DM, (bf16*)(ws + WS_H), HID, G);
    SEAM(8);
    if (IN(9)) run_gemm<0>(lds, (const bf16*)(ws + WS_H), HID, (const bf16*)(ws + WS_W2T0), ML, DM, HID, (bf16*)(ws + WS_YL), DM, G);
    SEAM(9);
    if (IN(10)) phase_norm1<true, true>((const bf16*)(ws + WS_YL), ws + WS_XLB, ws + WS_XLB, ng0 + 3 * DM, mod0, 5120, ng1, 30720, 30720 + 1024, (bf16*)(ws + WS_A1), wave, lane, vcu, G);
    SEAM(10);
    if (IN(11)) run_gemm<0>(lds, (const bf16*)(ws + WS_A1), DM, (const bf16*)(ws + WS_CINT), ML, 3 * DM, DM, (bf16*)(ws + WS_G), 3 * DM, G);
    SEAM(11);
    if (IN(12)) phase_conv(p, wave, lane, vcu, G);
    SEAM(12);
    if (IN(13)) run_gemm<0>(lds, (const bf16*)(ws + WS_Z), DM, (const bf16*)(ws + WS_COUTT), ML, DM, DM, (bf16*)(ws + WS_YL), DM, G);
    SEAM(13);
    if (IN(14)) phase_norm1<true, true>((const bf16*)(ws + WS_YL), ws + WS_XLB, ws + WS_XLB, ng1 + DM, mod1, 2048, ng1 + 2 * DM, 3072, 4096, (bf16*)(ws + WS_A1), wave, lane, vcu, G);
    SEAM(14);
    if (IN(15)) run_gemm<1>(lds, (const bf16*)(ws + WS_A1), DM, (const bf16*)(ws + WS_W1T1), ML, HID, DM, (bf16*)(ws + WS_H), HID, G);
    SEAM(15);
    if (IN(16)) run_gemm<0>(lds, (const bf16*)(ws + WS_H), HID, (const bf16*)(ws + WS_W2T1), ML, DM, HID, (bf16*)(ws + WS_YL), DM, G);
    SEAM(16);
    if (IN(17)) phase_norm1<true, false>((const bf16*)(ws + WS_YL), ws + WS_XLB, p.out, ng1 + 3 * DM, mod1, 5120, nullptr, 0, 0, nullptr, wave, lane, vcu, G);
#undef IN
#undef SEAM
}

extern "C" void kernel_launch(void* const* d_in, const int* in_sizes, int n_in, void* d_out, int out_size, void* d_ws, size_t ws_size, hipStream_t stream) {
    static int grid = 0;
    if (grid == 0) {
        if (n_in != 26 || out_size != ML * DM || ws_size < WS_END) { fprintf(stderr, "kernel_launch: unexpected shapes (n_in %d out %d ws %zu)\n", n_in, out_size, ws_size); grid = -1; return; }
        int dev = 0, cus = 0, per_cu = 0;
        (void)hipGetDevice(&dev); (void)hipDeviceGetAttribute(&cus, hipDeviceAttributeMultiprocessorCount, dev);
        if (hipFuncSetAttribute((const void*)mega_fwd, hipFuncAttributeMaxDynamicSharedMemorySize, LDS_BYTES) != hipSuccess) { fprintf(stderr, "kernel_launch: hipFuncSetAttribute failed\n"); grid = -1; return; }
        if (hipOccupancyMaxActiveBlocksPerMultiprocessor(&per_cu, (const void*)mega_fwd, NTHR, LDS_BYTES) != hipSuccess || per_cu < 1) per_cu = 1;
        (void)hipGetLastError();
        grid = cus * per_cu; if (grid > 256) grid = 256; if (grid < 1) grid = 256;
    }
    if (grid < 0) return;
    Params p{};
    const float** f = (const float**)&p;
    for (int i = 0; i < 26; ++i) f[i] = (const float*)d_in[i];
    p.out = (float*)d_out; p.ws = (unsigned char*)d_ws;
#ifndef MK_SPLIT
    p.ph_lo = 0; p.ph_hi = N_PHASES;
    void* args[] = {&p};
    hipError_t e = hipLaunchCooperativeKernel((void*)mega_fwd, dim3(grid), dim3(NTHR), args, LDS_BYTES, stream);
    if (e != hipSuccess) fprintf(stderr, "cooperative launch failed: %s (grid %d)\n", hipGetErrorString(e), grid);
#else
    for (int k = 0; k < N_PHASES; ++k) { p.ph_lo = k; p.ph_hi = k + 1; void* args[] = {&p};
        hipError_t e = hipLaunchCooperativeKernel((void*)mega_fwd, dim3(grid), dim3(NTHR), args, LDS_BYTES, stream);
        if (e != hipSuccess) { fprintf(stderr, "launch %d failed: %s\n", k, hipGetErrorString(e)); break; } }
#endif
}
```

```cpp
#include <hip/hip_runtime.h>
#include <hip/hip_cooperative_groups.h>
#include <cstdio>
#include <cstdint>
namespace cg = cooperative_groups;
namespace pg8 {
#define PG8_LAS __attribute__((address_space(3)))
typedef unsigned short bf16_t;
typedef short bf16x8 __attribute__((ext_vector_type(8)));
typedef float f32x4 __attribute__((ext_vector_type(4)));
typedef unsigned u32x4 __attribute__((ext_vector_type(4)));
constexpr int BM = 256, BK = 64, HALF = 128, HTB = HALF * BK * 2  , STAGE_BYTES = 8 * HTB, NXCD = 8, WGM = 4;

__host__ __device__ __forceinline__ int lds_byte(int r, int c) { const int st = (r >> 4) * 2 + (c >> 5), rr = r & 15, cc = c & 31, ob = rr * 64 + cc * 2; return st * 1024 + (ob ^ (((ob >> 9) & 1) << 5)); }
__host__ __device__ __forceinline__ void stage_rc(int b, int& R, int& C) { const int st = b / 1024, sb = b % 1024, swz = sb ^ (((sb >> 9) & 1) << 5); R = (st >> 1) * 16 + swz / 64; C = (st & 1) * 32 + (swz % 64) / 2; }
__host__ __device__ __forceinline__ int perm32(int rho) { const int n = rho >> 4, i = rho & 15; return 8 * (i >> 2) + 4 * n + (i & 3); }

struct Unit { int pm, pn; };
struct Gemm { const bf16_t* A; const bf16_t* Bt; int M, N, K, lda; };

struct StaticOrder {
    int nM, nN, nwg, G, c;
    __host__ __device__ void init(int M, int N, int G_, int c_) { nM = M / BM; nN = N / BM; nwg = nM * nN; G = G_; c = c_; }
    __host__ __device__ bool next(int i, Unit& u) const {
        const long L = (long)i * G + c; if (L >= nwg) return false;
        int wgid = (int)L; { const int q = nwg / NXCD, r = nwg % NXCD, xcd = wgid % NXCD, off = wgid / NXCD; wgid = (xcd < r ? xcd * (q + 1) : r * (q + 1) + (xcd - r) * q) + off; }
        const int nig = WGM * nN, gid = wgid / nig, fm = gid * WGM, gsz = (nM - fm) < WGM ? (nM - fm) : WGM;
        u.pm = fm + ((wgid % nig) % gsz); u.pn = (wgid % nig) / gsz; return true;
    }
    __device__ __forceinline__ void a_ready(const Unit&) const {}
    __device__ __forceinline__ void done(const Unit&) const {}
};

__device__ __forceinline__ unsigned cvt_pk_bf16(float lo, float hi) { unsigned r; asm volatile("v_cvt_pk_bf16_f32 %0, %1, %2" : "=v"(r) : "v"(lo), "v"(hi)); return r; }
typedef float f32x2 __attribute__((ext_vector_type(2)));
__device__ __forceinline__ f32x2 gelu_pk(f32x2 v) {
    const f32x2 av = __builtin_elementwise_abs(v), d = av * 0.2316418882f + 1.0f;
    f32x2 t; t.x = __builtin_amdgcn_rcpf(d.x); t.y = __builtin_amdgcn_rcpf(d.y);
    f32x2 q = t * 0.5307027145f + (-0.7265760135f); q = q * t + 0.7107068705f; q = q * t + (-0.142248368f); q = q * t + 0.127414796f; q = q * t;
    const f32x2 s = (v * v) * (-0.72134752044f);
    f32x2 e; e.x = __builtin_amdgcn_exp2f(s.x); e.y = __builtin_amdgcn_exp2f(s.y);
    const f32x2 m = v * (q * e), r = v - m;
    f32x2 o; o.x = v.x < 0.f ? m.x : r.x; o.y = v.y < 0.f ? m.y : r.y; return o;
}

template <int ACT  > struct EpiBf16 {
    static constexpr bool PERM = true, AFTER_DRAIN = false; static_assert(ACT == 0 || ACT == 1, "EpiBf16: ACT is 0 or 1");
    bf16_t* O; int ldc; const float* bias; int split_cols; size_t split_stride; float scale0;
    __device__ __forceinline__ void operator()(const f32x4 (&acc)[2][2][4][2], const Unit& u, int wr, int wc, int fr, int fq) const {
        const int row0 = u.pm * BM + wr * 64 + fr; int colt = u.pn * BM; bf16_t* base = O;
        float sc = 1.f; if (split_cols) { const int t = colt / split_cols; base += (size_t)t * split_stride; colt -= t * split_cols; if (t == 0) sc = scale0; }
        const int col0 = colt + wc * 32 + 8 * fq, bcol0 = u.pn * BM + wc * 32 + 8 * fq;
        f32x4 bv[2][2];
#pragma unroll
        for (int bj = 0; bj < 2; ++bj)
#pragma unroll
            for (int n = 0; n < 2; ++n) bv[bj][n] = bias ? *(const f32x4*)(bias + bcol0 + bj * HALF + 4 * n) : (f32x4){0.f, 0.f, 0.f, 0.f};
#pragma unroll
        for (int ai = 0; ai < 2; ++ai)
#pragma unroll
            for (int m = 0; m < 4; ++m) { bf16_t* rowp = base + (size_t)(row0 + ai * HALF + m * 16) * ldc + col0;
#pragma unroll
                for (int bj = 0; bj < 2; ++bj) { f32x4 v0 = acc[ai][bj][m][0] + bv[bj][0], v1 = acc[ai][bj][m][1] + bv[bj][1];
                    if (ACT == 1) { v0 = __builtin_elementwise_max(v0, (f32x4){0.f, 0.f, 0.f, 0.f}); v1 = __builtin_elementwise_max(v1, (f32x4){0.f, 0.f, 0.f, 0.f}); v0 = v0 * v0; v1 = v1 * v1; }
                    v0 = v0 * sc; v1 = v1 * sc; u32x4 w; w.x = cvt_pk_bf16(v0[0], v0[1]); w.y = cvt_pk_bf16(v0[2], v0[3]); w.z = cvt_pk_bf16(v1[0], v1[1]); w.w = cvt_pk_bf16(v1[2], v1[3]);
                    *(u32x4*)(rowp + bj * HALF) = w; } }
    }
};

template <class Epi, class Sched, bool ALIGN_EPI = false, bool SP2 = false>
__device__ __forceinline__ void gemm_phase(PG8_LAS unsigned char* lds, const Gemm g, const Sched& S, const Epi& E) {
    const int tid = threadIdx.x, wid = __builtin_amdgcn_readfirstlane(tid >> 6), lane = tid & 63, wr = wid >> 2, wc = wid & 3, fr = lane & 15, fq = lane >> 4;
    const int K = g.K, nt = K / BK;
    unsigned voffA[2], voffB[2];
#pragma unroll
    for (int i = 0; i < 2; ++i) { int R, C; stage_rc(tid * 16 + i * 8192, R, C); const int Rb = Epi::PERM ? ((R & ~31) + perm32(R & 31)) : R;
        voffA[i] = (unsigned)(R * g.lda + C) * 2u; voffB[i] = (unsigned)(Rb * K + C) * 2u; }
    const size_t kstep = (size_t)(BK * 2);
    const size_t hstep = (size_t)HALF * K * 2;
    const size_t tstep = 2 * hstep; const size_t hstepA = (size_t)HALF * g.lda * 2, tstepA = 2 * hstepA;
    const unsigned ldsw = (unsigned)wid * 1024u;
    const int aoff = lds_byte(wr * 64 + fr, fq * 8), boff = lds_byte(wc * 32 + fr, fq * 8);
#define PG8_SA(b, h) (((b) * 2 + (h)) * HTB)
#define PG8_SB(b, h) ((4 + (b) * 2 + (h)) * HTB)
#define PG8_STAGE(bufoff, gbase, voff) do { _Pragma("unroll") for (int _i = 0; _i < 2; ++_i) \
        __builtin_amdgcn_global_load_lds((const unsigned*)((const char*)(gbase) + (voff)[_i]), (PG8_LAS unsigned*)(lds + (bufoff) + ldsw + _i * 8192), 16, 0, 0); } while (0)
#define PG8_LDA(dst, b, h) do { _Pragma("unroll") for (int m = 0; m < 4; ++m) _Pragma("unroll") for (int k = 0; k < 2; ++k) dst[m][k] = *(const PG8_LAS bf16x8*)(lds + PG8_SA(b, h) + aoff + m * 2048 + k * 1024); } while (0)
#define PG8_LDB(dst, b, h) do { _Pragma("unroll") for (int n = 0; n < 2; ++n) _Pragma("unroll") for (int k = 0; k < 2; ++k) dst[n][k] = *(const PG8_LAS bf16x8*)(lds + PG8_SB(b, h) + boff + n * 2048 + k * 1024); } while (0)
#define PG8_MMA(ai, bj, At, Bt) do { __builtin_amdgcn_s_setprio(1); _Pragma("unroll") for (int m = 0; m < 4; ++m) _Pragma("unroll") for (int n = 0; n < 2; ++n) _Pragma("unroll") for (int k = 0; k < 2; ++k) \
        acc[ai][bj][m][n] = __builtin_amdgcn_mfma_f32_16x16x32_bf16(Bt[n][k], At[m][k], acc[ai][bj][m][n], 0, 0, 0); __builtin_amdgcn_s_setprio(0); } while (0)
#define PG8_WAIT_V(n) asm volatile("s_waitcnt vmcnt(" #n ")" ::: "memory")
#define PG8_WAIT_L(n) asm volatile("s_waitcnt lgkmcnt(" #n ")" ::: "memory")
#define PG8_BAR __builtin_amdgcn_s_barrier()
#define PG8_SCHED __builtin_amdgcn_sched_barrier(0)
    Unit cur, nxt; int ui = 0;
    if (!S.next(0, cur)) return;
    f32x4 acc[2][2][4][2];
#pragma unroll
    for (int a = 0; a < 2; ++a)
#pragma unroll
        for (int b = 0; b < 2; ++b)
#pragma unroll
            for (int m = 0; m < 4; ++m)
#pragma unroll
                for (int n = 0; n < 2; ++n) acc[a][b][m][n] = (f32x4){0.f, 0.f, 0.f, 0.f};
    bf16x8 At[4][2], B0[2][2], B1[2][2];
    const char* cA = (const char*)g.A + (size_t)cur.pm * tstepA; const char* cB = (const char*)g.Bt + (size_t)cur.pn * tstep;
    S.a_ready(cur);
    if constexpr (SP2) {
        PG8_STAGE(PG8_SB(0, 0), cB, voffB); PG8_STAGE(PG8_SB(0, 1), cB + hstep, voffB); PG8_STAGE(PG8_SA(0, 0), cA, voffA); PG8_STAGE(PG8_SA(0, 1), cA + hstepA, voffA);
        if (wr == 1) PG8_BAR;
        PG8_WAIT_V(2); PG8_BAR;
        PG8_STAGE(PG8_SB(1, 0), cB + kstep, voffB); PG8_STAGE(PG8_SA(1, 0), cA + kstep, voffA); PG8_STAGE(PG8_SB(1, 1), cB + hstep + kstep, voffB);
        PG8_WAIT_V(6); PG8_BAR;
    } else {
        PG8_STAGE(PG8_SB(0, 0), cB, voffB); PG8_STAGE(PG8_SA(0, 0), cA, voffA); PG8_STAGE(PG8_SB(0, 1), cB + hstep, voffB); PG8_STAGE(PG8_SA(0, 1), cA + hstepA, voffA);
        if (wr == 1) PG8_BAR;
        PG8_WAIT_V(4); PG8_BAR;
        PG8_STAGE(PG8_SB(1, 0), cB + kstep, voffB); PG8_STAGE(PG8_SA(1, 0), cA + kstep, voffA); PG8_STAGE(PG8_SB(1, 1), cB + hstep + kstep, voffB);
        PG8_WAIT_V(6); PG8_BAR;
    }
    for (;;) {
        const bool has_next = S.next(ui + 1, nxt);
        const char* nA = has_next ? (const char*)g.A + (size_t)nxt.pm * tstepA : cA; const char* nB = has_next ? (const char*)g.Bt + (size_t)nxt.pn * tstep : cB;
        for (int t = 0; t < nt; t += 2) {
            const bool last = (t == nt - 2);
            const char* a1 = cA + (size_t)(t + 1) * kstep;
            const char* a2 = last ? nA : cA + (size_t)(t + 2) * kstep; const char* b2 = last ? nB : cB + (size_t)(t + 2) * kstep;
            const char* a3 = a2 + kstep; const char* b3 = b2 + kstep;
            if (last && has_next) S.a_ready(nxt);
            if constexpr (SP2) {
            PG8_LDB(B0, 0, 0); PG8_LDB(B1, 0, 1); PG8_SCHED; PG8_LDA(At, 0, 0); PG8_STAGE(PG8_SA(1, 1), a1 + hstepA, voffA);
            PG8_WAIT_V(8); PG8_WAIT_L(0); PG8_BAR; PG8_MMA(0, 0, At, B0); PG8_MMA(0, 1, At, B1); PG8_BAR; PG8_SCHED;
            PG8_LDA(At, 0, 1); PG8_STAGE(PG8_SB(0, 0), b2, voffB); PG8_STAGE(PG8_SB(0, 1), b2 + hstep, voffB); PG8_STAGE(PG8_SA(0, 0), a2, voffA);
            PG8_WAIT_V(8); PG8_WAIT_L(0); PG8_BAR; PG8_MMA(1, 0, At, B0); PG8_MMA(1, 1, At, B1); PG8_BAR; PG8_SCHED;
            PG8_LDB(B0, 1, 0); PG8_LDB(B1, 1, 1); PG8_SCHED; PG8_LDA(At, 1, 0); PG8_STAGE(PG8_SA(0, 1), a2 + hstepA, voffA);
            PG8_WAIT_V(8); PG8_WAIT_L(0); PG8_BAR; PG8_MMA(0, 0, At, B0); PG8_MMA(0, 1, At, B1); PG8_BAR; PG8_SCHED;
            PG8_LDA(At, 1, 1); PG8_STAGE(PG8_SB(1, 0), b3, voffB); PG8_STAGE(PG8_SB(1, 1), b3 + hstep, voffB); PG8_STAGE(PG8_SA(1, 0), a3, voffA);
            PG8_WAIT_V(8); PG8_WAIT_L(0); PG8_BAR; PG8_MMA(1, 0, At, B0); PG8_MMA(1, 1, At, B1); PG8_BAR; PG8_SCHED;
            } else {
            PG8_LDB(B0, 0, 0); PG8_SCHED; PG8_LDA(At, 0, 0); PG8_STAGE(PG8_SA(1, 1), a1 + hstepA, voffA);
            PG8_WAIT_L(8); PG8_BAR; PG8_WAIT_L(0); PG8_MMA(0, 0, At, B0); PG8_BAR; PG8_SCHED;
            PG8_LDB(B1, 0, 1); PG8_STAGE(PG8_SB(0, 0), b2, voffB);
            PG8_BAR; PG8_WAIT_L(0); PG8_MMA(0, 1, At, B1); PG8_BAR;
            PG8_LDA(At, 0, 1); PG8_STAGE(PG8_SA(0, 0), a2, voffA);
            PG8_BAR; PG8_WAIT_L(0); PG8_MMA(1, 0, At, B0); PG8_BAR; PG8_SCHED;
            PG8_STAGE(PG8_SB(0, 1), b2 + hstep, voffB);
            PG8_WAIT_V(6); PG8_BAR; PG8_MMA(1, 1, At, B1); PG8_BAR;
            PG8_LDB(B0, 1, 0); PG8_SCHED; PG8_LDA(At, 1, 0); PG8_STAGE(PG8_SA(0, 1), a2 + hstepA, voffA);
            PG8_WAIT_L(8); PG8_BAR; PG8_WAIT_L(0); PG8_MMA(0, 0, At, B0); PG8_BAR; PG8_SCHED;
            PG8_LDB(B1, 1, 1); PG8_STAGE(PG8_SB(1, 0), b3, voffB);
            PG8_BAR; PG8_WAIT_L(0); PG8_MMA(0, 1, At, B1); PG8_BAR;
            PG8_LDA(At, 1, 1); PG8_STAGE(PG8_SA(1, 0), a3, voffA);
            PG8_BAR; PG8_WAIT_L(0); PG8_MMA(1, 0, At, B0); PG8_BAR; PG8_SCHED;
            PG8_STAGE(PG8_SB(1, 1), b3 + hstep, voffB);
            PG8_WAIT_V(6); PG8_BAR; PG8_MMA(1, 1, At, B1); PG8_BAR;
            }
        }
        if constexpr (ALIGN_EPI) { if (wr == 0) PG8_BAR; }
        if constexpr (!Epi::AFTER_DRAIN) { E(acc, cur, wr, wc, fr, fq); S.done(cur); }
        if (!has_next) break;
#pragma unroll
        for (int a = 0; a < 2; ++a)
#pragma unroll
            for (int b = 0; b < 2; ++b)
#pragma unroll
                for (int m = 0; m < 4; ++m)
#pragma unroll
                    for (int n = 0; n < 2; ++n) acc[a][b][m][n] = (f32x4){0.f, 0.f, 0.f, 0.f};
        cur = nxt; cA = nA; cB = nB; ++ui;
        if constexpr (ALIGN_EPI) { if (wr == 1) PG8_BAR; }
    }
    PG8_WAIT_V(0);
    if constexpr (!ALIGN_EPI) { if (wr == 0) PG8_BAR; }
    PG8_BAR;
    if constexpr (Epi::AFTER_DRAIN) { E.fused(acc, cur, wr, wc, fr, fq, lds, wid, lane); S.done(cur); }
#undef PG8_SA
#undef PG8_SB
#undef PG8_STAGE
#undef PG8_LDA
#undef PG8_LDB
#undef PG8_MMA
#undef PG8_WAIT_V
#undef PG8_WAIT_L
#undef PG8_BAR
#undef PG8_SCHED
}
}

#define DI __device__ __forceinline__
#define LAS __attribute__((address_space(3)))
typedef unsigned short bf16;
typedef float f32x2 __attribute__((ext_vector_type(2)));
typedef float f32x4 __attribute__((ext_vector_type(4)));
typedef float f32x16 __attribute__((ext_vector_type(16)));
typedef short bf16x8 __attribute__((ext_vector_type(8)));
typedef unsigned u32x2 __attribute__((ext_vector_type(2)));
typedef unsigned u32x4 __attribute__((ext_vector_type(4)));
typedef __bf16 bfv2 __attribute__((ext_vector_type(2)));

constexpr int NWAVES = 8, NTHR = 512;
constexpr int DM = 1024, NB = 4, SEQ = 8192, CTXL = 256, HID = 4096;
constexpr int ML = NB * SEQ, MC = NB * CTXL, MT = ML + MC;
constexpr int PP = 2816;
constexpr int RWC = 768;
constexpr int NPOS = CTXL + SEQ;
constexpr size_t MiB = 1u << 20;
constexpr size_t WS_BAR = 3 * MiB, WS_BAR_BYTES = 16384;
constexpr size_t WS_MOD = 0, WS_W2T = 256 * 1024, WS_A2T = 384 * 1024, WS_G2T = 512 * 1024, WS_BC = 1 * MiB;
constexpr size_t WS_CC = 4 * MiB;
constexpr size_t WS_WINT = 4 * MiB, WS_WOUTT = 10 * MiB, WS_P = 12 * MiB, WS_KP = 194 * MiB, WS_VT = 203 * MiB;
constexpr size_t WS_SH = 212 * MiB, WS_SD0 = 311 * MiB, WS_SD1 = 410 * MiB, WS_A0 = 212 * MiB;
constexpr size_t WS_W1T0 = 340 * MiB, WS_W2T0 = 348 * MiB, WS_W1T1 = 356 * MiB, WS_W2T1 = 364 * MiB, WS_CINT = 372 * MiB, WS_COUTT = 378 * MiB;
constexpr size_t WS_XLB = 268 * MiB;
constexpr size_t WS_YL = 380 * MiB, WS_A1 = 444 * MiB, WS_H = 12 * MiB, WS_G = 12 * MiB, WS_Z = 204 * MiB, WS_END = 509 * MiB;
constexpr int LDS_BYTES = 147456;
constexpr float LOG2E = 1.4426950408889634f;

struct Params {
    const float *x, *c, *ctx, *c_ctx, *mod_w, *mod_b, *norm_g, *mlp_w1, *mlp_w2, *ab_w_in, *ab_w_out, *att_sink;
    const float *rwkv_mu, *rwkv_w0, *rwkv_w2, *rwkv_a0, *rwkv_a2, *rwkv_g2, *rwkv_kk, *rwkv_ka, *rwkv_rk, *rwkv_ln_w, *rwkv_ln_b;
    const float *conv_w_in, *conv_w, *conv_w_out;
    float* out; unsigned char* ws;
    int ph_lo, ph_hi;
};

DI float bf_lo(unsigned p) { return __uint_as_float(p << 16); }
DI float bf_hi(unsigned p) { return __uint_as_float(p & 0xffff0000u); }
DI float bf1(bf16 v) { return __uint_as_float((unsigned)v << 16); }
DI unsigned pk2(float lo, float hi) { f32x2 v = {lo, hi}; bfv2 r = __builtin_convertvector(v, bfv2); return __builtin_bit_cast(unsigned, r); }
DI float wave_sum(float v) {
#pragma unroll
    for (int o = 1; o < 64; o <<= 1) v += __shfl_xor(v, o);
    return v;
}
#define DPP_ADD(x, ctrl) x += __builtin_bit_cast(float, __builtin_amdgcn_update_dpp(0, __builtin_bit_cast(int, x), ctrl, 0xf, 0xf, true))
DI float rowsum16(float x) { DPP_ADD(x, 0xB1); DPP_ADD(x, 0x4E); DPP_ADD(x, 0x141); DPP_ADD(x, 0x140); return x; }
DI float sigmoidf_(float z) { return __builtin_amdgcn_rcpf(1.0f + __expf(-z)); }
DI float tanhf_(float z) { const float e = __expf(-2.0f * fabsf(z)); const float t = (1.0f - e) * __builtin_amdgcn_rcpf(1.0f + e); return z < 0.f ? -t : t; }

DI void transpose_item(const float* W, int K, int N, bf16* WT, LAS float* scr, int item, int lane) {
    const int nblk = N / 32, kb = item / nblk, nb = item % nblk, k0 = 64 * kb, n0 = 32 * nb;
#pragma unroll 8
    for (int i = 0; i < 32; ++i) { const int kk = 2 * i + (lane >> 5); scr[kk * 33 + (lane & 31)] = W[(size_t)(k0 + kk) * N + n0 + (lane & 31)]; }
    asm volatile("s_waitcnt lgkmcnt(0)" ::: "memory");
    const int c = lane & 7;
#pragma unroll
    for (int j = 0; j < 4; ++j) { const int n = (lane >> 3) + 8 * j; const LAS float* s = scr + (8 * c) * 33 + n;
        u32x4 o; o.x = pk2(s[0 * 33], s[1 * 33]); o.y = pk2(s[2 * 33], s[3 * 33]); o.z = pk2(s[4 * 33], s[5 * 33]); o.w = pk2(s[6 * 33], s[7 * 33]);
        *(u32x4*)(WT + (size_t)(n0 + n) * K + k0 + 8 * c) = o; }
    asm volatile("s_waitcnt lgkmcnt(0)" ::: "memory");
}
DI void transpose_load(const float* W, int N, int item, int lane, float (&t)[32]) {
    const int nblk = N / 32, kb = item / nblk, nb = item % nblk, k0 = 64 * kb, n0 = 32 * nb;
#pragma unroll
    for (int i = 0; i < 32; ++i) t[i] = W[(size_t)(k0 + 2 * i + (lane >> 5)) * N + n0 + (lane & 31)];
}
DI void transpose_store(int K, int N, bf16* WT, LAS float* scr, int item, int lane, const float (&t)[32]) {
    const int nblk = N / 32, kb = item / nblk, nb = item % nblk, k0 = 64 * kb, n0 = 32 * nb;
#pragma unroll
    for (int i = 0; i < 32; ++i) scr[(2 * i + (lane >> 5)) * 33 + (lane & 31)] = t[i];
    asm volatile("s_waitcnt lgkmcnt(0)" ::: "memory");
    const int c = lane & 7;
#pragma unroll
    for (int j = 0; j < 4; ++j) { const int n = (lane >> 3) + 8 * j; const LAS float* s = scr + (8 * c) * 33 + n;
        u32x4 o; o.x = pk2(s[0 * 33], s[1 * 33]); o.y = pk2(s[2 * 33], s[3 * 33]); o.z = pk2(s[4 * 33], s[5 * 33]); o.w = pk2(s[6 * 33], s[7 * 33]);
        *(u32x4*)(WT + (size_t)(n0 + n) * K + k0 + 8 * c) = o; }
    asm volatile("s_waitcnt lgkmcnt(0)" ::: "memory");
}
DI void transpose_all(const float* W, int K, int N, bf16* WT, LAS float* scr, int gw, int ngw, int lane) {
    const int items = (K / 64) * (N / 32);
    for (int it = gw; it < items; it += 2 * ngw) {
        float ta[32], tb[32]; const bool two = it + ngw < items;
        transpose_load(W, N, it, lane, ta); if (two) transpose_load(W, N, it + ngw, lane, tb);
        transpose_store(K, N, WT, scr, it, lane, ta); if (two) transpose_store(K, N, WT, scr, it + ngw, lane, tb);
    }
}

DI void phase_prologue(const Params& p, LAS unsigned char* lds, int tid, int wave, int lane, int vcu, int G) {
    LAS float* sv = (LAS float*)lds;
    LAS float* part = (LAS float*)(lds + 20480);
    for (int i = tid; i < 5 * DM; i += NTHR) { const int v = i >> 10, k = i & 1023; const float cv = v < 4 ? p.c[v * DM + k] : p.c_ctx[k]; sv[i] = cv * __builtin_amdgcn_rcpf(1.0f + __expf(-cv)); }
    __syncthreads();
    float* mod = (float*)(p.ws + WS_MOD);
    for (int u = vcu; u < 192; u += G) {
        const int l = u / 96, n0 = (u % 96) * 64;
        const float* W = p.mod_w + (size_t)l * DM * 6144 + n0 + lane;
        float acc[5] = {0.f, 0.f, 0.f, 0.f, 0.f};
#pragma unroll 8
        for (int k = wave * 128; k < wave * 128 + 128; ++k) { const float w = W[(size_t)k * 6144];
#pragma unroll
            for (int v = 0; v < 5; ++v) acc[v] += sv[v * DM + k] * w; }
#pragma unroll
        for (int v = 0; v < 5; ++v) part[(wave * 5 + v) * 64 + lane] = acc[v];
        __syncthreads();
        if (tid < 320) { const int v = tid >> 6, n = tid & 63; float s = p.mod_b[l * 6144 + n0 + n];
#pragma unroll
            for (int w = 0; w < 8; ++w) s += part[(w * 5 + v) * 64 + n];
            mod[(l * 5 + v) * 6144 + n0 + n] = s; }
        __syncthreads();
    }
    __syncthreads();
    LAS float* scr = (LAS float*)(lds + wave * 16384);
    const int gw = vcu * NWAVES + wave, ngw = G * NWAVES;
    transpose_all(p.ab_w_in, DM, 2688, (bf16*)(p.ws + WS_WINT), scr, gw, ngw, lane);
    transpose_all(p.ab_w_out, DM, DM, (bf16*)(p.ws + WS_WOUTT), scr, gw, ngw, lane);
    for (int d = 0; d < 2; ++d) {
        transpose_all(p.rwkv_w2 + d * 64 * 512, 64, 512, (bf16*)(p.ws + WS_W2T) + d * 512 * 64, scr, gw, ngw, lane);
        transpose_all(p.rwkv_a2 + d * 64 * 512, 64, 512, (bf16*)(p.ws + WS_A2T) + d * 512 * 64, scr, gw, ngw, lane);
    }
    transpose_all(p.rwkv_g2, 128, 512, (bf16*)(p.ws + WS_G2T), scr, gw, ngw, lane);
    { u32x4* z = (u32x4*)((bf16*)(p.ws + WS_WINT) + (size_t)2688 * DM); const int n16 = 128 * DM * 2 / 16;
      for (int i = gw * 64 + lane; i < n16; i += ngw * 64) z[i] = (u32x4){0u, 0u, 0u, 0u}; }
}
DI void phase_weights2(const Params& p, LAS unsigned char* lds, int wave, int lane, int vcu, int G) {
    LAS float* scr = (LAS float*)(lds + wave * 16384);
    const int gw = vcu * NWAVES + wave, ngw = G * NWAVES;
    transpose_all(p.mlp_w1, DM, HID, (bf16*)(p.ws + WS_W1T0), scr, gw, ngw, lane);
    transpose_all(p.mlp_w2, HID, DM, (bf16*)(p.ws + WS_W2T0), scr, gw, ngw, lane);
    transpose_all(p.mlp_w1 + (size_t)DM * HID, DM, HID, (bf16*)(p.ws + WS_W1T1), scr, gw, ngw, lane);
    transpose_all(p.mlp_w2 + (size_t)DM * HID, HID, DM, (bf16*)(p.ws + WS_W2T1), scr, gw, ngw, lane);
    transpose_all(p.conv_w_in, DM, 3 * DM, (bf16*)(p.ws + WS_CINT), scr, gw, ngw, lane);
    transpose_all(p.conv_w_out, DM, DM, (bf16*)(p.ws + WS_COUTT), scr, gw, ngw, lane);
}

DI void store_row_bf16(bf16* orow, int lane, const f32x4 (&v)[4]) {
    unsigned long long* o8 = (unsigned long long*)orow + lane;
#pragma unroll
    for (int j = 0; j < 4; ++j) o8[64 * j] = (unsigned long long)pk2(v[j].x, v[j].y) | ((unsigned long long)pk2(v[j].z, v[j].w) << 32);
}
DI float wave_sum2(float v) { v = rowsum16(v); v += __shfl_xor(v, 16); v += __shfl_xor(v, 32); return v; }
DI void phase_norm0(const Params& p, int wave, int lane, int vcu, int G) {
    constexpr int NR = 4;
    const int gw = vcu * NWAVES + wave, ngw = G * NWAVES;
    const float* mod = (const float*)(p.ws + WS_MOD);
    bf16* A0 = (bf16*)(p.ws + WS_A0);
    for (int row0 = gw; row0 < MT; row0 += NR * ngw) {
        f32x4 xv[NR][4]; float ss[NR]; int rows[NR];
#pragma unroll
        for (int q = 0; q < NR; ++q) { int row = row0 + q * ngw; if (row >= MT) row = row0; rows[q] = row; ss[q] = 0.f;
            const float* xr = row < ML ? p.x + (size_t)row * DM : p.ctx + (size_t)(row - ML) * DM;
#pragma unroll
            for (int j = 0; j < 4; ++j) xv[q][j] = __builtin_nontemporal_load((const f32x4*)xr + lane + 64 * j); }
#pragma unroll
        for (int q = 0; q < NR; ++q) {
#pragma unroll
            for (int j = 0; j < 4; ++j) ss[q] += (xv[q][j].x * xv[q][j].x + xv[q][j].y * xv[q][j].y) + (xv[q][j].z * xv[q][j].z + xv[q][j].w * xv[q][j].w); }
#pragma unroll
        for (int q = 0; q < NR; ++q) {
            if (row0 + q * ngw >= MT) break;
            const int row = rows[q], v = row < ML ? row / SEQ : 4;
            const float* sh = mod + v * 6144, *sc = sh + 1024;
            const float rs = rsqrtf(wave_sum2(ss[q]) * (1.0f / DM) + 1e-6f);
#pragma unroll
            for (int j = 0; j < 4; ++j) { const f32x4 g = *((const f32x4*)p.norm_g + lane + 64 * j), s1 = *((const f32x4*)sc + lane + 64 * j), s0 = *((const f32x4*)sh + lane + 64 * j);
                xv[q][j] = (xv[q][j] * rs) * g * (s1 + 1.0f) + s0; }
            store_row_bf16(A0 + (size_t)row * DM, lane, xv[q]);
        }
    }
}
template <bool XIN_BF, bool XOUT_BF>
DI void phase_norm1(const bf16* Y, const void* xin_, void* xout_, const float* gA, const float* modl, int gt_off, const float* gB, int sh_off, int sc_off, bf16* aout,
                    int wave, int lane, int vcu, int G) {
    constexpr int NR = 4;
    const int gw = vcu * NWAVES + wave, ngw = G * NWAVES;
    for (int row0 = gw; row0 < ML; row0 += NR * ngw) {
        f32x4 yv[NR][4], xv[NR][4]; int rows[NR]; float ss[NR];
#pragma unroll
        for (int q = 0; q < NR; ++q) ss[q] = 0.f;
#pragma unroll
        for (int q = 0; q < NR; ++q) { int row = row0 + q * ngw; if (row >= ML) row = row0; rows[q] = row;
#pragma unroll
            for (int j = 0; j < 4; ++j) { const u32x2 w = __builtin_nontemporal_load((const u32x2*)(Y + (size_t)row * DM) + lane + 64 * j); yv[q][j] = (f32x4){bf_lo(w.x), bf_hi(w.x), bf_lo(w.y), bf_hi(w.y)};
                if (XIN_BF) { const u32x2 xw = __builtin_nontemporal_load((const u32x2*)((const bf16*)xin_ + (size_t)row * DM) + lane + 64 * j); xv[q][j] = (f32x4){bf_lo(xw.x), bf_hi(xw.x), bf_lo(xw.y), bf_hi(xw.y)}; }
                else xv[q][j] = __builtin_nontemporal_load((const f32x4*)((const float*)xin_ + (size_t)row * DM) + lane + 64 * j); } }
#pragma unroll
        for (int q = 0; q < NR; ++q)
#pragma unroll
            for (int j = 0; j < 4; ++j) ss[q] += (yv[q][j].x * yv[q][j].x + yv[q][j].y * yv[q][j].y) + (yv[q][j].z * yv[q][j].z + yv[q][j].w * yv[q][j].w);
        float rs[NR], s2[NR];
#pragma unroll
        for (int q = 0; q < NR; ++q) s2[q] = 0.f;
#pragma unroll
        for (int q = 0; q < NR; ++q) rs[q] = rsqrtf(wave_sum2(ss[q]) * (1.0f / DM) + 1e-6f);
#pragma unroll
        for (int q = 0; q < NR; ++q) { const float* mv = modl + (rows[q] / SEQ) * 6144;
            if (row0 + q * ngw >= ML) break;
#pragma unroll
            for (int j = 0; j < 4; ++j) { const f32x4 g = *((const f32x4*)gA + lane + 64 * j), gt = *((const f32x4*)(mv + gt_off) + lane + 64 * j);
                xv[q][j] = xv[q][j] + gt * ((yv[q][j] * rs[q]) * g);
                if (XOUT_BF) { u32x2 w; w.x = pk2(xv[q][j].x, xv[q][j].y); w.y = pk2(xv[q][j].z, xv[q][j].w); __builtin_nontemporal_store(w, (u32x2*)((bf16*)xout_ + (size_t)rows[q] * DM) + lane + 64 * j); }
                else __builtin_nontemporal_store(xv[q][j], (f32x4*)((float*)xout_ + (size_t)rows[q] * DM) + lane + 64 * j);
                s2[q] += (xv[q][j].x * xv[q][j].x + xv[q][j].y * xv[q][j].y) + (xv[q][j].z * xv[q][j].z + xv[q][j].w * xv[q][j].w); } }
        if (aout) {
            float r2[NR];
#pragma unroll
            for (int q = 0; q < NR; ++q) r2[q] = rsqrtf(wave_sum2(s2[q]) * (1.0f / DM) + 1e-6f);
#pragma unroll
            for (int q = 0; q < NR; ++q) { const float* mv = modl + (rows[q] / SEQ) * 6144;
                if (row0 + q * ngw >= ML) break;
#pragma unroll
                for (int j = 0; j < 4; ++j) { const f32x4 g = *((const f32x4*)gB + lane + 64 * j), s1 = *((const f32x4*)(mv + sc_off) + lane + 64 * j), s0 = *((const f32x4*)(mv + sh_off) + lane + 64 * j);
                    yv[q][j] = (xv[q][j] * r2[q]) * g * (s1 + 1.0f) + s0; }
                store_row_bf16(aout + (size_t)rows[q] * DM, lane, yv[q]); }
        }
    }
}

constexpr int FP = 1936;
DI f32x4 mix4(const LAS bf16* T, int t, int col, const f32x4 mu) {
    const u32x2 pv = *(const LAS u32x2*)(T + t * FP + col), cv = *(const LAS u32x2*)(T + (t + 1) * FP + col), nv = *(const LAS u32x2*)(T + (t + 2) * FP + col);
    const f32x4 p4 = {bf_lo(pv.x), bf_hi(pv.x), bf_lo(pv.y), bf_hi(pv.y)}, c4 = {bf_lo(cv.x), bf_hi(cv.x), bf_lo(cv.y), bf_hi(cv.y)}, n4 = {bf_lo(nv.x), bf_hi(nv.x), bf_lo(nv.y), bf_hi(nv.y)};
    return c4 + mu * ((p4 + n4) * 0.5f - c4);
}
DI void st4bf(bf16* dst, const f32x4 v) { u32x2 w; w.x = pk2(v.x, v.y); w.y = pk2(v.z, v.w); *(u32x2*)dst = w; }
DI void st4bf_nt(bf16* dst, const f32x4 v) { u32x2 w; w.x = pk2(v.x, v.y); w.y = pk2(v.z, v.w); __builtin_nontemporal_store(w, (u32x2*)dst); }
DI void unpack8(const u32x4 w, float (&o)[8]) { o[0] = bf_lo(w.x); o[1] = bf_hi(w.x); o[2] = bf_lo(w.y); o[3] = bf_hi(w.y); o[4] = bf_lo(w.z); o[5] = bf_hi(w.z); o[6] = bf_lo(w.w); o[7] = bf_hi(w.w); }
DI bf16x8 pack8(const float (&v)[8]) { u32x4 w; w.x = pk2(v[0], v[1]); w.y = pk2(v[2], v[3]); w.z = pk2(v[4], v[5]); w.w = pk2(v[6], v[7]); return __builtin_bit_cast(bf16x8, w); }

DI void phase_features(const Params& p, LAS unsigned char* lds, int tid, int wave, int lane, int vcu, int G) {
    const bf16* P = (const bf16*)(p.ws + WS_P);
    LAS bf16* T = (LAS bf16*)lds;
    bf16* SH = (bf16*)(p.ws + WS_SH); bf16* SD0 = (bf16*)(p.ws + WS_SD0); bf16* SD1 = (bf16*)(p.ws + WS_SD1);
    float* BC = (float*)(p.ws + WS_BC); bf16* KP = (bf16*)(p.ws + WS_KP); bf16* VT = (bf16*)(p.ws + WS_VT);
    const bf16* W2T = (const bf16*)(p.ws + WS_W2T); const bf16* A2T = (const bf16*)(p.ws + WS_A2T);
    const int h = wave, tq = lane >> 4, cl = lane & 15, c0 = h * 64 + 4 * cl;
    LAS float* PAR = (LAS float*)(lds + 18 * FP * 2);
    for (int i = tid; i < 10 * 512; i += NTHR) { const int v = i >> 9, c = i & 511;
        const float* src = v < 3 ? p.rwkv_mu + v * 512 : v == 3 ? p.rwkv_kk : v == 4 ? p.rwkv_ka : v == 5 ? p.rwkv_rk : v < 8 ? p.rwkv_w0 + (v - 6) * 512 : p.rwkv_a0 + (v - 8) * 512;
        PAR[i] = src[c]; }
    bf16x8 bwr[8];
#pragma unroll
    for (int q = 0; q < 8; ++q) { const int ks = (q >> 2) & 1, nt = q & 3; bwr[q] = *(const bf16x8*)(W2T + (size_t)(c0 + nt) * 64 + ks * 32 + tq * 8); }
    for (int u = vcu; u < MT / 16; u += G) {
        const int R0 = u * 16;
        int seq0, seqlen; if (R0 < ML) { seq0 = (R0 / SEQ) * SEQ; seqlen = SEQ; } else { seq0 = ML + ((R0 - ML) / CTXL) * CTXL; seqlen = CTXL; }
        bf16x8 bw[8];
#pragma unroll
        for (int q = 0; q < 8; ++q) bw[q] = *(const bf16x8*)(W2T + (size_t)512 * 64 + (size_t)(c0 + (q & 3)) * 64 + (q >> 2) * 32 + tq * 8);
        __syncthreads();
        for (int i = tid; i < 18 * 240; i += NTHR) { const int rr = i / 240, ch = i % 240, row = R0 - 1 + rr;
            u32x4 v = {0u, 0u, 0u, 0u}; if (row >= seq0 && row < seq0 + seqlen) v = *(const u32x4*)(P + (size_t)row * PP + RWC + ch * 8);
            *(LAS u32x4*)(T + rr * FP + ch * 8) = v; }
        __syncthreads();
        f32x4 lo[4][4];
#pragma unroll
        for (int L = 0; L < 4; ++L) {
            if (L >= 2) {
#pragma unroll
                for (int q = 0; q < 8; ++q) bw[q] = *(const bf16x8*)(A2T + (size_t)(L & 1) * 512 * 64 + (size_t)(c0 + (q & 3)) * 64 + (q >> 2) * 32 + tq * 8);
            }
#pragma unroll
            for (int nt = 0; nt < 4; ++nt) lo[L][nt] = (f32x4){0.f, 0.f, 0.f, 0.f};
#pragma unroll
            for (int ks = 0; ks < 2; ++ks) {
                const int cb = 1536 + 64 * L + ks * 32 + tq * 8, tok = lane & 15;
                float pv[8], cv[8], nv[8], a8[8];
                unpack8(*(const LAS u32x4*)(T + tok * FP + cb), pv); unpack8(*(const LAS u32x4*)(T + (tok + 1) * FP + cb), cv); unpack8(*(const LAS u32x4*)(T + (tok + 2) * FP + cb), nv);
                const f32x4 m0 = *(const f32x4*)(p.rwkv_mu + cb), m1 = *(const f32x4*)(p.rwkv_mu + cb + 4);
#pragma unroll
                for (int e = 0; e < 8; ++e) { const float mu = e < 4 ? m0[e] : m1[e - 4]; float m = cv[e] + mu * (0.5f * (pv[e] + nv[e]) - cv[e]); if (L < 2) m = tanhf_(m); a8[e] = m; }
                const bf16x8 a = pack8(a8);
#pragma unroll
                for (int nt = 0; nt < 4; ++nt) lo[L][nt] = __builtin_amdgcn_mfma_f32_16x16x32_bf16(a, L == 0 ? bwr[ks * 4 + nt] : bw[ks * 4 + nt], lo[L][nt], 0, 0, 0);
            }
            asm volatile("" ::: "memory");
        }
#pragma unroll
        for (int j = 0; j < 4; ++j) {
            const int t = 4 * tq + j, row = R0 + t;
            const f32x4 mu_r = *(const LAS f32x4*)(PAR + c0), mu_k = *(const LAS f32x4*)(PAR + 512 + c0), mu_v = *(const LAS f32x4*)(PAR + 1024 + c0);
            const f32x4 kkw = *(const LAS f32x4*)(PAR + 1536 + c0), kaw = *(const LAS f32x4*)(PAR + 2048 + c0), rkw = *(const LAS f32x4*)(PAR + 2560 + c0);
            const f32x4 w0f = *(const LAS f32x4*)(PAR + 3072 + c0), w0b = *(const LAS f32x4*)(PAR + 3584 + c0), a0f = *(const LAS f32x4*)(PAR + 4096 + c0), a0b = *(const LAS f32x4*)(PAR + 4608 + c0);
            const f32x4 r4 = mix4(T, t, c0, mu_r), k4 = mix4(T, t, 512 + c0, mu_k), v4 = mix4(T, t, 1024 + c0, mu_v);
            const f32x4 kkv = k4 * kkw;
            const float ss = rowsum16((kkv.x * kkv.x + kkv.y * kkv.y) + (kkv.z * kkv.z + kkv.w * kkv.w));
            const f32x4 kk4 = kkv * __builtin_amdgcn_rcpf(fmaxf(__builtin_amdgcn_sqrtf(ss), 1e-12f));
            f32x4 df, db, kf, kb, bf, bb_;
#pragma unroll
            for (int i = 0; i < 4; ++i) {
                const float zf = w0f[i] + lo[0][i][j], zb = w0b[i] + lo[1][i][j];
                df[i] = __expf(-0.6065306597f * sigmoidf_(zf)); db[i] = __expf(-0.6065306597f * sigmoidf_(zb));
                const float af = sigmoidf_(a0f[i] + lo[2][i][j]), ab = sigmoidf_(a0b[i] + lo[3][i][j]);
                kf[i] = k4[i] * (1.0f + (af - 1.0f) * kaw[i]); kb[i] = k4[i] * (1.0f + (ab - 1.0f) * kaw[i]);
                bf[i] = kk4[i] * af; bb_[i] = kk4[i] * ab;
            }
            const f32x4 bt = r4 * (kf + kb) * rkw;
            const float bonus = rowsum16((bt.x + bt.y) + (bt.z + bt.w));
            if (cl == 0) BC[row * 8 + h] = bonus;
            const size_t rec = ((size_t)row * 8 + h) * 192 + 4 * cl;
            st4bf_nt(SH + rec, r4); st4bf_nt(SH + rec + 64, v4); st4bf_nt(SH + rec + 128, -kk4);
            st4bf_nt(SD0 + rec, df); st4bf_nt(SD0 + rec + 64, kf); st4bf_nt(SD0 + rec + 128, bf);
            st4bf_nt(SD1 + rec, db); st4bf_nt(SD1 + rec + 64, kb); st4bf_nt(SD1 + rec + 128, bb_);
            asm volatile("" ::: "memory");
        }
        if (tid < 256) {
            const int t = tid >> 4, g = tid & 15, row = R0 + t, kvh = g >> 3, d0 = (g & 7) * 8;
            const bf16* src = P + (size_t)row * PP + 512 + kvh * 64;
            const bool lat = row < ML; int b_, pos, tt = 0;
            if (lat) { b_ = row / SEQ; tt = row % SEQ; pos = CTXL + tt; } else { b_ = (row - ML) / CTXL; pos = (row - ML) % CTXL; }
            u32x4 ov = *(const u32x4*)(src + d0);
            if (lat) {
                const int dd = d0 & 31; const bool first = dd < 16;
                float o8[8], q8[8], r8[8]; unpack8(ov, o8); unpack8(*(const u32x4*)(src + (first ? d0 + 16 : d0 - 16)), q8);
                const float posf = (d0 < 32) ? (float)(tt >> 6) : (float)(tt & 63);
#pragma unroll
                for (int e = 0; e < 8; ++e) { const float inv = exp2f(-(float)((dd & 15) + e) * 0.8304820237f), ang = posf * inv, sn = __sinf(ang), cs = __cosf(ang);
                    r8[e] = first ? o8[e] * cs - q8[e] * sn : o8[e] * cs + q8[e] * sn; }
                ov = __builtin_bit_cast(u32x4, pack8(r8));
            }
            *(u32x4*)(KP + ((size_t)(b_ * 2 + kvh) * NPOS + pos) * 64 + d0) = ov;
        }
        { const int t = tid & 15, dq = tid >> 4, row = R0 + t, kvh = dq >> 4, d = (dq & 15) * 4;
          int b_, pos; if (row < ML) { b_ = row / SEQ; pos = CTXL + row % SEQ; } else { b_ = (row - ML) / CTXL; pos = (row - ML) % CTXL; }
          const u32x2 w = *(const u32x2*)(P + (size_t)row * PP + 640 + 4 * dq);
          bf16* dst = VT + (((size_t)(b_ * 2 + kvh) * (NPOS / 32) + (pos >> 5)) * 64 + d) * 32 + (pos & 31);
          dst[0] = (bf16)(w.x & 0xffffu); dst[32] = (bf16)(w.x >> 16); dst[64] = (bf16)(w.y & 0xffffu); dst[96] = (bf16)(w.y >> 16); }
    }
}

DI int crow(int r, int hi) { return (r & 3) + 8 * (r >> 2) + 4 * hi; }
constexpr int ATT_TASKS = 8192;
struct AttRegs { f32x16 O[2]; float m_, l_; bf16x8 qf[4], kf[4], vf[2][2]; int b, kvh, head, ql0, kb0, it_lo, it_hi; bool local; };
DI void att_setup(const Params& p, int task, int lane, AttRegs& A) {
    const bf16* Pm = (const bf16*)(p.ws + WS_P);
    const int qblk = task & 1, qsub = (task >> 1) & 1, g = (task >> 2) & 3, qb = (task >> 4) & 63; A.kvh = (task >> 10) & 1; A.b = task >> 11;
    A.head = A.kvh * 4 + g; A.ql0 = qb * 128 + qsub * 64 + qblk * 32; A.kb0 = 0; A.local = false;
    A.it_lo = A.ql0 < 128 ? (128 - A.ql0) >> 5 : 0; A.it_hi = A.ql0 + 160 > SEQ ? (SEQ - A.ql0 + 128) >> 5 : 9;
    const int r = lane & 31, hh = lane >> 5;
    const int t = A.ql0 + r; const bf16* src = Pm + (size_t)(A.b * SEQ + t) * PP + A.head * 64 + 8 * hh;
    float qv[4][8];
#pragma unroll
    for (int c = 0; c < 4; ++c) unpack8(*(const u32x4*)(src + 16 * c), qv[c]);
    const float prow = (float)(t >> 6), pcol = (float)(t & 63);
    float n0[8], n1[8], n2[8], n3[8];
#pragma unroll
    for (int e = 0; e < 8; ++e) { const float inv = exp2f(-(float)(8 * hh + e) * 0.8304820237f);
        const float a1 = prow * inv, s1 = __sinf(a1), c1 = __cosf(a1), a2 = pcol * inv, s2 = __sinf(a2), c2 = __cosf(a2); const float sc = 0.125f * LOG2E;
        n0[e] = (qv[0][e] * c1 - qv[1][e] * s1) * sc; n1[e] = (qv[1][e] * c1 + qv[0][e] * s1) * sc; n2[e] = (qv[2][e] * c2 - qv[3][e] * s2) * sc; n3[e] = (qv[3][e] * c2 + qv[2][e] * s2) * sc; }
    A.qf[0] = pack8(n0); A.qf[1] = pack8(n1); A.qf[2] = pack8(n2); A.qf[3] = pack8(n3);
    A.m_ = p.att_sink[A.head] * LOG2E; A.l_ = hh == 0 ? 1.0f : 0.0f;
#pragma unroll
    for (int dblk = 0; dblk < 2; ++dblk)
#pragma unroll
        for (int i = 0; i < 16; ++i) A.O[dblk][i] = 0.f;
}
DI void att_issue(const Params& p, int it, int lane, AttRegs& A) {
    const bf16* KP = (const bf16*)(p.ws + WS_KP); const bf16* VT = (const bf16*)(p.ws + WS_VT);
    const int r = lane & 31, hh = lane >> 5;
    int pos0; A.local = it < 9;
    if (A.local) { A.kb0 = A.ql0 - 128 + it * 32; pos0 = CTXL + A.kb0; } else pos0 = (it - 9) * 32;
    const bf16* Kb = KP + (size_t)(A.b * 2 + A.kvh) * NPOS * 64; const bf16* Vb = VT + (size_t)(A.b * 2 + A.kvh) * (NPOS / 32) * 2048;
#pragma unroll
    for (int c = 0; c < 4; ++c) A.kf[c] = *(const bf16x8*)(Kb + (size_t)(pos0 + r) * 64 + 16 * c + 8 * hh);
#pragma unroll
    for (int dblk = 0; dblk < 2; ++dblk)
#pragma unroll
        for (int s = 0; s < 2; ++s) { const u32x2* vp = (const u32x2*)(Vb + (size_t)(pos0 >> 5) * 2048 + (dblk * 32 + r) * 32 + 16 * s + 4 * hh); const u32x2 lo = vp[0], hi = vp[2];
            A.vf[dblk][s] = __builtin_bit_cast(bf16x8, (u32x4){lo.x, lo.y, hi.x, hi.y}); }
}
DI void att_compute(int lane, AttRegs& A) {
    const int r = lane & 31, hh = lane >> 5;
    const bool need_mask = A.local && !(A.kb0 >= A.ql0 - 97 && A.kb0 <= A.ql0 + 97);
    f32x16 S;
#pragma unroll
    for (int i = 0; i < 16; ++i) S[i] = 0.f;
#pragma unroll
    for (int c = 0; c < 4; ++c) S = __builtin_amdgcn_mfma_f32_32x32x16_bf16(A.kf[c], A.qf[c], S, 0, 0, 0);
    if (need_mask) { const int ql = A.ql0 + r;
#pragma unroll
        for (int i = 0; i < 16; ++i) { const int kl = A.kb0 + crow(i, hh); const int dlt = ql - kl; const bool ok = dlt <= 128 && dlt >= -128; S[i] = ok ? S[i] : -INFINITY; } }
    float tmax = S[0];
#pragma unroll
    for (int i = 1; i < 16; ++i) tmax = fmaxf(tmax, S[i]);
    tmax = fmaxf(tmax, __shfl_xor(tmax, 32));
    const float mnew = fmaxf(A.m_, tmax), alpha = __builtin_amdgcn_exp2f(A.m_ - mnew);
    A.m_ = mnew;
    float pe[16]; float ps = 0.f;
#pragma unroll
    for (int i = 0; i < 16; ++i) { pe[i] = __builtin_amdgcn_exp2f(S[i] - mnew); ps += pe[i]; }
    A.l_ = A.l_ * alpha + ps;
    if (__any(alpha != 1.0f)) {
#pragma unroll
        for (int dblk = 0; dblk < 2; ++dblk)
#pragma unroll
            for (int i = 0; i < 16; ++i) A.O[dblk][i] *= alpha; }
    bf16x8 pf[2];
#pragma unroll
    for (int s = 0; s < 2; ++s) { u32x4 w; w.x = pk2(pe[8 * s], pe[8 * s + 1]); w.y = pk2(pe[8 * s + 2], pe[8 * s + 3]); w.z = pk2(pe[8 * s + 4], pe[8 * s + 5]); w.w = pk2(pe[8 * s + 6], pe[8 * s + 7]);
        pf[s] = __builtin_bit_cast(bf16x8, w); }
#pragma unroll
    for (int dblk = 0; dblk < 2; ++dblk)
#pragma unroll
        for (int s = 0; s < 2; ++s) A.O[dblk] = __builtin_amdgcn_mfma_f32_32x32x16_bf16(A.vf[dblk][s], pf[s], A.O[dblk], 0, 0, 0);
}
DI void att_finish(const Params& p, int lane, AttRegs& A) {
    bf16* Pm = (bf16*)(p.ws + WS_P);
    const int r = lane & 31, hh = lane >> 5;
    const float lt = A.l_ + __shfl_xor(A.l_, 32), inv = __builtin_amdgcn_rcpf(lt);
    bf16* dst = Pm + (size_t)(A.b * SEQ + A.ql0 + r) * PP + A.head * 64;
#pragma unroll
    for (int dblk = 0; dblk < 2; ++dblk)
#pragma unroll
        for (int gi = 0; gi < 4; ++gi) { const f32x4 v = {A.O[dblk][4 * gi] * inv, A.O[dblk][4 * gi + 1] * inv, A.O[dblk][4 * gi + 2] * inv, A.O[dblk][4 * gi + 3] * inv};
            st4bf(dst + dblk * 32 + 8 * gi + 4 * hh, v); }
}
#define ATT_STEP(p, lane, A, a_task, a_stride, a_it, a_stage) do { if (a_task < ATT_TASKS) { \
        if (a_stage == 0) { att_setup(p, a_task, lane, A); a_it = A.it_lo; att_issue(p, a_it, lane, A); a_stage = 1; } \
        else { att_compute(lane, A); ++a_it; if (a_it == A.it_hi) a_it = 9; \
            if (a_it < 17) att_issue(p, a_it, lane, A); else { att_finish(p, lane, A); a_task += a_stride; a_stage = 0; } } } } while (0)
DI void phase_attention2(const Params& p, int wave, int lane, int vcu, int G) {
    AttRegs A; int a_task = vcu * NWAVES + wave, a_it = 0, a_stage = 0; const int a_stride = G * NWAVES;
    while (a_task < ATT_TASKS) ATT_STEP(p, lane, A, a_task, a_stride, a_it, a_stage);
}

DI int scan_row(int step, int b, int d) { if (step < CTXL) return ML + b * CTXL + (d ? CTXL - 1 - step : step); const int t = step - CTXL; return b * SEQ + (d ? SEQ - 1 - t : t); }
DI int prev_row(int row, int d, bool& none) {
    none = false;
    if (row < ML) { const int b = row / SEQ, t = row % SEQ; if (d == 0) return t > 0 ? row - 1 : ML + b * CTXL + CTXL - 1; return t < SEQ - 1 ? row + 1 : ML + b * CTXL; }
    const int j = (row - ML) % CTXL; if (d == 0) { none = j == 0; return none ? row : row - 1; } none = j == CTXL - 1; return none ? row : row + 1;
}
DI f32x4 ld4bf(const bf16* src) { const u32x2 w = *(const u32x2*)src; return (f32x4){bf_lo(w.x), bf_hi(w.x), bf_lo(w.y), bf_hi(w.y)}; }
DI float dot4(const f32x4 a, const f32x4 b) { return (a.x * b.x + a.y * b.y) + (a.z * b.z + a.w * b.w); }
DI void phase_pairs(const Params& p, int wave, int lane, int vcu, int G) {
    const bf16* SH = (const bf16*)(p.ws + WS_SH); const bf16* SD0 = (const bf16*)(p.ws + WS_SD0); const bf16* SD1 = (const bf16*)(p.ws + WS_SD1); float* CC = (float*)(p.ws + WS_CC);
    const int gw = vcu * NWAVES + wave, ngw = G * NWAVES, sub = lane >> 4, ks = (lane & 15) * 4;
    constexpr int NIT = 4;
    for (int base = gw * 4 * NIT; base < MT * 8; base += ngw * 4 * NIT) {
        f32x4 a4[NIT], kf[NIT], bf_[NIT], kb[NIT], bb[NIT]; bool nf[NIT], nb[NIT]; int it[NIT];
#pragma unroll
        for (int q = 0; q < NIT; ++q) {
            int item = base + q * 4 + sub; if (item >= MT * 8) item = MT * 8 - 1;
            it[q] = item; const int row = item >> 3, h = item & 7;
            const int pf = prev_row(row, 0, nf[q]), pb = prev_row(row, 1, nb[q]);
            a4[q] = ld4bf(SH + ((size_t)row * 8 + h) * 192 + 128 + ks);
            kf[q] = ld4bf(SD0 + ((size_t)pf * 8 + h) * 192 + 64 + ks); bf_[q] = ld4bf(SD0 + ((size_t)pf * 8 + h) * 192 + 128 + ks);
            kb[q] = ld4bf(SD1 + ((size_t)pb * 8 + h) * 192 + 64 + ks); bb[q] = ld4bf(SD1 + ((size_t)pb * 8 + h) * 192 + 128 + ks);
        }
#pragma unroll
        for (int q = 0; q < NIT; ++q) {
            float c1f = rowsum16(dot4(bf_[q], a4[q])), c2f = rowsum16(dot4(kf[q], a4[q])), c1b = rowsum16(dot4(bb[q], a4[q])), c2b = rowsum16(dot4(kb[q], a4[q]));
            if (nf[q]) { c1f = 0.f; c2f = 0.f; } if (nb[q]) { c1b = 0.f; c2b = 0.f; }
            if ((lane & 15) == 0 && base + q * 4 + sub < MT * 8) { *(f32x2*)(CC + (size_t)it[q] * 2) = (f32x2){c1f, c2f}; *(f32x2*)(CC + ((size_t)MT * 8 + it[q]) * 2) = (f32x2){c1b, c2b}; }
        }
    }
}
DI float fma_(float a, float b, float c) { float d; asm("v_fma_f32 %0, %1, %2, %3" : "=v"(d) : "v"(a), "v"(b), "v"(c)); return d; }
DI float mul_(float a, float b) { float d; asm("v_mul_f32 %0, %1, %2" : "=v"(d) : "v"(a), "v"(b)); return d; }
template <int MODE> DI void phase_scan(const Params& p, LAS unsigned char* lds, int tid, int wave, int lane, int vcu) {
    constexpr int TC = 32, STEPF = 384, BUFF = TC * STEPF, NCH = NPOS / TC;
    const int s = vcu >> 2, qr = vcu & 3, b = s >> 4, h = (s >> 1) & 7, d = s & 1;
    const bf16* SH = (const bf16*)(p.ws + WS_SH); const bf16* SD = (const bf16*)(p.ws + (d ? WS_SD1 : WS_SD0));
    bf16* Pm = (bf16*)(p.ws + WS_P);
    LAS float* buf = (LAS float*)lds;
    if (wave >= 4) {
        const int lt = tid - 256;
        u32x4 rgA[6], rgB[6];
#define SCAN_LOAD(rg, c) do { _Pragma("unroll") for (int i = 0; i < 6; ++i) { const int idx = i * 256 + lt, st = idx / 48, part = idx % 48; const int row = scan_row((c) * TC + st, b, d); \
            const bf16* src = (part < 24 ? SH : SD) + ((size_t)row * 8 + h) * 192 + (part % 24) * 8; rg[i] = *(const u32x4*)src; } } while (0)
#define SCAN_WRITE(rg, bi) do { _Pragma("unroll") for (int i = 0; i < 6; ++i) { const int idx = i * 256 + lt, st = idx / 48, part = idx % 48; LAS float* dst = buf + (bi) * BUFF + st * STEPF + part * 8; \
            *(LAS f32x4*)dst = (f32x4){bf_lo(rg[i].x), bf_hi(rg[i].x), bf_lo(rg[i].y), bf_hi(rg[i].y)}; *(LAS f32x4*)(dst + 4) = (f32x4){bf_lo(rg[i].z), bf_hi(rg[i].z), bf_lo(rg[i].w), bf_hi(rg[i].w)}; } } while (0)
        SCAN_LOAD(rgA, 0); SCAN_WRITE(rgA, 0); SCAN_LOAD(rgA, 1); SCAN_LOAD(rgB, 2);
        AttRegs A; int a_task = MODE == 0 ? vcu * 4 + (wave - 4) : ATT_TASKS, a_it = 0, a_stage = 0; const int a_stride = 1024;
        __syncthreads();
        for (int c = 0; c < NCH; c += 2) {
            if (MODE != 1 && c + 1 < NCH) { SCAN_WRITE(rgA, 1); if (c + 3 < NCH) SCAN_LOAD(rgA, c + 3); }
            ATT_STEP(p, lane, A, a_task, a_stride, a_it, a_stage);
            __syncthreads();
            if (MODE != 1 && c + 2 < NCH) { SCAN_WRITE(rgB, 0); if (c + 4 < NCH) SCAN_LOAD(rgB, c + 4); }
            ATT_STEP(p, lane, A, a_task, a_stride, a_it, a_stage);
            __syncthreads();
        }
        while (a_task < ATT_TASKS) ATT_STEP(p, lane, A, a_task, a_stride, a_it, a_stage);
#undef SCAN_LOAD
#undef SCAN_WRITE
    } else {
        const int rl = wave * 4 + (lane >> 4), vidx = qr * 16 + rl, ks = (lane & 15) * 4, l15 = lane & 15;
        f32x2 S01 = {0.f, 0.f}, S23 = {0.f, 0.f};
        __builtin_amdgcn_s_setprio(2);
        bf16* ydst = MODE ? Pm + 2688 + d * 64 + vidx : Pm + 1024 + d * 512 + h * 64 + vidx;
        __syncthreads();
        for (int c = 0; c < NCH; ++c) {
            if (MODE == 2) { __syncthreads(); continue; }
            const LAS float* cb = buf + (c & 1) * BUFF + ks;
            const LAS float* cv = buf + (c & 1) * BUFF + 64 + vidx;
            const bool emit = c >= CTXL / TC;
            f32x4 R_[2], A_[2], W_[2], K_[2], B_[2]; float V_[2];
#define SCAN_LD(sl, st) do { const LAS float* bs = cb + (st) * STEPF; R_[sl] = *(const LAS f32x4*)(bs); A_[sl] = *(const LAS f32x4*)(bs + 128); W_[sl] = *(const LAS f32x4*)(bs + 192); \
            K_[sl] = *(const LAS f32x4*)(bs + 256); B_[sl] = *(const LAS f32x4*)(bs + 320); V_[sl] = cv[(st) * STEPF]; } while (0)
            SCAN_LD(0, 0); SCAN_LD(1, 1);
            float ykeep = 0.f;
#pragma unroll
            for (int st = 0; st < TC; ++st) {
                const int sl = st & 1;
                const f32x4 r4 = R_[sl], a4 = A_[sl], w4 = W_[sl], k4 = K_[sl], b4 = B_[sl]; const float vv = V_[sl];
                if (st + 2 < TC) SCAN_LD(sl, st + 2);
                f32x2 t = S01 * (f32x2){a4.x, a4.y}; t = S23 * (f32x2){a4.z, a4.w} + t;
                const float sa = rowsum16(t.x + t.y);
                S01 = (S01 * (f32x2){w4.x, w4.y} + (f32x2){k4.x, k4.y} * vv) + (f32x2){b4.x, b4.y} * sa;
                S23 = (S23 * (f32x2){w4.z, w4.w} + (f32x2){k4.z, k4.w} * vv) + (f32x2){b4.z, b4.w} * sa;
                f32x2 yq = S01 * (f32x2){r4.x, r4.y}; yq = S23 * (f32x2){r4.z, r4.w} + yq;
                const float y = rowsum16(yq.x + yq.y);
                ykeep = (l15 == (st & 15)) ? y : ykeep;
                if ((st & 15) == 15 && emit) { const int row = scan_row(c * TC + (st - 15) + l15, b, d); ydst[(size_t)row * PP] = (bf16)(pk2(ykeep, 0.f) & 0xffffu); }
            }
#undef SCAN_LD
            __syncthreads();
        }
        __builtin_amdgcn_s_setprio(0);
    }
}

template <int DUMMY> DI void phase_attention(const Params& p, LAS unsigned char* lds, int tid, int wave, int lane, int vcu, int G) {
    bf16* Pm = (bf16*)(p.ws + WS_P); const bf16* KP = (const bf16*)(p.ws + WS_KP); const bf16* VT = (const bf16*)(p.ws + WS_VT);
    LAS unsigned char* Kl = lds;
    LAS unsigned char* Vl = lds + 55296;
    const int r = lane & 31, hh = lane >> 5, g = wave >> 1, qsub = wave & 1;
    for (int u = vcu; u < 512; u += G) {
        const int b = u >> 7, kvh = (u >> 6) & 1, qb = u & 63, head = kvh * 4 + g, qlo = qb * 128 + qsub * 64;
        bf16x8 qf[2][4];
#pragma unroll
        for (int qblk = 0; qblk < 2; ++qblk) {
            const int t = qlo + qblk * 32 + r; const bf16* src = Pm + (size_t)(b * SEQ + t) * PP + head * 64 + 8 * hh;
            float qv[4][8];
#pragma unroll
            for (int c = 0; c < 4; ++c) unpack8(*(const u32x4*)(src + 16 * c), qv[c]);
            const float prow = (float)(t >> 6), pcol = (float)(t & 63);
            float n0[8], n1[8], n2[8], n3[8];
#pragma unroll
            for (int e = 0; e < 8; ++e) { const float inv = exp2f(-(float)(8 * hh + e) * 0.8304820237f);
                const float a1 = prow * inv, s1 = __sinf(a1), c1 = __cosf(a1), a2 = pcol * inv, s2 = __sinf(a2), c2 = __cosf(a2); const float sc = 0.125f * LOG2E;
                n0[e] = (qv[0][e] * c1 - qv[1][e] * s1) * sc; n1[e] = (qv[1][e] * c1 + qv[0][e] * s1) * sc; n2[e] = (qv[2][e] * c2 - qv[3][e] * s2) * sc; n3[e] = (qv[3][e] * c2 + qv[2][e] * s2) * sc; }
            qf[qblk][0] = pack8(n0); qf[qblk][1] = pack8(n1); qf[qblk][2] = pack8(n2); qf[qblk][3] = pack8(n3);
        }
        f32x16 O[2][2]; float m_[2], l_[2];
#pragma unroll
        for (int q = 0; q < 2; ++q) { m_[q] = p.att_sink[head] * LOG2E; l_[q] = hh == 0 ? 1.0f : 0.0f;
#pragma unroll
            for (int dblk = 0; dblk < 2; ++dblk)
#pragma unroll
                for (int i = 0; i < 16; ++i) O[q][dblk][i] = 0.f; }
        for (int round = 0; round < 2; ++round) {
            const int nslots = round ? 256 : 384;
            __syncthreads();
            for (int i = tid; i < nslots * 8; i += NTHR) { const int slot = i >> 3, ch = i & 7; int pos; bool valid = true;
                if (round == 0) { const int kl = (qb - 1) * 128 + slot; valid = kl >= 0 && kl < SEQ; pos = CTXL + kl; } else pos = slot;
                u32x4 v = {0u, 0u, 0u, 0u}; if (valid) v = *(const u32x4*)(KP + ((size_t)(b * 2 + kvh) * NPOS + pos) * 64 + ch * 8);
                *(LAS u32x4*)(Kl + slot * 144 + ch * 16) = v; }
            const int nch = nslots >> 3;
            for (int i = tid; i < 64 * nch; i += NTHR) { const int dd = i / nch, ch = i % nch, slot0 = ch * 8; int pos0; bool valid = true;
                if (round == 0) { const int kl0 = (qb - 1) * 128 + slot0; valid = kl0 >= 0 && kl0 < SEQ; pos0 = CTXL + kl0; } else pos0 = slot0;
                u32x4 v = {0u, 0u, 0u, 0u}; if (valid) v = *(const u32x4*)(VT + ((size_t)(b * 2 + kvh) * 64 + dd) * NPOS + pos0);
                LAS u32x2* dst = (LAS u32x2*)(Vl + dd * 776 + slot0 * 2); dst[0] = (u32x2){v.x, v.y}; dst[1] = (u32x2){v.z, v.w}; }
            __syncthreads();
            const int tlo = round ? 0 : 2 * qsub, thi = round ? 8 : 2 * qsub + 10;
            for (int T = tlo; T < thi; ++T) {
                bf16x8 kf[4], vf[2][2];
#pragma unroll
                for (int c = 0; c < 4; ++c) kf[c] = *(const LAS bf16x8*)(Kl + (T * 32 + r) * 144 + (16 * c + 8 * hh) * 2);
#pragma unroll
                for (int dblk = 0; dblk < 2; ++dblk)
#pragma unroll
                    for (int s = 0; s < 2; ++s) { const LAS u32x2* vp = (const LAS u32x2*)(Vl + (dblk * 32 + r) * 776 + (T * 32 + 16 * s + 4 * hh) * 2); const u32x2 lo = vp[0], hi = vp[2];
                        vf[dblk][s] = __builtin_bit_cast(bf16x8, (u32x4){lo.x, lo.y, hi.x, hi.y}); }
#pragma unroll
                for (int q = 0; q < 2; ++q) {
                    f32x16 S;
#pragma unroll
                    for (int i = 0; i < 16; ++i) S[i] = 0.f;
#pragma unroll
                    for (int c = 0; c < 4; ++c) S = __builtin_amdgcn_mfma_f32_32x32x16_bf16(kf[c], qf[q][c], S, 0, 0, 0);
                    const int kb0w = (qb - 1) * 128 + T * 32;
                    const bool need_mask = round == 0 && !(kb0w >= 0 && kb0w + 31 < SEQ && kb0w >= qlo - 65 && kb0w <= qlo + 97);
                    if (need_mask) { const int ql = qlo + q * 32 + r, kb0 = kb0w;
#pragma unroll
                        for (int i = 0; i < 16; ++i) { const int kl = kb0 + crow(i, hh); const int dlt = ql - kl; const bool ok = kl >= 0 && kl < SEQ && dlt <= 128 && dlt >= -128; S[i] = ok ? S[i] : -INFINITY; } }
                    float tmax = S[0];
#pragma unroll
                    for (int i = 1; i < 16; ++i) tmax = fmaxf(tmax, S[i]);
                    tmax = fmaxf(tmax, __shfl_xor(tmax, 32));
                    const float mnew = fmaxf(m_[q], tmax), alpha = __builtin_amdgcn_exp2f(m_[q] - mnew);
                    m_[q] = mnew;
                    float pe[16]; float ps = 0.f;
#pragma unroll
                    for (int i = 0; i < 16; ++i) { pe[i] = __builtin_amdgcn_exp2f(S[i] - mnew); ps += pe[i]; }
                    l_[q] = l_[q] * alpha + ps;
                    if (__any(alpha != 1.0f)) {
#pragma unroll
                    for (int dblk = 0; dblk < 2; ++dblk)
#pragma unroll
                        for (int i = 0; i < 16; ++i) O[q][dblk][i] *= alpha; }
                    bf16x8 pf[2];
#pragma unroll
                    for (int s = 0; s < 2; ++s) { u32x4 w; w.x = pk2(pe[8 * s], pe[8 * s + 1]); w.y = pk2(pe[8 * s + 2], pe[8 * s + 3]); w.z = pk2(pe[8 * s + 4], pe[8 * s + 5]); w.w = pk2(pe[8 * s + 6], pe[8 * s + 7]);
                        pf[s] = __builtin_bit_cast(bf16x8, w); }
#pragma unroll
                    for (int dblk = 0; dblk < 2; ++dblk)
#pragma unroll
                        for (int s = 0; s < 2; ++s) O[q][dblk] = __builtin_amdgcn_mfma_f32_32x32x16_bf16(vf[dblk][s], pf[s], O[q][dblk], 0, 0, 0);
                }
            }
        }
#pragma unroll
        for (int q = 0; q < 2; ++q) {
            const float lt = l_[q] + __shfl_xor(l_[q], 32), inv = __builtin_amdgcn_rcpf(lt);
            bf16* dst = Pm + (size_t)(b * SEQ + qlo + q * 32 + r) * PP + head * 64 + (DUMMY ? 1024 : 0);
#pragma unroll
            for (int dblk = 0; dblk < 2; ++dblk)
#pragma unroll
                for (int gi = 0; gi < 4; ++gi) { const f32x4 v = {O[q][dblk][4 * gi] * inv, O[q][dblk][4 * gi + 1] * inv, O[q][dblk][4 * gi + 2] * inv, O[q][dblk][4 * gi + 3] * inv};
                    st4bf(dst + dblk * 32 + 8 * gi + 4 * hh, v); }
        }
    }
}

DI void phase_rwkv_out(const Params& p, LAS unsigned char* lds, int tid, int wave, int lane, int vcu, int G) {
    bf16* Pm = (bf16*)(p.ws + WS_P); const bf16* SH = (const bf16*)(p.ws + WS_SH); const float* BC = (const float*)(p.ws + WS_BC); const bf16* G2T = (const bf16*)(p.ws + WS_G2T);
    constexpr int GP = 136;
    LAS bf16* T = (LAS bf16*)lds;
    const int h = wave, tq = lane >> 4, cl = lane & 15, c0 = h * 64 + 4 * cl;
    const f32x4 lnw = *(const f32x4*)(p.rwkv_ln_w + c0), lnb = *(const f32x4*)(p.rwkv_ln_b + c0);
    bf16x8 gw_[16];
#pragma unroll
    for (int q = 0; q < 16; ++q) gw_[q] = *(const bf16x8*)(G2T + (size_t)(c0 + (q & 3)) * 128 + (q >> 2) * 32 + tq * 8);
    for (int u = vcu; u < ML / 16; u += G) {
        const int R0 = u * 16, seq0 = (R0 / SEQ) * SEQ;
        u32x2 yf_[4], yb_[4], vw_[4]; float bc_[4];
#pragma unroll
        for (int j = 0; j < 4; ++j) { const int row = R0 + 4 * tq + j;
            yf_[j] = *(const u32x2*)(Pm + (size_t)row * PP + 1024 + c0); yb_[j] = *(const u32x2*)(Pm + (size_t)row * PP + 1536 + c0);
            vw_[j] = *(const u32x2*)(SH + ((size_t)row * 8 + h) * 192 + 64 + 4 * cl); bc_[j] = BC[row * 8 + h]; }
        __syncthreads();
        for (int i = tid; i < 18 * 16; i += NTHR) { const int rr = i >> 4, ch = i & 15, row = R0 - 1 + rr;
            u32x4 v = {0u, 0u, 0u, 0u}; if (row >= seq0 && row < seq0 + SEQ) v = *(const u32x4*)(Pm + (size_t)row * PP + RWC + 1792 + ch * 8);
            *(LAS u32x4*)(T + rr * GP + ch * 8) = v; }
        __syncthreads();
        f32x4 gate[4];
#pragma unroll
        for (int nt = 0; nt < 4; ++nt) gate[nt] = (f32x4){0.f, 0.f, 0.f, 0.f};
#pragma unroll
        for (int ks = 0; ks < 4; ++ks) {
            const int cb = ks * 32 + tq * 8, tok = lane & 15;
            float pv[8], cv[8], nv[8], a8[8];
            unpack8(*(const LAS u32x4*)(T + tok * GP + cb), pv); unpack8(*(const LAS u32x4*)(T + (tok + 1) * GP + cb), cv); unpack8(*(const LAS u32x4*)(T + (tok + 2) * GP + cb), nv);
            const f32x4 m0 = *(const f32x4*)(p.rwkv_mu + 1792 + cb), m1 = *(const f32x4*)(p.rwkv_mu + 1792 + cb + 4);
#pragma unroll
            for (int e = 0; e < 8; ++e) { const float mu = e < 4 ? m0[e] : m1[e - 4]; a8[e] = sigmoidf_(cv[e] + mu * (0.5f * (pv[e] + nv[e]) - cv[e])); }
            const bf16x8 a = pack8(a8);
#pragma unroll
            for (int nt = 0; nt < 4; ++nt) gate[nt] = __builtin_amdgcn_mfma_f32_16x16x32_bf16(a, gw_[ks * 4 + nt], gate[nt], 0, 0, 0);
        }
#pragma unroll
        for (int j = 0; j < 4; ++j) {
            const int row = R0 + 4 * tq + j;
            const u32x2 yf = yf_[j], yb = yb_[j];
            const f32x4 y = (f32x4){bf_lo(yf.x), bf_hi(yf.x), bf_lo(yf.y), bf_hi(yf.y)} + (f32x4){bf_lo(yb.x), bf_hi(yb.x), bf_lo(yb.y), bf_hi(yb.y)};
            const float mean = rowsum16((y.x + y.y) + (y.z + y.w)) * (1.0f / 64.0f);
            const f32x4 dv = y - mean;
            const float var = rowsum16((dv.x * dv.x + dv.y * dv.y) + (dv.z * dv.z + dv.w * dv.w)) * (1.0f / 64.0f);
            const float rstd = rsqrtf(var + 64e-5f);
            const u32x2 vw = vw_[j];
            const f32x4 v4 = {bf_lo(vw.x), bf_hi(vw.x), bf_lo(vw.y), bf_hi(vw.y)};
            const float bc = bc_[j];
            const f32x4 gt = {gate[0][j], gate[1][j], gate[2][j], gate[3][j]};
            const f32x4 o = (dv * rstd * lnw + lnb + v4 * bc) * gt;
            st4bf(Pm + (size_t)row * PP + 512 + c0, o);
        }
    }
}

DI void ld8f(const bf16* src, float (&o)[8]) { unpack8(*(const u32x4*)src, o); }
DI void phase_conv(const Params& p, int wave, int lane, int vcu, int G) {
    const bf16* Gm = (const bf16*)(p.ws + WS_G); bf16* Z = (bf16*)(p.ws + WS_Z);
    const int gw = vcu * NWAVES + wave, ngw = G * NWAVES;
    for (int row = gw; row < ML; row += ngw) {
        const int t = row % SEQ;
#pragma unroll
        for (int j = 0; j < 2; ++j) {
            const int col = 8 * lane + 512 * j; const bf16* base = Gm + (size_t)row * 3072 + col;
            float gb[8], gc[8], uu[8], qp[8], qn[8], z[8];
            ld8f(base, gb); ld8f(base + 1024, gc); ld8f(base + 2048, uu);
            if (t > 0) { float a[8], c[8]; ld8f(base - 3072 + 1024, a); ld8f(base - 3072 + 2048, c);
#pragma unroll
                for (int e = 0; e < 8; ++e) qp[e] = a[e] * c[e]; } else {
#pragma unroll
                for (int e = 0; e < 8; ++e) qp[e] = 0.f; }
            if (t < SEQ - 1) { float a[8], c[8]; ld8f(base + 3072 + 1024, a); ld8f(base + 3072 + 2048, c);
#pragma unroll
                for (int e = 0; e < 8; ++e) qn[e] = a[e] * c[e]; } else {
#pragma unroll
                for (int e = 0; e < 8; ++e) qn[e] = 0.f; }
#pragma unroll
            for (int e = 0; e < 8; ++e) z[e] = gb[e] * (p.conv_w[col + e] * qp[e] + p.conv_w[1024 + col + e] * (gc[e] * uu[e]) + p.conv_w[2048 + col + e] * qn[e]);
            *(u32x4*)(Z + (size_t)row * DM + col) = __builtin_bit_cast(u32x4, pack8(z));
        }
    }
}

#define RLX_AGENT __ATOMIC_RELAXED, __HIP_MEMORY_SCOPE_AGENT
#define XB_TMO      128
#define XB_XCNT(j)  (256  + 64 * (j))
#define XB_XSUB(j)  (1280 + 64 * (j))
#define XB_XGEN(j)  (2304 + 64 * (j))
#define XB_TOP      3328
#define XB_TOPGEN   3392
#define XCD_BAR_WORDS 3456
#define XB_SPIN_CAP (1u << 18)

__device__ __forceinline__ unsigned xb_ld(unsigned* p)              { return __hip_atomic_load(p, __ATOMIC_RELAXED, __HIP_MEMORY_SCOPE_AGENT); }
__device__ __forceinline__ unsigned xb_add(unsigned* p, unsigned v) { return __hip_atomic_fetch_add(p, v, __ATOMIC_RELAXED, __HIP_MEMORY_SCOPE_AGENT); }
__device__ __forceinline__ unsigned xb_xcc_id() { return (unsigned)__builtin_amdgcn_s_getreg((3 << 11) | 20) & 0xFu; }
#define XB_SPIN(cond, bar) do { unsigned _sp = 0; while (cond) { __builtin_amdgcn_s_sleep(1); \
    if ((++_sp & 255u) == 0u) { if (xb_ld(&(bar)[XB_TMO])) break; if (_sp > XB_SPIN_CAP) { atomicAdd(&(bar)[XB_TMO], 1u); break; } } } } while (0)

struct XcdBarrier {
    unsigned* bar; unsigned x;
    volatile LAS unsigned* st;
};

__device__ __forceinline__ XcdBarrier xcd_barrier_post(unsigned* bar, volatile LAS unsigned* st) {
    XcdBarrier b; b.bar = bar; b.x = xb_xcc_id(); b.st = st;
    if (threadIdx.x == 0) (void)xb_add(&bar[XB_XCNT(b.x)], 1u);
    return b;
}
__device__ __forceinline__ void xcd_barrier_complete(unsigned* bar, unsigned x, unsigned& nloc, unsigned& nx) {
    const unsigned G = gridDim.x * gridDim.y * gridDim.z;
    unsigned sum, cnt, mine, sp = 0u;
    for (;;) {
        sum = 0u; cnt = 0u; mine = 0u;
#pragma unroll
        for (unsigned j = 0; j < 16; ++j) { const unsigned c = xb_ld(&bar[XB_XCNT(j)]); sum += c; cnt += (c > 0u) ? 1u : 0u; mine = (j == x) ? c : mine; }
        if (sum == G) break;
        __builtin_amdgcn_s_sleep(1);
        if ((++sp & 255u) == 0u) { if (xb_ld(&bar[XB_TMO])) break; if (sp > XB_SPIN_CAP) { atomicAdd(&bar[XB_TMO], 1u); break; } }
    }
    nloc = mine > 0u ? mine : 1u; nx = cnt > 0u ? cnt : 1u;
}

__device__ __forceinline__ void xcd_barrier(const XcdBarrier& b) {
    asm volatile("s_waitcnt vmcnt(0)" ::: "memory");
    __syncthreads();
    if (threadIdx.x == 0) {
        unsigned* bar = b.bar;
        __builtin_amdgcn_s_waitcnt(0);
        unsigned nloc = b.st[0], nx = b.st[1];
        if (nloc == 0u) { xcd_barrier_complete(bar, b.x, nloc, nx); b.st[0] = nloc; b.st[1] = nx; }
        const unsigned old = xb_add(&bar[XB_XSUB(b.x)], 1u);
        const unsigned gen = old / nloc;
        if (old + 1u == (gen + 1u) * nloc) {
            __builtin_amdgcn_fence(__ATOMIC_RELEASE, "agent");
            asm volatile("s_waitcnt vmcnt(0)" ::: "memory");
            const unsigned og = xb_add(&bar[XB_TOP], 1u);
            const unsigned tg = og / nx;
            if (og + 1u == (tg + 1u) * nx) xb_add(&bar[XB_TOPGEN], 1u);
            else XB_SPIN(xb_ld(&bar[XB_TOPGEN]) == tg, bar);
            __builtin_amdgcn_fence(__ATOMIC_ACQUIRE, "agent");
            xb_add(&bar[XB_XGEN(b.x)], 1u);
            asm volatile("s_waitcnt vmcnt(0)" ::: "memory");
        } else {
            XB_SPIN(xb_ld(&bar[XB_XGEN(b.x)]) == gen, bar);
            __builtin_amdgcn_fence(__ATOMIC_ACQUIRE, "agent");
            asm volatile("s_waitcnt vmcnt(0)" ::: "memory");
        }
    }
    __syncthreads();
}

constexpr int N_PHASES = 18;
constexpr int PROBE = 0;
template <int ACT>
DI void run_gemm(LAS unsigned char* lds, const bf16* A, int lda, const bf16* Bt, int M, int N, int K, bf16* O, int ldc, int G) {
    pg8::Gemm g{A, Bt, M, N, K, lda}; pg8::StaticOrder S; S.init(M, N, G, (int)blockIdx.x);
    pg8::EpiBf16<ACT> E{O, ldc, nullptr, 0, 0, 1.f};
    pg8::gemm_phase<pg8::EpiBf16<ACT>, pg8::StaticOrder, true, true>(lds, g, S, E);
}

__global__ void __launch_bounds__(NTHR, 2) mega_fwd(Params p) {
    extern __shared__ __attribute__((aligned(16))) unsigned char lds_raw[];
    LAS unsigned char* lds = (LAS unsigned char*)lds_raw;
    cg::grid_group grid = cg::this_grid();
    const int tid = threadIdx.x, lane = tid & 63, wave = __builtin_amdgcn_readfirstlane(tid >> 6);
    const int G = gridDim.x, bx = blockIdx.x, vcu = (G % 8 == 0) ? (bx % 8) * (G / 8) + bx / 8 : bx;
    unsigned char* ws = p.ws;
    volatile LAS unsigned* misc = (volatile LAS unsigned*)(lds + 131072);
    if (tid < 32) misc[tid] = 0u;
    __syncthreads();
    if (bx == 0) for (int i = tid; i < (int)(WS_BAR_BYTES / 4); i += NTHR) ((unsigned*)(ws + WS_BAR))[i] = 0u;
    XcdBarrier xbar; xbar.bar = (unsigned*)(ws + WS_BAR); xbar.x = 0; xbar.st = misc + 8;
    const float* mod0 = (const float*)(ws + WS_MOD); const float* mod1 = mod0 + 5 * 6144;
    const float* ng0 = p.norm_g; const float* ng1 = p.norm_g + 4 * DM;
#define IN(k) (p.ph_lo <= (k) && (k) < p.ph_hi)
#define SEAM(k) do { if (IN(k) && IN((k) + 1)) { if ((k) == 0) grid.sync(); else xcd_barrier(xbar); } } while (0)
    if (IN(0)) { phase_prologue(p, lds, tid, wave, lane, vcu, G); if (PROBE == 7) { __syncthreads(); phase_prologue(p, lds, tid, wave, lane, vcu, G); } }
    SEAM(0);
    xbar = xcd_barrier_post((unsigned*)(ws + WS_BAR), misc + 8);
    if (IN(1)) phase_norm0(p, wave, lane, vcu, G);
    SEAM(1);
    if (IN(2)) run_gemm<0>(lds, (const bf16*)(ws + WS_A0), DM, (const bf16*)(ws + WS_WINT), MT, PP, DM, (bf16*)(ws + WS_P), PP, G);
    SEAM(2);
    if (IN(3)) { phase_features(p, lds, tid, wave, lane, vcu, G);  }
    SEAM(3);
    if (IN(4)) { if (PROBE == 8) { phase_attention<1>(p, lds, tid, wave, lane, vcu, G); __syncthreads(); }
        for (int su = vcu; su < 256; su += G) phase_scan<0>(p, lds, tid, wave, lane, su); __syncthreads(); if (PROBE == 2) { for (int su = vcu; su < 256; su += G) phase_scan<0>(p, lds, tid, wave, lane, su); __syncthreads(); }
        if (PROBE == 5) { for (int su = vcu; su < 256; su += G) phase_scan<1>(p, lds, tid, wave, lane, su); __syncthreads(); }
        if (PROBE == 6) { for (int su = vcu; su < 256; su += G) phase_scan<2>(p, lds, tid, wave, lane, su); __syncthreads(); } }
    SEAM(4);
    if (IN(5)) { phase_rwkv_out(p, lds, tid, wave, lane, vcu, G); __syncthreads(); phase_weights2(p, lds, wave, lane, vcu, G);
        if (PROBE == 9) { __syncthreads(); phase_rwkv_out(p, lds, tid, wave, lane, vcu, G); __syncthreads(); phase_weights2(p, lds, wave, lane, vcu, G); }
        if (PROBE == 3) { __syncthreads(); phase_weights2(p, lds, wave, lane, vcu, G); } if (PROBE == 4) { __syncthreads(); phase_rwkv_out(p, lds, tid, wave, lane, vcu, G); } }
    SEAM(5);
    if (IN(6)) run_gemm<0>(lds, (const bf16*)(ws + WS_P), PP, (const bf16*)(ws + WS_WOUTT), ML, DM, DM, (bf16*)(ws + WS_YL), DM, G);
    SEAM(6);
    if (IN(7)) { phase_norm1<false, true>((const bf16*)(ws + WS_YL), p.x, ws + WS_XLB, ng0 + DM, mod0, 2048, ng0 + 2 * DM, 3072, 4096, (bf16*)(ws + WS_A1), wave, lane, vcu, G);
        if (PROBE == 1) phase_norm1<false, true>((const bf16*)(ws + WS_YL), p.x, ws + WS_XLB, ng0 + DM, mod0, 2048, ng0 + 2 * DM, 3072, 4096, (bf16*)(ws + WS_A1), wave, lane, vcu, G); }
    SEAM(7);
    if (IN(8)) run_gemm<1>(lds, (const bf16*)(ws + WS_A1), DM, (const bf16*)(ws + WS_W1T0), ML, HID, DM, (bf16*)(ws + WS_H), HID, G);
    SEAM(8);
    if (IN(9)) run_gemm<0>(lds, (const bf16*)(ws + WS_H), HID, (const bf16*)(ws + WS_W2T0), ML, DM, HID, (bf16*)(ws + WS_YL), DM, G);
    SEAM(9);
    if (IN(10)) phase_norm1<true, true>((const bf16*)(ws + WS_YL), ws + WS_XLB, ws + WS_XLB, ng0 + 3 * DM, mod0, 5120, ng1, 30720, 30720 + 1024, (bf16*)(ws + WS_A1), wave, lane, vcu, G);
    SEAM(10);
    if (IN(11)) run_gemm<0>(lds, (const bf16*)(ws + WS_A1), DM, (const bf16*)(ws + WS_CINT), ML, 3 * DM, DM, (bf16*)(ws + WS_G), 3 * DM, G);
    SEAM(11);
    if (IN(12)) phase_conv(p, wave, lane, vcu, G);
    SEAM(12);
    if (IN(13)) run_gemm<0>(lds, (const bf16*)(ws + WS_Z), DM, (const bf16*)(ws + WS_COUTT), ML, DM, DM, (bf16*)(ws + WS_YL), DM, G);
    SEAM(13);
    if (IN(14)) phase_norm1<true, true>((const bf16*)(ws + WS_YL), ws + WS_XLB, ws + WS_XLB, ng1 + DM, mod1, 2048, ng1 + 2 * DM, 3072, 4096, (bf16*)(ws + WS_A1), wave, lane, vcu, G);
    SEAM(14);
    if (IN(15)) run_gemm<1>(lds, (const bf16*)(ws + WS_A1), DM, (const bf16*)(ws + WS_W1T1), ML, HID, DM, (bf16*)(ws + WS_H), HID, G);
    SEAM(15);
    if (IN(16)) run_gemm<0>(lds, (const bf16*)(ws + WS_H), HID, (const bf16*)(ws + WS_W2T1), ML, DM, HID, (bf16*)(ws + WS_YL), DM, G);
    SEAM(16);
    if (IN(17)) phase_norm1<true, false>((const bf16*)(ws + WS_YL), ws + WS_XLB, p.out, ng1 + 3 * DM, mod1, 5120, nullptr, 0, 0, nullptr, wave, lane, vcu, G);
#undef IN
#undef SEAM
}

extern "C" void kernel_launch(void* const* d_in, const int* in_sizes, int n_in, void* d_out, int out_size, void* d_ws, size_t ws_size, hipStream_t stream) {
    static int grid = 0;
    if (grid == 0) {
        if (n_in != 26 || out_size != ML * DM || ws_size < WS_END) { fprintf(stderr, "kernel_launch: unexpected shapes (n_in %d out %d ws %zu)\n", n_in, out_size, ws_size); grid = -1; return; }
        int dev = 0, cus = 0, per_cu = 0;
        (void)hipGetDevice(&dev); (void)hipDeviceGetAttribute(&cus, hipDeviceAttributeMultiprocessorCount, dev);
        if (hipFuncSetAttribute((const void*)mega_fwd, hipFuncAttributeMaxDynamicSharedMemorySize, LDS_BYTES) != hipSuccess) { fprintf(stderr, "kernel_launch: hipFuncSetAttribute failed\n"); grid = -1; return; }
        if (hipOccupancyMaxActiveBlocksPerMultiprocessor(&per_cu, (const void*)mega_fwd, NTHR, LDS_BYTES) != hipSuccess || per_cu < 1) per_cu = 1;
        (void)hipGetLastError();
        grid = cus * per_cu; if (grid > 256) grid = 256; if (grid < 1) grid = 256;
    }
    if (grid < 0) return;
    Params p{};
    const float** f = (const float**)&p;
    for (int i = 0; i < 26; ++i) f[i] = (const float*)d_in[i];
    p.out = (float*)d_out; p.ws = (unsigned char*)d_ws;
#ifndef MK_SPLIT
    p.ph_lo = 0; p.ph_hi = N_PHASES;
    void* args[] = {&p};
    hipError_t e = hipLaunchCooperativeKernel((void*)mega_fwd, dim3(grid), dim3(NTHR), args, LDS_BYTES, stream);
    if (e != hipSuccess) fprintf(stderr, "cooperative launch failed: %s (grid %d)\n", hipGetErrorString(e), grid);
#else
    for (int k = 0; k < N_PHASES; ++k) { p.ph_lo = k; p.ph_hi = k + 1; void* args[] = {&p};
        hipError_t e = hipLaunchCooperativeKernel((void*)mega_fwd, dim3(grid), dim3(NTHR), args, LDS_BYTES, stream);
        if (e != hipSuccess) { fprintf(stderr, "launch %d failed: %s\n", k, hipGetErrorString(e)); break; } }
#endif
}
```

```cpp
#include <hip/hip_runtime.h>
#include <hip/hip_cooperative_groups.h>
#include <cstdio>
#include <cstdint>
namespace cg = cooperative_groups;
namespace pg8 {
#define PG8_LAS __attribute__((address_space(3)))
typedef unsigned short bf16_t;
typedef short bf16x8 __attribute__((ext_vector_type(8)));
typedef float f32x4 __attribute__((ext_vector_type(4)));
typedef unsigned u32x4 __attribute__((ext_vector_type(4)));
constexpr int BM = 256, BK = 64, HALF = 128, HTB = HALF * BK * 2  , STAGE_BYTES = 8 * HTB, NXCD = 8, WGM = 4;

__host__ __device__ __forceinline__ int lds_byte(int r, int c) { const int st = (r >> 4) * 2 + (c >> 5), rr = r & 15, cc = c & 31, ob = rr * 64 + cc * 2; return st * 1024 + (ob ^ (((ob >> 9) & 1) << 5)); }
__host__ __device__ __forceinline__ void stage_rc(int b, int& R, int& C) { const int st = b / 1024, sb = b % 1024, swz = sb ^ (((sb >> 9) & 1) << 5); R = (st >> 1) * 16 + swz / 64; C = (st & 1) * 32 + (swz % 64) / 2; }
__host__ __device__ __forceinline__ int perm32(int rho) { const int n = rho >> 4, i = rho & 15; return 8 * (i >> 2) + 4 * n + (i & 3); }

struct Unit { int pm, pn; };
struct Gemm { const bf16_t* A; const bf16_t* Bt; int M, N, K, lda; };

struct StaticOrder {
    int nM, nN, nwg, G, c;
    __host__ __device__ void init(int M, int N, int G_, int c_) { nM = M / BM; nN = N / BM; nwg = nM * nN; G = G_; c = c_; }
    __host__ __device__ bool next(int i, Unit& u) const {
        const long L = (long)i * G + c; if (L >= nwg) return false;
        int wgid = (int)L; { const int q = nwg / NXCD, r = nwg % NXCD, xcd = wgid % NXCD, off = wgid / NXCD; wgid = (xcd < r ? xcd * (q + 1) : r * (q + 1) + (xcd - r) * q) + off; }
        const int nig = WGM * nN, gid = wgid / nig, fm = gid * WGM, gsz = (nM - fm) < WGM ? (nM - fm) : WGM;
        u.pm = fm + ((wgid % nig) % gsz); u.pn = (wgid % nig) / gsz; return true;
    }
    __device__ __forceinline__ void a_ready(const Unit&) const {}
    __device__ __forceinline__ void done(const Unit&) const {}
};

__device__ __forceinline__ unsigned cvt_pk_bf16(float lo, float hi) { unsigned r; asm volatile("v_cvt_pk_bf16_f32 %0, %1, %2" : "=v"(r) : "v"(lo), "v"(hi)); return r; }
typedef float f32x2 __attribute__((ext_vector_type(2)));
__device__ __forceinline__ f32x2 gelu_pk(f32x2 v) {
    const f32x2 av = __builtin_elementwise_abs(v), d = av * 0.2316418882f + 1.0f;
    f32x2 t; t.x = __builtin_amdgcn_rcpf(d.x); t.y = __builtin_amdgcn_rcpf(d.y);
    f32x2 q = t * 0.5307027145f + (-0.7265760135f); q = q * t + 0.7107068705f; q = q * t + (-0.142248368f); q = q * t + 0.127414796f; q = q * t;
    const f32x2 s = (v * v) * (-0.72134752044f);
    f32x2 e; e.x = __builtin_amdgcn_exp2f(s.x); e.y = __builtin_amdgcn_exp2f(s.y);
    const f32x2 m = v * (q * e), r = v - m;
    f32x2 o; o.x = v.x < 0.f ? m.x : r.x; o.y = v.y < 0.f ? m.y : r.y; return o;
}

template <int ACT  > struct EpiBf16 {
    static constexpr bool PERM = true, AFTER_DRAIN = false; static_assert(ACT == 0 || ACT == 1, "EpiBf16: ACT is 0 or 1");
    bf16_t* O; int ldc; const float* bias; int split_cols; size_t split_stride; float scale0;
    __device__ __forceinline__ void operator()(const f32x4 (&acc)[2][2][4][2], const Unit& u, int wr, int wc, int fr, int fq) const {
        const int row0 = u.pm * BM + wr * 64 + fr; int colt = u.pn * BM; bf16_t* base = O;
        float sc = 1.f; if (split_cols) { const int t = colt / split_cols; base += (size_t)t * split_stride; colt -= t * split_cols; if (t == 0) sc = scale0; }
        const int col0 = colt + wc * 32 + 8 * fq, bcol0 = u.pn * BM + wc * 32 + 8 * fq;
        f32x4 bv[2][2];
#pragma unroll
        for (int bj = 0; bj < 2; ++bj)
#pragma unroll
            for (int n = 0; n < 2; ++n) bv[bj][n] = bias ? *(const f32x4*)(bias + bcol0 + bj * HALF + 4 * n) : (f32x4){0.f, 0.f, 0.f, 0.f};
#pragma unroll
        for (int ai = 0; ai < 2; ++ai)
#pragma unroll
            for (int m = 0; m < 4; ++m) { bf16_t* rowp = base + (size_t)(row0 + ai * HALF + m * 16) * ldc + col0;
#pragma unroll
                for (int bj = 0; bj < 2; ++bj) { f32x4 v0 = acc[ai][bj][m][0] + bv[bj][0], v1 = acc[ai][bj][m][1] + bv[bj][1];
                    if (ACT == 1) { v0 = __builtin_elementwise_max(v0, (f32x4){0.f, 0.f, 0.f, 0.f}); v1 = __builtin_elementwise_max(v1, (f32x4){0.f, 0.f, 0.f, 0.f}); v0 = v0 * v0; v1 = v1 * v1; }
                    v0 = v0 * sc; v1 = v1 * sc; u32x4 w; w.x = cvt_pk_bf16(v0[0], v0[1]); w.y = cvt_pk_bf16(v0[2], v0[3]); w.z = cvt_pk_bf16(v1[0], v1[1]); w.w = cvt_pk_bf16(v1[2], v1[3]);
                    *(u32x4*)(rowp + bj * HALF) = w; } }
    }
};

template <class Epi, class Sched, bool ALIGN_EPI = false, bool SP2 = false>
__device__ __forceinline__ void gemm_phase(PG8_LAS unsigned char* lds, const Gemm g, const Sched& S, const Epi& E) {
    const int tid = threadIdx.x, wid = __builtin_amdgcn_readfirstlane(tid >> 6), lane = tid & 63, wr = wid >> 2, wc = wid & 3, fr = lane & 15, fq = lane >> 4;
    const int K = g.K, nt = K / BK;
    unsigned voffA[2], voffB[2];
#pragma unroll
    for (int i = 0; i < 2; ++i) { int R, C; stage_rc(tid * 16 + i * 8192, R, C); const int Rb = Epi::PERM ? ((R & ~31) + perm32(R & 31)) : R;
        voffA[i] = (unsigned)(R * g.lda + C) * 2u; voffB[i] = (unsigned)(Rb * K + C) * 2u; }
    const size_t kstep = (size_t)(BK * 2);
    const size_t hstep = (size_t)HALF * K * 2;
    const size_t tstep = 2 * hstep; const size_t hstepA = (size_t)HALF * g.lda * 2, tstepA = 2 * hstepA;
    const unsigned ldsw = (unsigned)wid * 1024u;
    const int aoff = lds_byte(wr * 64 + fr, fq * 8), boff = lds_byte(wc * 32 + fr, fq * 8);
#define PG8_SA(b, h) (((b) * 2 + (h)) * HTB)
#define PG8_SB(b, h) ((4 + (b) * 2 + (h)) * HTB)
#define PG8_STAGE(bufoff, gbase, voff) do { _Pragma("unroll") for (int _i = 0; _i < 2; ++_i) \
        __builtin_amdgcn_global_load_lds((const unsigned*)((const char*)(gbase) + (voff)[_i]), (PG8_LAS unsigned*)(lds + (bufoff) + ldsw + _i * 8192), 16, 0, 0); } while (0)
#define PG8_LDA(dst, b, h) do { _Pragma("unroll") for (int m = 0; m < 4; ++m) _Pragma("unroll") for (int k = 0; k < 2; ++k) dst[m][k] = *(const PG8_LAS bf16x8*)(lds + PG8_SA(b, h) + aoff + m * 2048 + k * 1024); } while (0)
#define PG8_LDB(dst, b, h) do { _Pragma("unroll") for (int n = 0; n < 2; ++n) _Pragma("unroll") for (int k = 0; k < 2; ++k) dst[n][k] = *(const PG8_LAS bf16x8*)(lds + PG8_SB(b, h) + boff + n * 2048 + k * 1024); } while (0)
#define PG8_MMA(ai, bj, At, Bt) do { __builtin_amdgcn_s_setprio(1); _Pragma("unroll") for (int m = 0; m < 4; ++m) _Pragma("unroll") for (int n = 0; n < 2; ++n) _Pragma("unroll") for (int k = 0; k < 2; ++k) \
        acc[ai][bj][m][n] = __builtin_amdgcn_mfma_f32_16x16x32_bf16(Bt[n][k], At[m][k], acc[ai][bj][m][n], 0, 0, 0); __builtin_amdgcn_s_setprio(0); } while (0)
#define PG8_WAIT_V(n) asm volatile("s_waitcnt vmcnt(" #n ")" ::: "memory")
#define PG8_WAIT_L(n) asm volatile("s_waitcnt lgkmcnt(" #n ")" ::: "memory")
#define PG8_BAR __builtin_amdgcn_s_barrier()
#define PG8_SCHED __builtin_amdgcn_sched_barrier(0)
    Unit cur, nxt; int ui = 0;
    if (!S.next(0, cur)) return;
    f32x4 acc[2][2][4][2];
#pragma unroll
    for (int a = 0; a < 2; ++a)
#pragma unroll
        for (int b = 0; b < 2; ++b)
#pragma unroll
            for (int m = 0; m < 4; ++m)
#pragma unroll
                for (int n = 0; n < 2; ++n) acc[a][b][m][n] = (f32x4){0.f, 0.f, 0.f, 0.f};
    bf16x8 At[4][2], B0[2][2], B1[2][2];
    const char* cA = (const char*)g.A + (size_t)cur.pm * tstepA; const char* cB = (const char*)g.Bt + (size_t)cur.pn * tstep;
    S.a_ready(cur);
    if constexpr (SP2) {
        PG8_STAGE(PG8_SB(0, 0), cB, voffB); PG8_STAGE(PG8_SB(0, 1), cB + hstep, voffB); PG8_STAGE(PG8_SA(0, 0), cA, voffA); PG8_STAGE(PG8_SA(0, 1), cA + hstepA, voffA);
        if (wr == 1) PG8_BAR;
        PG8_WAIT_V(2); PG8_BAR;
        PG8_STAGE(PG8_SB(1, 0), cB + kstep, voffB); PG8_STAGE(PG8_SA(1, 0), cA + kstep, voffA); PG8_STAGE(PG8_SB(1, 1), cB + hstep + kstep, voffB);
        PG8_WAIT_V(6); PG8_BAR;
    } else {
        PG8_STAGE(PG8_SB(0, 0), cB, voffB); PG8_STAGE(PG8_SA(0, 0), cA, voffA); PG8_STAGE(PG8_SB(0, 1), cB + hstep, voffB); PG8_STAGE(PG8_SA(0, 1), cA + hstepA, voffA);
        if (wr == 1) PG8_BAR;
        PG8_WAIT_V(4); PG8_BAR;
        PG8_STAGE(PG8_SB(1, 0), cB + kstep, voffB); PG8_STAGE(PG8_SA(1, 0), cA + kstep, voffA); PG8_STAGE(PG8_SB(1, 1), cB + hstep + kstep, voffB);
        PG8_WAIT_V(6); PG8_BAR;
    }
    for (;;) {
        const bool has_next = S.next(ui + 1, nxt);
        const char* nA = has_next ? (const char*)g.A + (size_t)nxt.pm * tstepA : cA; const char* nB = has_next ? (const char*)g.Bt + (size_t)nxt.pn * tstep : cB;
        for (int t = 0; t < nt; t += 2) {
            const bool last = (t == nt - 2);
            const char* a1 = cA + (size_t)(t + 1) * kstep;
            const char* a2 = last ? nA : cA + (size_t)(t + 2) * kstep; const char* b2 = last ? nB : cB + (size_t)(t + 2) * kstep;
            const char* a3 = a2 + kstep; const char* b3 = b2 + kstep;
            if (last && has_next) S.a_ready(nxt);
            if constexpr (SP2) {
            PG8_LDB(B0, 0, 0); PG8_LDB(B1, 0, 1); PG8_SCHED; PG8_LDA(At, 0, 0); PG8_STAGE(PG8_SA(1, 1), a1 + hstepA, voffA);
            PG8_WAIT_V(8); PG8_WAIT_L(0); PG8_BAR; PG8_MMA(0, 0, At, B0); PG8_MMA(0, 1, At, B1); PG8_BAR; PG8_SCHED;
            PG8_LDA(At, 0, 1); PG8_STAGE(PG8_SB(0, 0), b2, voffB); PG8_STAGE(PG8_SB(0, 1), b2 + hstep, voffB); PG8_STAGE(PG8_SA(0, 0), a2, voffA);
            PG8_WAIT_V(8); PG8_WAIT_L(0); PG8_BAR; PG8_MMA(1, 0, At, B0); PG8_MMA(1, 1, At, B1); PG8_BAR; PG8_SCHED;
            PG8_LDB(B0, 1, 0); PG8_LDB(B1, 1, 1); PG8_SCHED; PG8_LDA(At, 1, 0); PG8_STAGE(PG8_SA(0, 1), a2 + hstepA, voffA);
            PG8_WAIT_V(8); PG8_WAIT_L(0); PG8_BAR; PG8_MMA(0, 0, At, B0); PG8_MMA(0, 1, At, B1); PG8_BAR; PG8_SCHED;
            PG8_LDA(At, 1, 1); PG8_STAGE(PG8_SB(1, 0), b3, voffB); PG8_STAGE(PG8_SB(1, 1), b3 + hstep, voffB); PG8_STAGE(PG8_SA(1, 0), a3, voffA);
            PG8_WAIT_V(8); PG8_WAIT_L(0); PG8_BAR; PG8_MMA(1, 0, At, B0); PG8_MMA(1, 1, At, B1); PG8_BAR; PG8_SCHED;
            } else {
            PG8_LDB(B0, 0, 0); PG8_SCHED; PG8_LDA(At, 0, 0); PG8_STAGE(PG8_SA(1, 1), a1 + hstepA, voffA);
            PG8_WAIT_L(8); PG8_BAR; PG8_WAIT_L(0); PG8_MMA(0, 0, At, B0); PG8_BAR; PG8_SCHED;
            PG8_LDB(B1, 0, 1); PG8_STAGE(PG8_SB(0, 0), b2, voffB);
            PG8_BAR; PG8_WAIT_L(0); PG8_MMA(0, 1, At, B1); PG8_BAR;
            PG8_LDA(At, 0, 1); PG8_STAGE(PG8_SA(0, 0), a2, voffA);
            PG8_BAR; PG8_WAIT_L(0); PG8_MMA(1, 0, At, B0); PG8_BAR; PG8_SCHED;
            PG8_STAGE(PG8_SB(0, 1), b2 + hstep, voffB);
            PG8_WAIT_V(6); PG8_BAR; PG8_MMA(1, 1, At, B1); PG8_BAR;
            PG8_LDB(B0, 1, 0); PG8_SCHED; PG8_LDA(At, 1, 0); PG8_STAGE(PG8_SA(0, 1), a2 + hstepA, voffA);
            PG8_WAIT_L(8); PG8_BAR; PG8_WAIT_L(0); PG8_MMA(0, 0, At, B0); PG8_BAR; PG8_SCHED;
            PG8_LDB(B1, 1, 1); PG8_STAGE(PG8_SB(1, 0), b3, voffB);
            PG8_BAR; PG8_WAIT_L(0); PG8_MMA(0, 1, At, B1); PG8_BAR;
            PG8_LDA(At, 1, 1); PG8_STAGE(PG8_SA(1, 0), a3, voffA);
            PG8_BAR; PG8_WAIT_L(0); PG8_MMA(1, 0, At, B0); PG8_BAR; PG8_SCHED;
            PG8_STAGE(PG8_SB(1, 1), b3 + hstep, voffB);
            PG8_WAIT_V(6); PG8_BAR; PG8_MMA(1, 1, At, B1); PG8_BAR;
            }
        }
        if constexpr (ALIGN_EPI) { if (wr == 0) PG8_BAR; }
        if constexpr (!Epi::AFTER_DRAIN) { E(acc, cur, wr, wc, fr, fq); S.done(cur); }
        if (!has_next) break;
#pragma unroll
        for (int a = 0; a < 2; ++a)
#pragma unroll
            for (int b = 0; b < 2; ++b)
#pragma unroll
                for (int m = 0; m < 4; ++m)
#pragma unroll
                    for (int n = 0; n < 2; ++n) acc[a][b][m][n] = (f32x4){0.f, 0.f, 0.f, 0.f};
        cur = nxt; cA = nA; cB = nB; ++ui;
        if constexpr (ALIGN_EPI) { if (wr == 1) PG8_BAR; }
    }
    PG8_WAIT_V(0);
    if constexpr (!ALIGN_EPI) { if (wr == 0) PG8_BAR; }
    PG8_BAR;
    if constexpr (Epi::AFTER_DRAIN) { E.fused(acc, cur, wr, wc, fr, fq, lds, wid, lane); S.done(cur); }
#undef PG8_SA
#undef PG8_SB
#undef PG8_STAGE
#undef PG8_LDA
#undef PG8_LDB
#undef PG8_MMA
#undef PG8_WAIT_V
#undef PG8_WAIT_L
#undef PG8_BAR
#undef PG8_SCHED
}
}

#define DI __device__ __forceinline__
#define LAS __attribute__((address_space(3)))
typedef unsigned short bf16;
typedef float f32x2 __attribute__((ext_vector_type(2)));
typedef float f32x4 __attribute__((ext_vector_type(4)));
typedef float f32x16 __attribute__((ext_vector_type(16)));
typedef short bf16x8 __attribute__((ext_vector_type(8)));
typedef unsigned u32x2 __attribute__((ext_vector_type(2)));
typedef unsigned u32x4 __attribute__((ext_vector_type(4)));
typedef __bf16 bfv2 __attribute__((ext_vector_type(2)));

constexpr int NWAVES = 8, NTHR = 512;
constexpr int DM = 1024, NB = 4, SEQ = 8192, CTXL = 256, HID = 4096;
constexpr int ML = NB * SEQ, MC = NB * CTXL, MT = ML + MC;
constexpr int PP = 2816;
constexpr int RWC = 768;
constexpr int NPOS = CTXL + SEQ;
constexpr size_t MiB = 1u << 20;
constexpr size_t WS_BAR = 3 * MiB, WS_BAR_BYTES = 16384;
constexpr size_t WS_MOD = 0, WS_W2T = 256 * 1024, WS_A2T = 384 * 1024, WS_G2T = 512 * 1024, WS_BC = 1 * MiB;
constexpr size_t WS_CC = 4 * MiB;
constexpr size_t WS_WINT = 4 * MiB, WS_WOUTT = 10 * MiB, WS_P = 12 * MiB, WS_KP = 194 * MiB, WS_VT = 203 * MiB;
constexpr size_t WS_SH = 212 * MiB, WS_SD0 = 311 * MiB, WS_SD1 = 410 * MiB, WS_A0 = 212 * MiB;
constexpr size_t WS_W1T0 = 340 * MiB, WS_W2T0 = 348 * MiB, WS_W1T1 = 356 * MiB, WS_W2T1 = 364 * MiB, WS_CINT = 372 * MiB, WS_COUTT = 378 * MiB;
constexpr size_t WS_XLB = 268 * MiB;
constexpr size_t WS_YL = 380 * MiB, WS_A1 = 444 * MiB, WS_H = 12 * MiB, WS_G = 12 * MiB, WS_Z = 204 * MiB, WS_END = 509 * MiB;
constexpr int LDS_BYTES = 147456;
constexpr float LOG2E = 1.4426950408889634f;

struct Params {
    const float *x, *c, *ctx, *c_ctx, *mod_w, *mod_b, *norm_g, *mlp_w1, *mlp_w2, *ab_w_in, *ab_w_out, *att_sink;
    const float *rwkv_mu, *rwkv_w0, *rwkv_w2, *rwkv_a0, *rwkv_a2, *rwkv_g2, *rwkv_kk, *rwkv_ka, *rwkv_rk, *rwkv_ln_w, *rwkv_ln_b;
    const float *conv_w_in, *conv_w, *conv_w_out;
    float* out; unsigned char* ws;
    int ph_lo, ph_hi;
};

DI float bf_lo(unsigned p) { return __uint_as_float(p << 16); }
DI float bf_hi(unsigned p) { return __uint_as_float(p & 0xffff0000u); }
DI float bf1(bf16 v) { return __uint_as_float((unsigned)v << 16); }
DI unsigned pk2(float lo, float hi) { f32x2 v = {lo, hi}; bfv2 r = __builtin_convertvector(v, bfv2); return __builtin_bit_cast(unsigned, r); }
DI float wave_sum(float v) {
#pragma unroll
    for (int o = 1; o < 64; o <<= 1) v += __shfl_xor(v, o);
    return v;
}
#define DPP_ADD(x, ctrl) x += __builtin_bit_cast(float, __builtin_amdgcn_update_dpp(0, __builtin_bit_cast(int, x), ctrl, 0xf, 0xf, true))
DI float rowsum16(float x) { DPP_ADD(x, 0xB1); DPP_ADD(x, 0x4E); DPP_ADD(x, 0x141); DPP_ADD(x, 0x140); return x; }
DI float sigmoidf_(float z) { return __builtin_amdgcn_rcpf(1.0f + __expf(-z)); }
DI float tanhf_(float z) { const float e = __expf(-2.0f * fabsf(z)); const float t = (1.0f - e) * __builtin_amdgcn_rcpf(1.0f + e); return z < 0.f ? -t : t; }

DI void transpose_item(const float* W, int K, int N, bf16* WT, LAS float* scr, int item, int lane) {
    const int nblk = N / 32, kb = item / nblk, nb = item % nblk, k0 = 64 * kb, n0 = 32 * nb;
#pragma unroll 8
    for (int i = 0; i < 32; ++i) { const int kk = 2 * i + (lane >> 5); scr[kk * 33 + (lane & 31)] = W[(size_t)(k0 + kk) * N + n0 + (lane & 31)]; }
    asm volatile("s_waitcnt lgkmcnt(0)" ::: "memory");
    const int c = lane & 7;
#pragma unroll
    for (int j = 0; j < 4; ++j) { const int n = (lane >> 3) + 8 * j; const LAS float* s = scr + (8 * c) * 33 + n;
        u32x4 o; o.x = pk2(s[0 * 33], s[1 * 33]); o.y = pk2(s[2 * 33], s[3 * 33]); o.z = pk2(s[4 * 33], s[5 * 33]); o.w = pk2(s[6 * 33], s[7 * 33]);
        *(u32x4*)(WT + (size_t)(n0 + n) * K + k0 + 8 * c) = o; }
    asm volatile("s_waitcnt lgkmcnt(0)" ::: "memory");
}
DI void transpose_load(const float* W, int N, int item, int lane, float (&t)[32]) {
    const int nblk = N / 32, kb = item / nblk, nb = item % nblk, k0 = 64 * kb, n0 = 32 * nb;
#pragma unroll
    for (int i = 0; i < 32; ++i) t[i] = W[(size_t)(k0 + 2 * i + (lane >> 5)) * N + n0 + (lane & 31)];
}
DI void transpose_store(int K, int N, bf16* WT, LAS float* scr, int item, int lane, const float (&t)[32]) {
    const int nblk = N / 32, kb = item / nblk, nb = item % nblk, k0 = 64 * kb, n0 = 32 * nb;
#pragma unroll
    for (int i = 0; i < 32; ++i) scr[(2 * i + (lane >> 5)) * 33 + (lane & 31)] = t[i];
    asm volatile("s_waitcnt lgkmcnt(0)" ::: "memory");
    const int c = lane & 7;
#pragma unroll
    for (int j = 0; j < 4; ++j) { const int n = (lane >> 3) + 8 * j; const LAS float* s = scr + (8 * c) * 33 + n;
        u32x4 o; o.x = pk2(s[0 * 33], s[1 * 33]); o.y = pk2(s[2 * 33], s[3 * 33]); o.z = pk2(s[4 * 33], s[5 * 33]); o.w = pk2(s[6 * 33], s[7 * 33]);
        *(u32x4*)(WT + (size_t)(n0 + n) * K + k0 + 8 * c) = o; }
    asm volatile("s_waitcnt lgkmcnt(0)" ::: "memory");
}
DI void transpose_all(const float* W, int K, int N, bf16* WT, LAS float* scr, int gw, int ngw, int lane) {
    const int items = (K / 64) * (N / 32);
    for (int it = gw; it < items; it += 2 * ngw) {
        float ta[32], tb[32]; const bool two = it + ngw < items;
        transpose_load(W, N, it, lane, ta); if (two) transpose_load(W, N, it + ngw, lane, tb);
        transpose_store(K, N, WT, scr, it, lane, ta); if (two) transpose_store(K, N, WT, scr, it + ngw, lane, tb);
    }
}

DI void phase_prologue(const Params& p, LAS unsigned char* lds, int tid, int wave, int lane, int vcu, int G) {
    LAS float* sv = (LAS float*)lds;
    LAS float* part = (LAS float*)(lds + 20480);
    for (int i = tid; i < 5 * DM; i += NTHR) { const int v = i >> 10, k = i & 1023; const float cv = v < 4 ? p.c[v * DM + k] : p.c_ctx[k]; sv[i] = cv * __builtin_amdgcn_rcpf(1.0f + __expf(-cv)); }
    __syncthreads();
    float* mod = (float*)(p.ws + WS_MOD);
    for (int u = vcu; u < 192; u += G) {
        const int l = u / 96, n0 = (u % 96) * 64;
        const float* W = p.mod_w + (size_t)l * DM * 6144 + n0 + lane;
        float acc[5] = {0.f, 0.f, 0.f, 0.f, 0.f};
#pragma unroll 8
        for (int k = wave * 128; k < wave * 128 + 128; ++k) { const float w = W[(size_t)k * 6144];
#pragma unroll
            for (int v = 0; v < 5; ++v) acc[v] += sv[v * DM + k] * w; }
#pragma unroll
        for (int v = 0; v < 5; ++v) part[(wave * 5 + v) * 64 + lane] = acc[v];
        __syncthreads();
        if (tid < 320) { const int v = tid >> 6, n = tid & 63; float s = p.mod_b[l * 6144 + n0 + n];
#pragma unroll
            for (int w = 0; w < 8; ++w) s += part[(w * 5 + v) * 64 + n];
            mod[(l * 5 + v) * 6144 + n0 + n] = s; }
        __syncthreads();
    }
    __syncthreads();
    LAS float* scr = (LAS float*)(lds + wave * 16384);
    const int gw = vcu * NWAVES + wave, ngw = G * NWAVES;
    transpose_all(p.ab_w_in, DM, 2688, (bf16*)(p.ws + WS_WINT), scr, gw, ngw, lane);
    transpose_all(p.ab_w_out, DM, DM, (bf16*)(p.ws + WS_WOUTT), scr, gw, ngw, lane);
    for (int d = 0; d < 2; ++d) {
        transpose_all(p.rwkv_w2 + d * 64 * 512, 64, 512, (bf16*)(p.ws + WS_W2T) + d * 512 * 64, scr, gw, ngw, lane);
        transpose_all(p.rwkv_a2 + d * 64 * 512, 64, 512, (bf16*)(p.ws + WS_A2T) + d * 512 * 64, scr, gw, ngw, lane);
    }
    transpose_all(p.rwkv_g2, 128, 512, (bf16*)(p.ws + WS_G2T), scr, gw, ngw, lane);
    { u32x4* z = (u32x4*)((bf16*)(p.ws + WS_WINT) + (size_t)2688 * DM); const int n16 = 128 * DM * 2 / 16;
      for (int i = gw * 64 + lane; i < n16; i += ngw * 64) z[i] = (u32x4){0u, 0u, 0u, 0u}; }
}
DI void phase_weights2(const Params& p, LAS unsigned char* lds, int wave, int lane, int vcu, int G) {
    LAS float* scr = (LAS float*)(lds + wave * 16384);
    const int gw = vcu * NWAVES + wave, ngw = G * NWAVES;
    transpose_all(p.mlp_w1, DM, HID, (bf16*)(p.ws + WS_W1T0), scr, gw, ngw, lane);
    transpose_all(p.mlp_w2, HID, DM, (bf16*)(p.ws + WS_W2T0), scr, gw, ngw, lane);
    transpose_all(p.mlp_w1 + (size_t)DM * HID, DM, HID, (bf16*)(p.ws + WS_W1T1), scr, gw, ngw, lane);
    transpose_all(p.mlp_w2 + (size_t)DM * HID, HID, DM, (bf16*)(p.ws + WS_W2T1), scr, gw, ngw, lane);
    transpose_all(p.conv_w_in, DM, 3 * DM, (bf16*)(p.ws + WS_CINT), scr, gw, ngw, lane);
    transpose_all(p.conv_w_out, DM, DM, (bf16*)(p.ws + WS_COUTT), scr, gw, ngw, lane);
}

DI void store_row_bf16(bf16* orow, int lane, const f32x4 (&v)[4]) {
    unsigned long long* o8 = (unsigned long long*)orow + lane;
#pragma unroll
    for (int j = 0; j < 4; ++j) o8[64 * j] = (unsigned long long)pk2(v[j].x, v[j].y) | ((unsigned long long)pk2(v[j].z, v[j].w) << 32);
}
DI float wave_sum2(float v) { v = rowsum16(v); v += __shfl_xor(v, 16); v += __shfl_xor(v, 32); return v; }
DI void phase_norm0(const Params& p, int wave, int lane, int vcu, int G) {
    constexpr int NR = 4;
    const int gw = vcu * NWAVES + wave, ngw = G * NWAVES;
    const float* mod = (const float*)(p.ws + WS_MOD);
    bf16* A0 = (bf16*)(p.ws + WS_A0);
    for (int row0 = gw; row0 < MT; row0 += NR * ngw) {
        f32x4 xv[NR][4]; float ss[NR]; int rows[NR];
#pragma unroll
        for (int q = 0; q < NR; ++q) { int row = row0 + q * ngw; if (row >= MT) row = row0; rows[q] = row; ss[q] = 0.f;
            const float* xr = row < ML ? p.x + (size_t)row * DM : p.ctx + (size_t)(row - ML) * DM;
#pragma unroll
            for (int j = 0; j < 4; ++j) xv[q][j] = __builtin_nontemporal_load((const f32x4*)xr + lane + 64 * j); }
#pragma unroll
        for (int q = 0; q < NR; ++q) {
#pragma unroll
            for (int j = 0; j < 4; ++j) ss[q] += (xv[q][j].x * xv[q][j].x + xv[q][j].y * xv[q][j].y) + (xv[q][j].z * xv[q][j].z + xv[q][j].w * xv[q][j].w); }
        const int v0 = rows[0] < ML ? rows[0] / SEQ : 4, v3 = rows[NR - 1] < ML ? rows[NR - 1] / SEQ : 4;
        if (v0 == v3) {
            const float* sh = mod + v0 * 6144, *sc = sh + 1024;
            f32x4 c1[4], c0v[4];
#pragma unroll
            for (int j = 0; j < 4; ++j) { c1[j] = *((const f32x4*)p.norm_g + lane + 64 * j) * (*((const f32x4*)sc + lane + 64 * j) + 1.0f); c0v[j] = *((const f32x4*)sh + lane + 64 * j); }
#pragma unroll
            for (int q = 0; q < NR; ++q) {
                if (row0 + q * ngw >= MT) break;
                const float rs = rsqrtf(wave_sum2(ss[q]) * (1.0f / DM) + 1e-6f);
#pragma unroll
                for (int j = 0; j < 4; ++j) xv[q][j] = (xv[q][j] * rs) * c1[j] + c0v[j];
                store_row_bf16(A0 + (size_t)rows[q] * DM, lane, xv[q]);
            }
        } else {
#pragma unroll
        for (int q = 0; q < NR; ++q) {
            if (row0 + q * ngw >= MT) break;
            const int row = rows[q], v = row < ML ? row / SEQ : 4;
            const float* sh = mod + v * 6144, *sc = sh + 1024;
            const float rs = rsqrtf(wave_sum2(ss[q]) * (1.0f / DM) + 1e-6f);
#pragma unroll
            for (int j = 0; j < 4; ++j) { const f32x4 g = *((const f32x4*)p.norm_g + lane + 64 * j), s1 = *((const f32x4*)sc + lane + 64 * j), s0 = *((const f32x4*)sh + lane + 64 * j);
                xv[q][j] = (xv[q][j] * rs) * g * (s1 + 1.0f) + s0; }
            store_row_bf16(A0 + (size_t)row * DM, lane, xv[q]);
        }
        }
    }
}
template <bool XIN_BF, bool XOUT_BF>
DI void phase_norm1(const bf16* Y, const void* xin_, void* xout_, const float* gA, const float* modl, int gt_off, const float* gB, int sh_off, int sc_off, bf16* aout,
                    int wave, int lane, int vcu, int G) {
    constexpr int NR = 4;
    const int gw = vcu * NWAVES + wave, ngw = G * NWAVES;
    for (int row0 = gw; row0 < ML; row0 += NR * ngw) {
        f32x4 yv[NR][4], xv[NR][4]; int rows[NR]; float ss[NR];
#pragma unroll
        for (int q = 0; q < NR; ++q) ss[q] = 0.f;
#pragma unroll
        for (int q = 0; q < NR; ++q) { int row = row0 + q * ngw; if (row >= ML) row = row0; rows[q] = row;
#pragma unroll
            for (int j = 0; j < 4; ++j) { const u32x2 w = __builtin_nontemporal_load((const u32x2*)(Y + (size_t)row * DM) + lane + 64 * j); yv[q][j] = (f32x4){bf_lo(w.x), bf_hi(w.x), bf_lo(w.y), bf_hi(w.y)};
                if (XIN_BF) { const u32x2 xw = __builtin_nontemporal_load((const u32x2*)((const bf16*)xin_ + (size_t)row * DM) + lane + 64 * j); xv[q][j] = (f32x4){bf_lo(xw.x), bf_hi(xw.x), bf_lo(xw.y), bf_hi(xw.y)}; }
                else xv[q][j] = __builtin_nontemporal_load((const f32x4*)((const float*)xin_ + (size_t)row * DM) + lane + 64 * j); } }
#pragma unroll
        for (int q = 0; q < NR; ++q)
#pragma unroll
            for (int j = 0; j < 4; ++j) ss[q] += (yv[q][j].x * yv[q][j].x + yv[q][j].y * yv[q][j].y) + (yv[q][j].z * yv[q][j].z + yv[q][j].w * yv[q][j].w);
        float rs[NR], s2[NR];
#pragma unroll
        for (int q = 0; q < NR; ++q) s2[q] = 0.f;
#pragma unroll
        for (int q = 0; q < NR; ++q) rs[q] = rsqrtf(wave_sum2(ss[q]) * (1.0f / DM) + 1e-6f);
        const int b0 = rows[0] / SEQ; const bool same = b0 == rows[NR - 1] / SEQ;
        if (same) {
            const float* mv = modl + b0 * 6144;
            f32x4 cA[4];
#pragma unroll
            for (int j = 0; j < 4; ++j) cA[j] = *((const f32x4*)gA + lane + 64 * j) * *((const f32x4*)(mv + gt_off) + lane + 64 * j);
#pragma unroll
            for (int q = 0; q < NR; ++q) {
                if (row0 + q * ngw >= ML) break;
#pragma unroll
                for (int j = 0; j < 4; ++j) {
                    xv[q][j] = xv[q][j] + cA[j] * (yv[q][j] * rs[q]);
                    if (XOUT_BF) { u32x2 w; w.x = pk2(xv[q][j].x, xv[q][j].y); w.y = pk2(xv[q][j].z, xv[q][j].w); __builtin_nontemporal_store(w, (u32x2*)((bf16*)xout_ + (size_t)rows[q] * DM) + lane + 64 * j); }
                    else __builtin_nontemporal_store(xv[q][j], (f32x4*)((float*)xout_ + (size_t)rows[q] * DM) + lane + 64 * j);
                    s2[q] += (xv[q][j].x * xv[q][j].x + xv[q][j].y * xv[q][j].y) + (xv[q][j].z * xv[q][j].z + xv[q][j].w * xv[q][j].w); } }
            if (aout) {
                float r2[NR];
#pragma unroll
                for (int q = 0; q < NR; ++q) r2[q] = rsqrtf(wave_sum2(s2[q]) * (1.0f / DM) + 1e-6f);
                f32x4 c1[4], c0v[4];
#pragma unroll
                for (int j = 0; j < 4; ++j) { c1[j] = *((const f32x4*)gB + lane + 64 * j) * (*((const f32x4*)(mv + sc_off) + lane + 64 * j) + 1.0f); c0v[j] = *((const f32x4*)(mv + sh_off) + lane + 64 * j); }
#pragma unroll
                for (int q = 0; q < NR; ++q) {
                    if (row0 + q * ngw >= ML) break;
#pragma unroll
                    for (int j = 0; j < 4; ++j) yv[q][j] = (xv[q][j] * r2[q]) * c1[j] + c0v[j];
                    store_row_bf16(aout + (size_t)rows[q] * DM, lane, yv[q]); }
            }
        } else {
#pragma unroll
        for (int q = 0; q < NR; ++q) { const float* mv = modl + (rows[q] / SEQ) * 6144;
            if (row0 + q * ngw >= ML) break;
#pragma unroll
            for (int j = 0; j < 4; ++j) { const f32x4 g = *((const f32x4*)gA + lane + 64 * j), gt = *((const f32x4*)(mv + gt_off) + lane + 64 * j);
                xv[q][j] = xv[q][j] + gt * ((yv[q][j] * rs[q]) * g);
                if (XOUT_BF) { u32x2 w; w.x = pk2(xv[q][j].x, xv[q][j].y); w.y = pk2(xv[q][j].z, xv[q][j].w); __builtin_nontemporal_store(w, (u32x2*)((bf16*)xout_ + (size_t)rows[q] * DM) + lane + 64 * j); }
                else __builtin_nontemporal_store(xv[q][j], (f32x4*)((float*)xout_ + (size_t)rows[q] * DM) + lane + 64 * j);
                s2[q] += (xv[q][j].x * xv[q][j].x + xv[q][j].y * xv[q][j].y) + (xv[q][j].z * xv[q][j].z + xv[q][j].w * xv[q][j].w); } }
        if (aout) {
            float r2[NR];
#pragma unroll
            for (int q = 0; q < NR; ++q) r2[q] = rsqrtf(wave_sum2(s2[q]) * (1.0f / DM) + 1e-6f);
#pragma unroll
            for (int q = 0; q < NR; ++q) { const float* mv = modl + (rows[q] / SEQ) * 6144;
                if (row0 + q * ngw >= ML) break;
#pragma unroll
                for (int j = 0; j < 4; ++j) { const f32x4 g = *((const f32x4*)gB + lane + 64 * j), s1 = *((const f32x4*)(mv + sc_off) + lane + 64 * j), s0 = *((const f32x4*)(mv + sh_off) + lane + 64 * j);
                    yv[q][j] = (xv[q][j] * r2[q]) * g * (s1 + 1.0f) + s0; }
                store_row_bf16(aout + (size_t)rows[q] * DM, lane, yv[q]); }
        }
        }
    }
}

constexpr int FP = 1936;
DI f32x4 mix4(const LAS bf16* T, int t, int col, const f32x4 mu) {
    const u32x2 pv = *(const LAS u32x2*)(T + t * FP + col), cv = *(const LAS u32x2*)(T + (t + 1) * FP + col), nv = *(const LAS u32x2*)(T + (t + 2) * FP + col);
    const f32x4 p4 = {bf_lo(pv.x), bf_hi(pv.x), bf_lo(pv.y), bf_hi(pv.y)}, c4 = {bf_lo(cv.x), bf_hi(cv.x), bf_lo(cv.y), bf_hi(cv.y)}, n4 = {bf_lo(nv.x), bf_hi(nv.x), bf_lo(nv.y), bf_hi(nv.y)};
    return c4 + mu * ((p4 + n4) * 0.5f - c4);
}
DI void st4bf(bf16* dst, const f32x4 v) { u32x2 w; w.x = pk2(v.x, v.y); w.y = pk2(v.z, v.w); *(u32x2*)dst = w; }
DI void st4bf_nt(bf16* dst, const f32x4 v) { u32x2 w; w.x = pk2(v.x, v.y); w.y = pk2(v.z, v.w); __builtin_nontemporal_store(w, (u32x2*)dst); }
DI void unpack8(const u32x4 w, float (&o)[8]) { o[0] = bf_lo(w.x); o[1] = bf_hi(w.x); o[2] = bf_lo(w.y); o[3] = bf_hi(w.y); o[4] = bf_lo(w.z); o[5] = bf_hi(w.z); o[6] = bf_lo(w.w); o[7] = bf_hi(w.w); }
DI bf16x8 pack8(const float (&v)[8]) { u32x4 w; w.x = pk2(v[0], v[1]); w.y = pk2(v[2], v[3]); w.z = pk2(v[4], v[5]); w.w = pk2(v[6], v[7]); return __builtin_bit_cast(bf16x8, w); }

DI void phase_features(const Params& p, LAS unsigned char* lds, int tid, int wave, int lane, int vcu, int G) {
    const bf16* P = (const bf16*)(p.ws + WS_P);
    LAS bf16* T = (LAS bf16*)lds;
    bf16* SH = (bf16*)(p.ws + WS_SH); bf16* SD0 = (bf16*)(p.ws + WS_SD0); bf16* SD1 = (bf16*)(p.ws + WS_SD1);
    float* BC = (float*)(p.ws + WS_BC); bf16* KP = (bf16*)(p.ws + WS_KP); bf16* VT = (bf16*)(p.ws + WS_VT);
    const bf16* W2T = (const bf16*)(p.ws + WS_W2T); const bf16* A2T = (const bf16*)(p.ws + WS_A2T);
    const int h = wave, tq = lane >> 4, cl = lane & 15, c0 = h * 64 + 4 * cl;
    LAS float* PAR = (LAS float*)(lds + 18 * FP * 2);
    for (int i = tid; i < 10 * 512; i += NTHR) { const int v = i >> 9, c = i & 511;
        const float* src = v < 3 ? p.rwkv_mu + v * 512 : v == 3 ? p.rwkv_kk : v == 4 ? p.rwkv_ka : v == 5 ? p.rwkv_rk : v < 8 ? p.rwkv_w0 + (v - 6) * 512 : p.rwkv_a0 + (v - 8) * 512;
        PAR[i] = src[c]; }
    bf16x8 bwr[8];
#pragma unroll
    for (int q = 0; q < 8; ++q) { const int ks = (q >> 2) & 1, nt = q & 3; bwr[q] = *(const bf16x8*)(W2T + (size_t)(c0 + nt) * 64 + ks * 32 + tq * 8); }
    for (int u = vcu; u < MT / 16; u += G) {
        const int R0 = u * 16;
        int seq0, seqlen; if (R0 < ML) { seq0 = (R0 / SEQ) * SEQ; seqlen = SEQ; } else { seq0 = ML + ((R0 - ML) / CTXL) * CTXL; seqlen = CTXL; }
        bf16x8 bw[8];
#pragma unroll
        for (int q = 0; q < 8; ++q) bw[q] = *(const bf16x8*)(W2T + (size_t)512 * 64 + (size_t)(c0 + (q & 3)) * 64 + (q >> 2) * 32 + tq * 8);
        __syncthreads();
        for (int i = tid; i < 18 * 240; i += NTHR) { const int rr = i / 240, ch = i % 240, row = R0 - 1 + rr;
            u32x4 v = {0u, 0u, 0u, 0u}; if (row >= seq0 && row < seq0 + seqlen) v = *(const u32x4*)(P + (size_t)row * PP + RWC + ch * 8);
            *(LAS u32x4*)(T + rr * FP + ch * 8) = v; }
        __syncthreads();
        f32x4 lo[4][4];
#pragma unroll
        for (int L = 0; L < 4; ++L) {
            if (L >= 2) {
#pragma unroll
                for (int q = 0; q < 8; ++q) bw[q] = *(const bf16x8*)(A2T + (size_t)(L & 1) * 512 * 64 + (size_t)(c0 + (q & 3)) * 64 + (q >> 2) * 32 + tq * 8);
            }
#pragma unroll
            for (int nt = 0; nt < 4; ++nt) lo[L][nt] = (f32x4){0.f, 0.f, 0.f, 0.f};
#pragma unroll
            for (int ks = 0; ks < 2; ++ks) {
                const int cb = 1536 + 64 * L + ks * 32 + tq * 8, tok = lane & 15;
                float pv[8], cv[8], nv[8], a8[8];
                unpack8(*(const LAS u32x4*)(T + tok * FP + cb), pv); unpack8(*(const LAS u32x4*)(T + (tok + 1) * FP + cb), cv); unpack8(*(const LAS u32x4*)(T + (tok + 2) * FP + cb), nv);
                const f32x4 m0 = *(const f32x4*)(p.rwkv_mu + cb), m1 = *(const f32x4*)(p.rwkv_mu + cb + 4);
#pragma unroll
                for (int e = 0; e < 8; ++e) { const float mu = e < 4 ? m0[e] : m1[e - 4]; float m = cv[e] + mu * (0.5f * (pv[e] + nv[e]) - cv[e]); if (L < 2) m = tanhf_(m); a8[e] = m; }
                const bf16x8 a = pack8(a8);
#pragma unroll
                for (int nt = 0; nt < 4; ++nt) lo[L][nt] = __builtin_amdgcn_mfma_f32_16x16x32_bf16(a, L == 0 ? bwr[ks * 4 + nt] : bw[ks * 4 + nt], lo[L][nt], 0, 0, 0);
            }
            asm volatile("" ::: "memory");
        }
#pragma unroll
        for (int j = 0; j < 4; ++j) {
            const int t = 4 * tq + j, row = R0 + t;
            const f32x4 mu_r = *(const LAS f32x4*)(PAR + c0), mu_k = *(const LAS f32x4*)(PAR + 512 + c0), mu_v = *(const LAS f32x4*)(PAR + 1024 + c0);
            const f32x4 kkw = *(const LAS f32x4*)(PAR + 1536 + c0), kaw = *(const LAS f32x4*)(PAR + 2048 + c0), rkw = *(const LAS f32x4*)(PAR + 2560 + c0);
            const f32x4 w0f = *(const LAS f32x4*)(PAR + 3072 + c0), w0b = *(const LAS f32x4*)(PAR + 3584 + c0), a0f = *(const LAS f32x4*)(PAR + 4096 + c0), a0b = *(const LAS f32x4*)(PAR + 4608 + c0);
            const f32x4 r4 = mix4(T, t, c0, mu_r), k4 = mix4(T, t, 512 + c0, mu_k), v4 = mix4(T, t, 1024 + c0, mu_v);
            const f32x4 kkv = k4 * kkw;
            const float ss = rowsum16((kkv.x * kkv.x + kkv.y * kkv.y) + (kkv.z * kkv.z + kkv.w * kkv.w));
            const f32x4 kk4 = kkv * __builtin_amdgcn_rcpf(fmaxf(__builtin_amdgcn_sqrtf(ss), 1e-12f));
            f32x4 df, db, kf, kb, bf, bb_;
#pragma unroll
            for (int i = 0; i < 4; ++i) {
                const float zf = w0f[i] + lo[0][i][j], zb = w0b[i] + lo[1][i][j];
                df[i] = __expf(-0.6065306597f * sigmoidf_(zf)); db[i] = __expf(-0.6065306597f * sigmoidf_(zb));
                const float af = sigmoidf_(a0f[i] + lo[2][i][j]), ab = sigmoidf_(a0b[i] + lo[3][i][j]);
                kf[i] = k4[i] * (1.0f + (af - 1.0f) * kaw[i]); kb[i] = k4[i] * (1.0f + (ab - 1.0f) * kaw[i]);
                bf[i] = kk4[i] * af; bb_[i] = kk4[i] * ab;
            }
            const f32x4 bt = r4 * (kf + kb) * rkw;
            const float bonus = rowsum16((bt.x + bt.y) + (bt.z + bt.w));
            if (cl == 0) BC[row * 8 + h] = bonus;
            const size_t rec = ((size_t)row * 8 + h) * 192 + 4 * cl;
            st4bf_nt(SH + rec, r4); st4bf_nt(SH + rec + 64, v4); st4bf_nt(SH + rec + 128, -kk4);
            st4bf_nt(SD0 + rec, df); st4bf_nt(SD0 + rec + 64, kf); st4bf_nt(SD0 + rec + 128, bf);
            st4bf_nt(SD1 + rec, db); st4bf_nt(SD1 + rec + 64, kb); st4bf_nt(SD1 + rec + 128, bb_);
            asm volatile("" ::: "memory");
        }
        if (tid < 256) {
            const int t = tid >> 4, g = tid & 15, row = R0 + t, kvh = g >> 3, d0 = (g & 7) * 8;
            const bf16* src = P + (size_t)row * PP + 512 + kvh * 64;
            const bool lat = row < ML; int b_, pos, tt = 0;
            if (lat) { b_ = row / SEQ; tt = row % SEQ; pos = CTXL + tt; } else { b_ = (row - ML) / CTXL; pos = (row - ML) % CTXL; }
            u32x4 ov = *(const u32x4*)(src + d0);
            if (lat) {
                const int dd = d0 & 31; const bool first = dd < 16;
                float o8[8], q8[8], r8[8]; unpack8(ov, o8); unpack8(*(const u32x4*)(src + (first ? d0 + 16 : d0 - 16)), q8);
                const float posf = (d0 < 32) ? (float)(tt >> 6) : (float)(tt & 63);
#pragma unroll
                for (int e = 0; e < 8; ++e) { const float inv = exp2f(-(float)((dd & 15) + e) * 0.8304820237f), ang = posf * inv, sn = __sinf(ang), cs = __cosf(ang);
                    r8[e] = first ? o8[e] * cs - q8[e] * sn : o8[e] * cs + q8[e] * sn; }
                ov = __builtin_bit_cast(u32x4, pack8(r8));
            }
            *(u32x4*)(KP + ((size_t)(b_ * 2 + kvh) * NPOS + pos) * 64 + d0) = ov;
        }
        { const int t = tid & 15, dq = tid >> 4, row = R0 + t, kvh = dq >> 4, d = (dq & 15) * 4;
          int b_, pos; if (row < ML) { b_ = row / SEQ; pos = CTXL + row % SEQ; } else { b_ = (row - ML) / CTXL; pos = (row - ML) % CTXL; }
          const u32x2 w = *(const u32x2*)(P + (size_t)row * PP + 640 + 4 * dq);
          bf16* dst = VT + (((size_t)(b_ * 2 + kvh) * (NPOS / 32) + (pos >> 5)) * 64 + d) * 32 + (pos & 31);
          dst[0] = (bf16)(w.x & 0xffffu); dst[32] = (bf16)(w.x >> 16); dst[64] = (bf16)(w.y & 0xffffu); dst[96] = (bf16)(w.y >> 16); }
    }
}

DI int crow(int r, int hi) { return (r & 3) + 8 * (r >> 2) + 4 * hi; }
constexpr int ATT_TASKS = 8192;
struct AttRegs { f32x16 O[2]; float m_, l_; bf16x8 qf[4], kf[4], vf[2][2]; int b, kvh, head, ql0, kb0, it_lo, it_hi; bool local; };
DI void att_setup(const Params& p, int task, int lane, AttRegs& A) {
    const bf16* Pm = (const bf16*)(p.ws + WS_P);
    const int qblk = task & 1, qsub = (task >> 1) & 1, g = (task >> 2) & 3, qb = (task >> 4) & 63; A.kvh = (task >> 10) & 1; A.b = task >> 11;
    A.head = A.kvh * 4 + g; A.ql0 = qb * 128 + qsub * 64 + qblk * 32; A.kb0 = 0; A.local = false;
    A.it_lo = A.ql0 < 128 ? (128 - A.ql0) >> 5 : 0; A.it_hi = A.ql0 + 160 > SEQ ? (SEQ - A.ql0 + 128) >> 5 : 9;
    const int r = lane & 31, hh = lane >> 5;
    const int t = A.ql0 + r; const bf16* src = Pm + (size_t)(A.b * SEQ + t) * PP + A.head * 64 + 8 * hh;
    float qv[4][8];
#pragma unroll
    for (int c = 0; c < 4; ++c) unpack8(*(const u32x4*)(src + 16 * c), qv[c]);
    const float prow = (float)(t >> 6), pcol = (float)(t & 63);
    float n0[8], n1[8], n2[8], n3[8];
#pragma unroll
    for (int e = 0; e < 8; ++e) { const float inv = exp2f(-(float)(8 * hh + e) * 0.8304820237f);
        const float a1 = prow * inv, s1 = __sinf(a1), c1 = __cosf(a1), a2 = pcol * inv, s2 = __sinf(a2), c2 = __cosf(a2); const float sc = 0.125f * LOG2E;
        n0[e] = (qv[0][e] * c1 - qv[1][e] * s1) * sc; n1[e] = (qv[1][e] * c1 + qv[0][e] * s1) * sc; n2[e] = (qv[2][e] * c2 - qv[3][e] * s2) * sc; n3[e] = (qv[3][e] * c2 + qv[2][e] * s2) * sc; }
    A.qf[0] = pack8(n0); A.qf[1] = pack8(n1); A.qf[2] = pack8(n2); A.qf[3] = pack8(n3);
    A.m_ = p.att_sink[A.head] * LOG2E; A.l_ = hh == 0 ? 1.0f : 0.0f;
#pragma unroll
    for (int dblk = 0; dblk < 2; ++dblk)
#pragma unroll
        for (int i = 0; i < 16; ++i) A.O[dblk][i] = 0.f;
}
DI void att_issue(const Params& p, int it, int lane, AttRegs& A) {
    const bf16* KP = (const bf16*)(p.ws + WS_KP); const bf16* VT = (const bf16*)(p.ws + WS_VT);
    const int r = lane & 31, hh = lane >> 5;
    int pos0; A.local = it < 9;
    if (A.local) { A.kb0 = A.ql0 - 128 + it * 32; pos0 = CTXL + A.kb0; } else pos0 = (it - 9) * 32;
    const bf16* Kb = KP + (size_t)(A.b * 2 + A.kvh) * NPOS * 64; const bf16* Vb = VT + (size_t)(A.b * 2 + A.kvh) * (NPOS / 32) * 2048;
#pragma unroll
    for (int c = 0; c < 4; ++c) A.kf[c] = *(const bf16x8*)(Kb + (size_t)(pos0 + r) * 64 + 16 * c + 8 * hh);
#pragma unroll
    for (int dblk = 0; dblk < 2; ++dblk)
#pragma unroll
        for (int s = 0; s < 2; ++s) { const u32x2* vp = (const u32x2*)(Vb + (size_t)(pos0 >> 5) * 2048 + (dblk * 32 + r) * 32 + 16 * s + 4 * hh); const u32x2 lo = vp[0], hi = vp[2];
            A.vf[dblk][s] = __builtin_bit_cast(bf16x8, (u32x4){lo.x, lo.y, hi.x, hi.y}); }
}
DI void att_compute(int lane, AttRegs& A) {
    const int r = lane & 31, hh = lane >> 5;
    const bool need_mask = A.local && !(A.kb0 >= A.ql0 - 97 && A.kb0 <= A.ql0 + 97);
    f32x16 S;
#pragma unroll
    for (int i = 0; i < 16; ++i) S[i] = 0.f;
#pragma unroll
    for (int c = 0; c < 4; ++c) S = __builtin_amdgcn_mfma_f32_32x32x16_bf16(A.kf[c], A.qf[c], S, 0, 0, 0);
    if (need_mask) { const int ql = A.ql0 + r;
#pragma unroll
        for (int i = 0; i < 16; ++i) { const int kl = A.kb0 + crow(i, hh); const int dlt = ql - kl; const bool ok = dlt <= 128 && dlt >= -128; S[i] = ok ? S[i] : -INFINITY; } }
    float tmax = S[0];
#pragma unroll
    for (int i = 1; i < 16; ++i) tmax = fmaxf(tmax, S[i]);
    tmax = fmaxf(tmax, __shfl_xor(tmax, 32));
    const float mnew = fmaxf(A.m_, tmax), alpha = __builtin_amdgcn_exp2f(A.m_ - mnew);
    A.m_ = mnew;
    float pe[16]; float ps = 0.f;
#pragma unroll
    for (int i = 0; i < 16; ++i) { pe[i] = __builtin_amdgcn_exp2f(S[i] - mnew); ps += pe[i]; }
    A.l_ = A.l_ * alpha + ps;
    if (__any(alpha != 1.0f)) {
#pragma unroll
        for (int dblk = 0; dblk < 2; ++dblk)
#pragma unroll
            for (int i = 0; i < 16; ++i) A.O[dblk][i] *= alpha; }
    bf16x8 pf[2];
#pragma unroll
    for (int s = 0; s < 2; ++s) { u32x4 w; w.x = pk2(pe[8 * s], pe[8 * s + 1]); w.y = pk2(pe[8 * s + 2], pe[8 * s + 3]); w.z = pk2(pe[8 * s + 4], pe[8 * s + 5]); w.w = pk2(pe[8 * s + 6], pe[8 * s + 7]);
        pf[s] = __builtin_bit_cast(bf16x8, w); }
#pragma unroll
    for (int dblk = 0; dblk < 2; ++dblk)
#pragma unroll
        for (int s = 0; s < 2; ++s) A.O[dblk] = __builtin_amdgcn_mfma_f32_32x32x16_bf16(A.vf[dblk][s], pf[s], A.O[dblk], 0, 0, 0);
}
DI void att_finish(const Params& p, int lane, AttRegs& A) {
    bf16* Pm = (bf16*)(p.ws + WS_P);
    const int r = lane & 31, hh = lane >> 5;
    const float lt = A.l_ + __shfl_xor(A.l_, 32), inv = __builtin_amdgcn_rcpf(lt);
    bf16* dst = Pm + (size_t)(A.b * SEQ + A.ql0 + r) * PP + A.head * 64;
#pragma unroll
    for (int dblk = 0; dblk < 2; ++dblk)
#pragma unroll
        for (int gi = 0; gi < 4; ++gi) { const f32x4 v = {A.O[dblk][4 * gi] * inv, A.O[dblk][4 * gi + 1] * inv, A.O[dblk][4 * gi + 2] * inv, A.O[dblk][4 * gi + 3] * inv};
            st4bf(dst + dblk * 32 + 8 * gi + 4 * hh, v); }
}
#define ATT_STEP(p, lane, A, a_task, a_stride, a_it, a_stage) do { if (a_task < ATT_TASKS) { \
        if (a_stage == 0) { att_setup(p, a_task, lane, A); a_it = A.it_lo; att_issue(p, a_it, lane, A); a_stage = 1; } \
        else { att_compute(lane, A); ++a_it; if (a_it == A.it_hi) a_it = 9; \
            if (a_it < 17) att_issue(p, a_it, lane, A); else { att_finish(p, lane, A); a_task += a_stride; a_stage = 0; } } } } while (0)
DI void phase_attention2(const Params& p, int wave, int lane, int vcu, int G) {
    AttRegs A; int a_task = vcu * NWAVES + wave, a_it = 0, a_stage = 0; const int a_stride = G * NWAVES;
    while (a_task < ATT_TASKS) ATT_STEP(p, lane, A, a_task, a_stride, a_it, a_stage);
}

DI int scan_row(int step, int b, int d) { if (step < CTXL) return ML + b * CTXL + (d ? CTXL - 1 - step : step); const int t = step - CTXL; return b * SEQ + (d ? SEQ - 1 - t : t); }
DI int prev_row(int row, int d, bool& none) {
    none = false;
    if (row < ML) { const int b = row / SEQ, t = row % SEQ; if (d == 0) return t > 0 ? row - 1 : ML + b * CTXL + CTXL - 1; return t < SEQ - 1 ? row + 1 : ML + b * CTXL; }
    const int j = (row - ML) % CTXL; if (d == 0) { none = j == 0; return none ? row : row - 1; } none = j == CTXL - 1; return none ? row : row + 1;
}
DI f32x4 ld4bf(const bf16* src) { const u32x2 w = *(const u32x2*)src; return (f32x4){bf_lo(w.x), bf_hi(w.x), bf_lo(w.y), bf_hi(w.y)}; }
DI float dot4(const f32x4 a, const f32x4 b) { return (a.x * b.x + a.y * b.y) + (a.z * b.z + a.w * b.w); }
DI void phase_pairs(const Params& p, int wave, int lane, int vcu, int G) {
    const bf16* SH = (const bf16*)(p.ws + WS_SH); const bf16* SD0 = (const bf16*)(p.ws + WS_SD0); const bf16* SD1 = (const bf16*)(p.ws + WS_SD1); float* CC = (float*)(p.ws + WS_CC);
    const int gw = vcu * NWAVES + wave, ngw = G * NWAVES, sub = lane >> 4, ks = (lane & 15) * 4;
    constexpr int NIT = 4;
    for (int base = gw * 4 * NIT; base < MT * 8; base += ngw * 4 * NIT) {
        f32x4 a4[NIT], kf[NIT], bf_[NIT], kb[NIT], bb[NIT]; bool nf[NIT], nb[NIT]; int it[NIT];
#pragma unroll
        for (int q = 0; q < NIT; ++q) {
            int item = base + q * 4 + sub; if (item >= MT * 8) item = MT * 8 - 1;
            it[q] = item; const int row = item >> 3, h = item & 7;
            const int pf = prev_row(row, 0, nf[q]), pb = prev_row(row, 1, nb[q]);
            a4[q] = ld4bf(SH + ((size_t)row * 8 + h) * 192 + 128 + ks);
            kf[q] = ld4bf(SD0 + ((size_t)pf * 8 + h) * 192 + 64 + ks); bf_[q] = ld4bf(SD0 + ((size_t)pf * 8 + h) * 192 + 128 + ks);
            kb[q] = ld4bf(SD1 + ((size_t)pb * 8 + h) * 192 + 64 + ks); bb[q] = ld4bf(SD1 + ((size_t)pb * 8 + h) * 192 + 128 + ks);
        }
#pragma unroll
        for (int q = 0; q < NIT; ++q) {
            float c1f = rowsum16(dot4(bf_[q], a4[q])), c2f = rowsum16(dot4(kf[q], a4[q])), c1b = rowsum16(dot4(bb[q], a4[q])), c2b = rowsum16(dot4(kb[q], a4[q]));
            if (nf[q]) { c1f = 0.f; c2f = 0.f; } if (nb[q]) { c1b = 0.f; c2b = 0.f; }
            if ((lane & 15) == 0 && base + q * 4 + sub < MT * 8) { *(f32x2*)(CC + (size_t)it[q] * 2) = (f32x2){c1f, c2f}; *(f32x2*)(CC + ((size_t)MT * 8 + it[q]) * 2) = (f32x2){c1b, c2b}; }
        }
    }
}
DI float fma_(float a, float b, float c) { float d; asm("v_fma_f32 %0, %1, %2, %3" : "=v"(d) : "v"(a), "v"(b), "v"(c)); return d; }
DI float mul_(float a, float b) { float d; asm("v_mul_f32 %0, %1, %2" : "=v"(d) : "v"(a), "v"(b)); return d; }
template <int MODE> DI void phase_scan(const Params& p, LAS unsigned char* lds, int tid, int wave, int lane, int vcu) {
    constexpr int TC = 32, STEPF = 384, BUFF = TC * STEPF, NCH = NPOS / TC;
    const int s = vcu >> 2, qr = vcu & 3, b = s >> 4, h = (s >> 1) & 7, d = s & 1;
    const bf16* SH = (const bf16*)(p.ws + WS_SH); const bf16* SD = (const bf16*)(p.ws + (d ? WS_SD1 : WS_SD0));
    bf16* Pm = (bf16*)(p.ws + WS_P);
    LAS float* buf = (LAS float*)lds;
    if (wave >= 4) {
        const int lt = tid - 256;
        u32x4 rgA[6], rgB[6];
#define SCAN_LOAD(rg, c) do { _Pragma("unroll") for (int i = 0; i < 6; ++i) { const int idx = i * 256 + lt, st = idx / 48, part = idx % 48; const int row = scan_row((c) * TC + st, b, d); \
            const bf16* src = (part < 24 ? SH : SD) + ((size_t)row * 8 + h) * 192 + (part % 24) * 8; rg[i] = *(const u32x4*)src; } } while (0)
#define SCAN_WRITE(rg, bi) do { _Pragma("unroll") for (int i = 0; i < 6; ++i) { const int idx = i * 256 + lt, st = idx / 48, part = idx % 48; LAS float* dst = buf + (bi) * BUFF + st * STEPF + part * 8; \
            *(LAS f32x4*)dst = (f32x4){bf_lo(rg[i].x), bf_hi(rg[i].x), bf_lo(rg[i].y), bf_hi(rg[i].y)}; *(LAS f32x4*)(dst + 4) = (f32x4){bf_lo(rg[i].z), bf_hi(rg[i].z), bf_lo(rg[i].w), bf_hi(rg[i].w)}; } } while (0)
        SCAN_LOAD(rgA, 0); SCAN_WRITE(rgA, 0); SCAN_LOAD(rgA, 1); SCAN_LOAD(rgB, 2);
        AttRegs A; int a_task = MODE == 0 ? vcu * 4 + (wave - 4) : ATT_TASKS, a_it = 0, a_stage = 0; const int a_stride = 1024;
        __syncthreads();
        for (int c = 0; c < NCH; c += 2) {
            if (MODE != 1 && c + 1 < NCH) { SCAN_WRITE(rgA, 1); if (c + 3 < NCH) SCAN_LOAD(rgA, c + 3); }
            ATT_STEP(p, lane, A, a_task, a_stride, a_it, a_stage);
            __syncthreads();
            if (MODE != 1 && c + 2 < NCH) { SCAN_WRITE(rgB, 0); if (c + 4 < NCH) SCAN_LOAD(rgB, c + 4); }
            ATT_STEP(p, lane, A, a_task, a_stride, a_it, a_stage);
            __syncthreads();
        }
        while (a_task < ATT_TASKS) ATT_STEP(p, lane, A, a_task, a_stride, a_it, a_stage);
#undef SCAN_LOAD
#undef SCAN_WRITE
    } else {
        const int rl = wave * 4 + (lane >> 4), vidx = qr * 16 + rl, ks = (lane & 15) * 4, l15 = lane & 15;
        f32x2 S01 = {0.f, 0.f}, S23 = {0.f, 0.f};
        __builtin_amdgcn_s_setprio(2);
        bf16* ydst = MODE ? Pm + 2688 + d * 64 + vidx : Pm + 1024 + d * 512 + h * 64 + vidx;
        __syncthreads();
        for (int c = 0; c < NCH; ++c) {
            if (MODE == 2) { __syncthreads(); continue; }
            const LAS float* cb = buf + (c & 1) * BUFF + ks;
            const LAS float* cv = buf + (c & 1) * BUFF + 64 + vidx;
            const bool emit = c >= CTXL / TC;
            f32x4 R_[2], A_[2], W_[2], K_[2], B_[2]; float V_[2];
#define SCAN_LD(sl, st) do { const LAS float* bs = cb + (st) * STEPF; R_[sl] = *(const LAS f32x4*)(bs); A_[sl] = *(const LAS f32x4*)(bs + 128); W_[sl] = *(const LAS f32x4*)(bs + 192); \
            K_[sl] = *(const LAS f32x4*)(bs + 256); B_[sl] = *(const LAS f32x4*)(bs + 320); V_[sl] = cv[(st) * STEPF]; } while (0)
            SCAN_LD(0, 0); SCAN_LD(1, 1);
            float ykeep = 0.f;
#pragma unroll
            for (int st = 0; st < TC; ++st) {
                const int sl = st & 1;
                const f32x4 r4 = R_[sl], a4 = A_[sl], w4 = W_[sl], k4 = K_[sl], b4 = B_[sl]; const float vv = V_[sl];
                if (st + 2 < TC) SCAN_LD(sl, st + 2);
                f32x2 t = S01 * (f32x2){a4.x, a4.y}; t = S23 * (f32x2){a4.z, a4.w} + t;
                const float sa = rowsum16(t.x + t.y);
                S01 = (S01 * (f32x2){w4.x, w4.y} + (f32x2){k4.x, k4.y} * vv) + (f32x2){b4.x, b4.y} * sa;
                S23 = (S23 * (f32x2){w4.z, w4.w} + (f32x2){k4.z, k4.w} * vv) + (f32x2){b4.z, b4.w} * sa;
                f32x2 yq = S01 * (f32x2){r4.x, r4.y}; yq = S23 * (f32x2){r4.z, r4.w} + yq;
                const float y = rowsum16(yq.x + yq.y);
                ykeep = (l15 == (st & 15)) ? y : ykeep;
                if ((st & 15) == 15 && emit) { const int row = scan_row(c * TC + (st - 15) + l15, b, d); ydst[(size_t)row * PP] = (bf16)(pk2(ykeep, 0.f) & 0xffffu); }
            }
#undef SCAN_LD
            __syncthreads();
        }
        __builtin_amdgcn_s_setprio(0);
    }
}

template <int DUMMY> DI void phase_attention(const Params& p, LAS unsigned char* lds, int tid, int wave, int lane, int vcu, int G) {
    bf16* Pm = (bf16*)(p.ws + WS_P); const bf16* KP = (const bf16*)(p.ws + WS_KP); const bf16* VT = (const bf16*)(p.ws + WS_VT);
    LAS unsigned char* Kl = lds;
    LAS unsigned char* Vl = lds + 55296;
    const int r = lane & 31, hh = lane >> 5, g = wave >> 1, qsub = wave & 1;
    for (int u = vcu; u < 512; u += G) {
        const int b = u >> 7, kvh = (u >> 6) & 1, qb = u & 63, head = kvh * 4 + g, qlo = qb * 128 + qsub * 64;
        bf16x8 qf[2][4];
#pragma unroll
        for (int qblk = 0; qblk < 2; ++qblk) {
            const int t = qlo + qblk * 32 + r; const bf16* src = Pm + (size_t)(b * SEQ + t) * PP + head * 64 + 8 * hh;
            float qv[4][8];
#pragma unroll
            for (int c = 0; c < 4; ++c) unpack8(*(const u32x4*)(src + 16 * c), qv[c]);
            const float prow = (float)(t >> 6), pcol = (float)(t & 63);
            float n0[8], n1[8], n2[8], n3[8];
#pragma unroll
            for (int e = 0; e < 8; ++e) { const float inv = exp2f(-(float)(8 * hh + e) * 0.8304820237f);
                const float a1 = prow * inv, s1 = __sinf(a1), c1 = __cosf(a1), a2 = pcol * inv, s2 = __sinf(a2), c2 = __cosf(a2); const float sc = 0.125f * LOG2E;
                n0[e] = (qv[0][e] * c1 - qv[1][e] * s1) * sc; n1[e] = (qv[1][e] * c1 + qv[0][e] * s1) * sc; n2[e] = (qv[2][e] * c2 - qv[3][e] * s2) * sc; n3[e] = (qv[3][e] * c2 + qv[2][e] * s2) * sc; }
            qf[qblk][0] = pack8(n0); qf[qblk][1] = pack8(n1); qf[qblk][2] = pack8(n2); qf[qblk][3] = pack8(n3);
        }
        f32x16 O[2][2]; float m_[2], l_[2];
#pragma unroll
        for (int q = 0; q < 2; ++q) { m_[q] = p.att_sink[head] * LOG2E; l_[q] = hh == 0 ? 1.0f : 0.0f;
#pragma unroll
            for (int dblk = 0; dblk < 2; ++dblk)
#pragma unroll
                for (int i = 0; i < 16; ++i) O[q][dblk][i] = 0.f; }
        for (int round = 0; round < 2; ++round) {
            const int nslots = round ? 256 : 384;
            __syncthreads();
            for (int i = tid; i < nslots * 8; i += NTHR) { const int slot = i >> 3, ch = i & 7; int pos; bool valid = true;
                if (round == 0) { const int kl = (qb - 1) * 128 + slot; valid = kl >= 0 && kl < SEQ; pos = CTXL + kl; } else pos = slot;
                u32x4 v = {0u, 0u, 0u, 0u}; if (valid) v = *(const u32x4*)(KP + ((size_t)(b * 2 + kvh) * NPOS + pos) * 64 + ch * 8);
                *(LAS u32x4*)(Kl + slot * 144 + ch * 16) = v; }
            const int nch = nslots >> 3;
            for (int i = tid; i < 64 * nch; i += NTHR) { const int dd = i / nch, ch = i % nch, slot0 = ch * 8; int pos0; bool valid = true;
                if (round == 0) { const int kl0 = (qb - 1) * 128 + slot0; valid = kl0 >= 0 && kl0 < SEQ; pos0 = CTXL + kl0; } else pos0 = slot0;
                u32x4 v = {0u, 0u, 0u, 0u}; if (valid) v = *(const u32x4*)(VT + ((size_t)(b * 2 + kvh) * 64 + dd) * NPOS + pos0);
                LAS u32x2* dst = (LAS u32x2*)(Vl + dd * 776 + slot0 * 2); dst[0] = (u32x2){v.x, v.y}; dst[1] = (u32x2){v.z, v.w}; }
            __syncthreads();
            const int tlo = round ? 0 : 2 * qsub, thi = round ? 8 : 2 * qsub + 10;
            for (int T = tlo; T < thi; ++T) {
                bf16x8 kf[4], vf[2][2];
#pragma unroll
                for (int c = 0; c < 4; ++c) kf[c] = *(const LAS bf16x8*)(Kl + (T * 32 + r) * 144 + (16 * c + 8 * hh) * 2);
#pragma unroll
                for (int dblk = 0; dblk < 2; ++dblk)
#pragma unroll
                    for (int s = 0; s < 2; ++s) { const LAS u32x2* vp = (const LAS u32x2*)(Vl + (dblk * 32 + r) * 776 + (T * 32 + 16 * s + 4 * hh) * 2); const u32x2 lo = vp[0], hi = vp[2];
                        vf[dblk][s] = __builtin_bit_cast(bf16x8, (u32x4){lo.x, lo.y, hi.x, hi.y}); }
#pragma unroll
                for (int q = 0; q < 2; ++q) {
                    f32x16 S;
#pragma unroll
                    for (int i = 0; i < 16; ++i) S[i] = 0.f;
#pragma unroll
                    for (int c = 0; c < 4; ++c) S = __builtin_amdgcn_mfma_f32_32x32x16_bf16(kf[c], qf[q][c], S, 0, 0, 0);
                    const int kb0w = (qb - 1) * 128 + T * 32;
                    const bool need_mask = round == 0 && !(kb0w >= 0 && kb0w + 31 < SEQ && kb0w >= qlo - 65 && kb0w <= qlo + 97);
                    if (need_mask) { const int ql = qlo + q * 32 + r, kb0 = kb0w;
#pragma unroll
                        for (int i = 0; i < 16; ++i) { const int kl = kb0 + crow(i, hh); const int dlt = ql - kl; const bool ok = kl >= 0 && kl < SEQ && dlt <= 128 && dlt >= -128; S[i] = ok ? S[i] : -INFINITY; } }
                    float tmax = S[0];
#pragma unroll
                    for (int i = 1; i < 16; ++i) tmax = fmaxf(tmax, S[i]);
                    tmax = fmaxf(tmax, __shfl_xor(tmax, 32));
                    const float mnew = fmaxf(m_[q], tmax), alpha = __builtin_amdgcn_exp2f(m_[q] - mnew);
                    m_[q] = mnew;
                    float pe[16]; float ps = 0.f;
#pragma unroll
                    for (int i = 0; i < 16; ++i) { pe[i] = __builtin_amdgcn_exp2f(S[i] - mnew); ps += pe[i]; }
                    l_[q] = l_[q] * alpha + ps;
                    if (__any(alpha != 1.0f)) {
#pragma unroll
                    for (int dblk = 0; dblk < 2; ++dblk)
#pragma unroll
                        for (int i = 0; i < 16; ++i) O[q][dblk][i] *= alpha; }
                    bf16x8 pf[2];
#pragma unroll
                    for (int s = 0; s < 2; ++s) { u32x4 w; w.x = pk2(pe[8 * s], pe[8 * s + 1]); w.y = pk2(pe[8 * s + 2], pe[8 * s + 3]); w.z = pk2(pe[8 * s + 4], pe[8 * s + 5]); w.w = pk2(pe[8 * s + 6], pe[8 * s + 7]);
                        pf[s] = __builtin_bit_cast(bf16x8, w); }
#pragma unroll
                    for (int dblk = 0; dblk < 2; ++dblk)
#pragma unroll
                        for (int s = 0; s < 2; ++s) O[q][dblk] = __builtin_amdgcn_mfma_f32_32x32x16_bf16(vf[dblk][s], pf[s], O[q][dblk], 0, 0, 0);
                }
            }
        }
#pragma unroll
        for (int q = 0; q < 2; ++q) {
            const float lt = l_[q] + __shfl_xor(l_[q], 32), inv = __builtin_amdgcn_rcpf(lt);
            bf16* dst = Pm + (size_t)(b * SEQ + qlo + q * 32 + r) * PP + head * 64 + (DUMMY ? 1024 : 0);
#pragma unroll
            for (int dblk = 0; dblk < 2; ++dblk)
#pragma unroll
                for (int gi = 0; gi < 4; ++gi) { const f32x4 v = {O[q][dblk][4 * gi] * inv, O[q][dblk][4 * gi + 1] * inv, O[q][dblk][4 * gi + 2] * inv, O[q][dblk][4 * gi + 3] * inv};
                    st4bf(dst + dblk * 32 + 8 * gi + 4 * hh, v); }
        }
    }
}

DI void phase_rwkv_out(const Params& p, LAS unsigned char* lds, int tid, int wave, int lane, int vcu, int G) {
    bf16* Pm = (bf16*)(p.ws + WS_P); const bf16* SH = (const bf16*)(p.ws + WS_SH); const float* BC = (const float*)(p.ws + WS_BC); const bf16* G2T = (const bf16*)(p.ws + WS_G2T);
    constexpr int GP = 136;
    LAS bf16* T = (LAS bf16*)lds;
    const int h = wave, tq = lane >> 4, cl = lane & 15, c0 = h * 64 + 4 * cl;
    const f32x4 lnw = *(const f32x4*)(p.rwkv_ln_w + c0), lnb = *(const f32x4*)(p.rwkv_ln_b + c0);
    bf16x8 gw_[16];
#pragma unroll
    for (int q = 0; q < 16; ++q) gw_[q] = *(const bf16x8*)(G2T + (size_t)(c0 + (q & 3)) * 128 + (q >> 2) * 32 + tq * 8);
    for (int u = vcu; u < ML / 16; u += G) {
        const int R0 = u * 16, seq0 = (R0 / SEQ) * SEQ;
        u32x2 yf_[4], yb_[4], vw_[4]; float bc_[4];
#pragma unroll
        for (int j = 0; j < 4; ++j) { const int row = R0 + 4 * tq + j;
            yf_[j] = *(const u32x2*)(Pm + (size_t)row * PP + 1024 + c0); yb_[j] = *(const u32x2*)(Pm + (size_t)row * PP + 1536 + c0);
            vw_[j] = *(const u32x2*)(SH + ((size_t)row * 8 + h) * 192 + 64 + 4 * cl); bc_[j] = BC[row * 8 + h]; }
        __syncthreads();
        for (int i = tid; i < 18 * 16; i += NTHR) { const int rr = i >> 4, ch = i & 15, row = R0 - 1 + rr;
            u32x4 v = {0u, 0u, 0u, 0u}; if (row >= seq0 && row < seq0 + SEQ) v = *(const u32x4*)(Pm + (size_t)row * PP + RWC + 1792 + ch * 8);
            *(LAS u32x4*)(T + rr * GP + ch * 8) = v; }
        __syncthreads();
        f32x4 gate[4];
#pragma unroll
        for (int nt = 0; nt < 4; ++nt) gate[nt] = (f32x4){0.f, 0.f, 0.f, 0.f};
#pragma unroll
        for (int ks = 0; ks < 4; ++ks) {
            const int cb = ks * 32 + tq * 8, tok = lane & 15;
            float pv[8], cv[8], nv[8], a8[8];
            unpack8(*(const LAS u32x4*)(T + tok * GP + cb), pv); unpack8(*(const LAS u32x4*)(T + (tok + 1) * GP + cb), cv); unpack8(*(const LAS u32x4*)(T + (tok + 2) * GP + cb), nv);
            const f32x4 m0 = *(const f32x4*)(p.rwkv_mu + 1792 + cb), m1 = *(const f32x4*)(p.rwkv_mu + 1792 + cb + 4);
#pragma unroll
            for (int e = 0; e < 8; ++e) { const float mu = e < 4 ? m0[e] : m1[e - 4]; a8[e] = sigmoidf_(cv[e] + mu * (0.5f * (pv[e] + nv[e]) - cv[e])); }
            const bf16x8 a = pack8(a8);
#pragma unroll
            for (int nt = 0; nt < 4; ++nt) gate[nt] = __builtin_amdgcn_mfma_f32_16x16x32_bf16(a, gw_[ks * 4 + nt], gate[nt], 0, 0, 0);
        }
#pragma unroll
        for (int j = 0; j < 4; ++j) {
            const int row = R0 + 4 * tq + j;
            const u32x2 yf = yf_[j], yb = yb_[j];
            const f32x4 y = (f32x4){bf_lo(yf.x), bf_hi(yf.x), bf_lo(yf.y), bf_hi(yf.y)} + (f32x4){bf_lo(yb.x), bf_hi(yb.x), bf_lo(yb.y), bf_hi(yb.y)};
            const float mean = rowsum16((y.x + y.y) + (y.z + y.w)) * (1.0f / 64.0f);
            const f32x4 dv = y - mean;
            const float var = rowsum16((dv.x * dv.x + dv.y * dv.y) + (dv.z * dv.z + dv.w * dv.w)) * (1.0f / 64.0f);
            const float rstd = rsqrtf(var + 64e-5f);
            const u32x2 vw = vw_[j];
            const f32x4 v4 = {bf_lo(vw.x), bf_hi(vw.x), bf_lo(vw.y), bf_hi(vw.y)};
            const float bc = bc_[j];
            const f32x4 gt = {gate[0][j], gate[1][j], gate[2][j], gate[3][j]};
            const f32x4 o = (dv * rstd * lnw + lnb + v4 * bc) * gt;
            st4bf(Pm + (size_t)row * PP + 512 + c0, o);
        }
    }
}

DI void ld8f(const bf16* src, float (&o)[8]) { unpack8(*(const u32x4*)src, o); }
DI void phase_conv(const Params& p, int wave, int lane, int vcu, int G) {
    const bf16* Gm = (const bf16*)(p.ws + WS_G); bf16* Z = (bf16*)(p.ws + WS_Z);
    const int gw = vcu * NWAVES + wave, ngw = G * NWAVES;
    float cw[2][3][8];
#pragma unroll
    for (int j = 0; j < 2; ++j)
#pragma unroll
        for (int k = 0; k < 3; ++k) { const f32x4 a = *(const f32x4*)(p.conv_w + k * 1024 + 8 * lane + 512 * j), b = *(const f32x4*)(p.conv_w + k * 1024 + 8 * lane + 512 * j + 4);
            cw[j][k][0] = a.x; cw[j][k][1] = a.y; cw[j][k][2] = a.z; cw[j][k][3] = a.w; cw[j][k][4] = b.x; cw[j][k][5] = b.y; cw[j][k][6] = b.z; cw[j][k][7] = b.w; }
    for (int row = gw; row < ML; row += ngw) {
        const int t = row % SEQ;
#pragma unroll
        for (int j = 0; j < 2; ++j) {
            const int col = 8 * lane + 512 * j; const bf16* base = Gm + (size_t)row * 3072 + col;
            float gb[8], gc[8], uu[8], qp[8], qn[8], z[8];
            ld8f(base, gb); ld8f(base + 1024, gc); ld8f(base + 2048, uu);
            if (t > 0) { float a[8], c[8]; ld8f(base - 3072 + 1024, a); ld8f(base - 3072 + 2048, c);
#pragma unroll
                for (int e = 0; e < 8; ++e) qp[e] = a[e] * c[e]; } else {
#pragma unroll
                for (int e = 0; e < 8; ++e) qp[e] = 0.f; }
            if (t < SEQ - 1) { float a[8], c[8]; ld8f(base + 3072 + 1024, a); ld8f(base + 3072 + 2048, c);
#pragma unroll
                for (int e = 0; e < 8; ++e) qn[e] = a[e] * c[e]; } else {
#pragma unroll
                for (int e = 0; e < 8; ++e) qn[e] = 0.f; }
#pragma unroll
            for (int e = 0; e < 8; ++e) z[e] = gb[e] * (cw[j][0][e] * qp[e] + cw[j][1][e] * (gc[e] * uu[e]) + cw[j][2][e] * qn[e]);
            *(u32x4*)(Z + (size_t)row * DM + col) = __builtin_bit_cast(u32x4, pack8(z));
        }
    }
}

#define RLX_AGENT __ATOMIC_RELAXED, __HIP_MEMORY_SCOPE_AGENT
#define XB_TMO      128
#define XB_XCNT(j)  (256  + 64 * (j))
#define XB_XSUB(j)  (1280 + 64 * (j))
#define XB_XGEN(j)  (2304 + 64 * (j))
#define XB_TOP      3328
#define XB_TOPGEN   3392
#define XCD_BAR_WORDS 3456
#define XB_SPIN_CAP (1u << 18)

__device__ __forceinline__ unsigned xb_ld(unsigned* p)              { return __hip_atomic_load(p, __ATOMIC_RELAXED, __HIP_MEMORY_SCOPE_AGENT); }
__device__ __forceinline__ unsigned xb_add(unsigned* p, unsigned v) { return __hip_atomic_fetch_add(p, v, __ATOMIC_RELAXED, __HIP_MEMORY_SCOPE_AGENT); }
__device__ __forceinline__ unsigned xb_xcc_id() { return (unsigned)__builtin_amdgcn_s_getreg((3 << 11) | 20) & 0xFu; }
#define XB_SPIN(cond, bar) do { unsigned _sp = 0; while (cond) { __builtin_amdgcn_s_sleep(1); \
    if ((++_sp & 255u) == 0u) { if (xb_ld(&(bar)[XB_TMO])) break; if (_sp > XB_SPIN_CAP) { atomicAdd(&(bar)[XB_TMO], 1u); break; } } } } while (0)

struct XcdBarrier {
    unsigned* bar; unsigned x;
    volatile LAS unsigned* st;
};

__device__ __forceinline__ XcdBarrier xcd_barrier_post(unsigned* bar, volatile LAS unsigned* st) {
    XcdBarrier b; b.bar = bar; b.x = xb_xcc_id(); b.st = st;
    if (threadIdx.x == 0) (void)xb_add(&bar[XB_XCNT(b.x)], 1u);
    return b;
}
__device__ __forceinline__ void xcd_barrier_complete(unsigned* bar, unsigned x, unsigned& nloc, unsigned& nx) {
    const unsigned G = gridDim.x * gridDim.y * gridDim.z;
    unsigned sum, cnt, mine, sp = 0u;
    for (;;) {
        sum = 0u; cnt = 0u; mine = 0u;
#pragma unroll
        for (unsigned j = 0; j < 16; ++j) { const unsigned c = xb_ld(&bar[XB_XCNT(j)]); sum += c; cnt += (c > 0u) ? 1u : 0u; mine = (j == x) ? c : mine; }
        if (sum == G) break;
        __builtin_amdgcn_s_sleep(1);
        if ((++sp & 255u) == 0u) { if (xb_ld(&bar[XB_TMO])) break; if (sp > XB_SPIN_CAP) { atomicAdd(&bar[XB_TMO], 1u); break; } }
    }
    nloc = mine > 0u ? mine : 1u; nx = cnt > 0u ? cnt : 1u;
}

__device__ __forceinline__ void xcd_barrier(const XcdBarrier& b) {
    asm volatile("s_waitcnt vmcnt(0)" ::: "memory");
    __syncthreads();
    if (threadIdx.x == 0) {
        unsigned* bar = b.bar;
        __builtin_amdgcn_s_waitcnt(0);
        unsigned nloc = b.st[0], nx = b.st[1];
        if (nloc == 0u) { xcd_barrier_complete(bar, b.x, nloc, nx); b.st[0] = nloc; b.st[1] = nx; }
        const unsigned old = xb_add(&bar[XB_XSUB(b.x)], 1u);
        const unsigned gen = old / nloc;
        if (old + 1u == (gen + 1u) * nloc) {
            __builtin_amdgcn_fence(__ATOMIC_RELEASE, "agent");
            asm volatile("s_waitcnt vmcnt(0)" ::: "memory");
            const unsigned og = xb_add(&bar[XB_TOP], 1u);
            const unsigned tg = og / nx;
            if (og + 1u == (tg + 1u) * nx) xb_add(&bar[XB_TOPGEN], 1u);
            else XB_SPIN(xb_ld(&bar[XB_TOPGEN]) == tg, bar);
            __builtin_amdgcn_fence(__ATOMIC_ACQUIRE, "agent");
            xb_add(&bar[XB_XGEN(b.x)], 1u);
            asm volatile("s_waitcnt vmcnt(0)" ::: "memory");
        } else {
            XB_SPIN(xb_ld(&bar[XB_XGEN(b.x)]) == gen, bar);
            __builtin_amdgcn_fence(__ATOMIC_ACQUIRE, "agent");
            asm volatile("s_waitcnt vmcnt(0)" ::: "memory");
        }
    }
    __syncthreads();
}

constexpr int N_PHASES = 18;
constexpr int PROBE = 0;
template <int ACT>
DI void run_gemm(LAS unsigned char* lds, const bf16* A, int lda, const bf16* Bt, int M, int N, int K, bf16* O, int ldc, int G) {
    pg8::Gemm g{A, Bt, M, N, K, lda}; pg8::StaticOrder S; S.init(M, N, G, (int)blockIdx.x);
    pg8::EpiBf16<ACT> E{O, ldc, nullptr, 0, 0, 1.f};
    pg8::gemm_phase<pg8::EpiBf16<ACT>, pg8::StaticOrder, true, true>(lds, g, S, E);
}

__global__ void __launch_bounds__(NTHR, 2) mega_fwd(Params p) {
    extern __shared__ __attribute__((aligned(16))) unsigned char lds_raw[];
    LAS unsigned char* lds = (LAS unsigned char*)lds_raw;
    cg::grid_group grid = cg::this_grid();
    const int tid = threadIdx.x, lane = tid & 63, wave = __builtin_amdgcn_readfirstlane(tid >> 6);
    const int G = gridDim.x, bx = blockIdx.x, vcu = (G % 8 == 0) ? (bx % 8) * (G / 8) + bx / 8 : bx;
    unsigned char* ws = p.ws;
    volatile LAS unsigned* misc = (volatile LAS unsigned*)(lds + 131072);
    if (tid < 32) misc[tid] = 0u;
    __syncthreads();
    if (bx == 0) for (int i = tid; i < (int)(WS_BAR_BYTES / 4); i += NTHR) ((unsigned*)(ws + WS_BAR))[i] = 0u;
    XcdBarrier xbar; xbar.bar = (unsigned*)(ws + WS_BAR); xbar.x = 0; xbar.st = misc + 8;
    const float* mod0 = (const float*)(ws + WS_MOD); const float* mod1 = mod0 + 5 * 6144;
    const float* ng0 = p.norm_g; const float* ng1 = p.norm_g + 4 * DM;
#define IN(k) (p.ph_lo <= (k) && (k) < p.ph_hi)
#define SEAM(k) do { if (IN(k) && IN((k) + 1)) { if ((k) == 0) grid.sync(); else xcd_barrier(xbar); } } while (0)
    if (IN(0)) { phase_prologue(p, lds, tid, wave, lane, vcu, G); if (PROBE == 7) { __syncthreads(); phase_prologue(p, lds, tid, wave, lane, vcu, G); } }
    SEAM(0);
    xbar = xcd_barrier_post((unsigned*)(ws + WS_BAR), misc + 8);
    if (IN(1)) phase_norm0(p, wave, lane, vcu, G);
    SEAM(1);
    if (IN(2)) run_gemm<0>(lds, (const bf16*)(ws + WS_A0), DM, (const bf16*)(ws + WS_WINT), MT, PP, DM, (bf16*)(ws + WS_P), PP, G);
    SEAM(2);
    if (IN(3)) { phase_features(p, lds, tid, wave, lane, vcu, G);  }
    SEAM(3);
    if (IN(4)) { if (PROBE == 8) { phase_attention<1>(p, lds, tid, wave, lane, vcu, G); __syncthreads(); }
        for (int su = vcu; su < 256; su += G) phase_scan<0>(p, lds, tid, wave, lane, su); __syncthreads(); if (PROBE == 2) { for (int su = vcu; su < 256; su += G) phase_scan<0>(p, lds, tid, wave, lane, su); __syncthreads(); }
        if (PROBE == 5) { for (int su = vcu; su < 256; su += G) phase_scan<1>(p, lds, tid, wave, lane, su); __syncthreads(); }
        if (PROBE == 6) { for (int su = vcu; su < 256; su += G) phase_scan<2>(p, lds, tid, wave, lane, su); __syncthreads(); } }
    SEAM(4);
    if (IN(5)) { phase_rwkv_out(p, lds, tid, wave, lane, vcu, G); __syncthreads(); phase_weights2(p, lds, wave, lane, vcu, G);
        if (PROBE == 9) { __syncthreads(); phase_rwkv_out(p, lds, tid, wave, lane, vcu, G); __syncthreads(); phase_weights2(p, lds, wave, lane, vcu, G); }
        if (PROBE == 3) { __syncthreads(); phase_weights2(p, lds, wave, lane, vcu, G); } if (PROBE == 4) { __syncthreads(); phase_rwkv_out(p, lds, tid, wave, lane, vcu, G); } }
    SEAM(5);
    if (IN(6)) run_gemm<0>(lds, (const bf16*)(ws + WS_P), PP, (const bf16*)(ws + WS_WOUTT), ML, DM, DM, (bf16*)(ws + WS_YL), DM, G);
    SEAM(6);
    if (IN(7)) { phase_norm1<false, true>((const bf16*)(ws + WS_YL), p.x, ws + WS_XLB, ng0 + DM, mod0, 2048, ng0 + 2 * DM, 3072, 4096, (bf16*)(ws + WS_A1), wave, lane, vcu, G);
        if (PROBE == 1) phase_norm1<false, true>((const bf16*)(ws + WS_YL), p.x, ws + WS_XLB, ng0 + DM, mod0, 2048, ng0 + 2 * DM, 3072, 4096, (bf16*)(ws + WS_A1), wave, lane, vcu, G); }
    SEAM(7);
    if (IN(8)) run_gemm<1>(lds, (const bf16*)(ws + WS_A1), DM, (const bf16*)(ws + WS_W1T0), ML, HID, DM, (bf16*)(ws + WS_H), HID, G);
    SEAM(8);
    if (IN(9)) run_gemm<0>(lds, (const bf16*)(ws + WS_H), HID, (const bf16*)(ws + WS_W2T0), ML, DM, HID, (bf16*)(ws + WS_YL), DM, G);
    SEAM(9);
    if (IN(10)) phase_norm1<true, true>((const bf16*)(ws + WS_YL), ws + WS_XLB, ws + WS_XLB, ng0 + 3 * DM, mod0, 5120, ng1, 30720, 30720 + 1024, (bf16*)(ws + WS_A1), wave, lane, vcu, G);
    SEAM(10);
    if (IN(11)) run_gemm<0>(lds, (const bf16*)(ws + WS_A1), DM, (const bf16*)(ws + WS_CINT), ML, 3 * DM, DM, (bf16*)(ws + WS_G), 3 * DM, G);
    SEAM(11);
    if (IN(12)) phase_conv(p, wave, lane, vcu, G);
    SEAM(12);
    if (IN(13)) run_gemm<0>(lds, (const bf16*)(ws + WS_Z), DM, (const bf16*)(ws + WS_COUTT), ML, DM, DM, (bf16*)(ws + WS_YL), DM, G);
    SEAM(13);
    if (IN(14)) phase_norm1<true, true>((const bf16*)(ws + WS_YL), ws + WS_XLB, ws + WS_XLB, ng1 + DM, mod1, 2048, ng1 + 2 * DM, 3072, 4096, (bf16*)(ws + WS_A1), wave, lane, vcu, G);
    SEAM(14);
    if (IN(15)) run_gemm<1>(lds, (const bf16*)(ws + WS_A1), DM, (const bf16*)(ws + WS_W1T1), ML, HID, DM, (bf16*)(ws + WS_H), HID, G);
    SEAM(15);
    if (IN(16)) run_gemm<0>(lds, (const bf16*)(ws + WS_H), HID, (const bf16*)(ws + WS_W2T1), ML, DM, HID, (bf16*)(ws + WS_YL), DM, G);
    SEAM(16);
    if (IN(17)) phase_norm1<true, false>((const bf16*)(ws + WS_YL), ws + WS_XLB, p.out, ng1 + 3 * DM, mod1, 5120, nullptr, 0, 0, nullptr, wave, lane, vcu, G);
#undef IN
#undef SEAM
}

extern "C" void kernel_launch(void* const* d_in, const int* in_sizes, int n_in, void* d_out, int out_size, void* d_ws, size_t ws_size, hipStream_t stream) {
    static int grid = 0;
    if (grid == 0) {
        if (n_in != 26 || out_size != ML * DM || ws_size < WS_END) { fprintf(stderr, "kernel_launch: unexpected shapes (n_in %d out %d ws %zu)\n", n_in, out_size, ws_size); grid = -1; return; }
        int dev = 0, cus = 0, per_cu = 0;
        (void)hipGetDevice(&dev); (void)hipDeviceGetAttribute(&cus, hipDeviceAttributeMultiprocessorCount, dev);
        if (hipFuncSetAttribute((const void*)mega_fwd, hipFuncAttributeMaxDynamicSharedMemorySize, LDS_BYTES) != hipSuccess) { fprintf(stderr, "kernel_launch: hipFuncSetAttribute failed\n"); grid = -1; return; }
        if (hipOccupancyMaxActiveBlocksPerMultiprocessor(&per_cu, (const void*)mega_fwd, NTHR, LDS_BYTES) != hipSuccess || per_cu < 1) per_cu = 1;
        (void)hipGetLastError();
        grid = cus * per_cu; if (grid > 256) grid = 256; if (grid < 1) grid = 256;
    }
    if (grid < 0) return;
    Params p{};
    const float** f = (const float**)&p;
    for (int i = 0; i < 26; ++i) f[i] = (const float*)d_in[i];
    p.out = (float*)d_out; p.ws = (unsigned char*)d_ws;
#ifndef MK_SPLIT
    p.ph_lo = 0; p.ph_hi = N_PHASES;
    void* args[] = {&p};
    hipError_t e = hipLaunchCooperativeKernel((void*)mega_fwd, dim3(grid), dim3(NTHR), args, LDS_BYTES, stream);
    if (e != hipSuccess) fprintf(stderr, "cooperative launch failed: %s (grid %d)\n", hipGetErrorString(e), grid);
#else
    for (int k = 0; k < N_PHASES; ++k) { p.ph_lo = k; p.ph_hi = k + 1; void* args[] = {&p};
        hipError_t e = hipLaunchCooperativeKernel((void*)mega_fwd, dim3(grid), dim3(NTHR), args, LDS_BYTES, stream);
        if (e != hipSuccess) { fprintf(stderr, "launch %d failed: %s\n", k, hipGetErrorString(e)); break; } }
#endif
}
```
